# Optimizing an MI355X kernel written in HIP

```python
import jax, jax.numpy as jnp
from jax import lax
import numpy as np

D_MODEL = 1024
BATCH = 8
SEQ = 8192
DEPTH = 1

CHUNK = 64
RET_HEADS = 4
RET_QK_DIM = 128
RET_V_DIM = D_MODEL // RET_HEADS
RET_QK_WIDTH = RET_HEADS * RET_QK_DIM
RET_V_WIDTH = RET_HEADS * RET_V_DIM
LRU_WIDTH = D_MODEL
LRU_BLOCKS = 8
LRU_BLOCK_DIM = LRU_WIDTH // LRU_BLOCKS
CONV_WIDTH = 4
RG_LRU_C = 8.0
ROPE_BASE = 10000.0
LN_EPS = 1e-5
DEEPNORM_ALPHA = (2.0 * DEPTH) ** 0.25
DEEPNORM_BETA = (8.0 * DEPTH) ** -0.25
IN_SPLITS = (RET_QK_WIDTH, RET_QK_WIDTH, RET_V_WIDTH, RET_V_WIDTH, LRU_WIDTH, LRU_WIDTH, D_MODEL, D_MODEL)
IN_WIDTH = sum(IN_SPLITS)

kernel_name = "hybrid_retention_rglru_gated_merge"


def layer_norm(x, g, b):
    xf = x.astype(jnp.float32)
    mu = jnp.mean(xf, axis=-1, keepdims=True)
    var = jnp.mean(jnp.square(xf - mu), axis=-1, keepdims=True)
    y = (xf - mu) * lax.rsqrt(var + LN_EPS)
    return (y * g.astype(jnp.float32) + b.astype(jnp.float32)).astype(x.dtype)


def rotary(x):
    s, d = x.shape[1], x.shape[-1]
    half = d // 2
    inv = ROPE_BASE ** (-2.0 * jnp.arange(half, dtype=jnp.float32) / d)
    ang = jnp.arange(s, dtype=jnp.float32)[:, None] * inv[None, :]
    cos = jnp.cos(ang)[None, :, None, :]
    sin = jnp.sin(ang)[None, :, None, :]
    xf = x.astype(jnp.float32)
    x1, x2 = xf[..., :half], xf[..., half:]
    return jnp.concatenate([x1 * cos - x2 * sin, x2 * cos + x1 * sin], axis=-1)


def chunk_retention(q, k, v):
    b, s, h, dk = q.shape
    dv = v.shape[-1]
    nc = s // CHUNK
    log_g = jnp.log1p(-jnp.exp2(-5.0 - jnp.arange(h, dtype=jnp.float32)))
    qc = q.reshape(b, nc, CHUNK, h, dk)
    kc = (k * (dk ** -0.5)).reshape(b, nc, CHUNK, h, dk)
    vc = v.astype(jnp.float32).reshape(b, nc, CHUNK, h, dv)
    pos = jnp.arange(CHUNK, dtype=jnp.float32)
    intra_decay = jnp.exp(log_g[:, None, None] * jnp.abs(pos[:, None] - pos[None, :]))
    scores = jnp.einsum('bnihd,bnjhd->bnhij', qc, kc) * intra_decay[None, None]
    o_intra = jnp.einsum('bnhij,bnjhe->bnihe', scores, vc)
    k_decay = jnp.exp((CHUNK - 1 - pos)[:, None] * log_g[None, :])
    kv = jnp.einsum('bnjhd,bnjhe,jh->nbhde', kc, vc, k_decay)
    chunk_decay = jnp.exp(log_g * CHUNK)[None, :, None, None]

    def step(state, kv_c):
        return state * chunk_decay + kv_c, state

    _, s_prev = lax.scan(step, jnp.zeros((b, h, dk, dv), jnp.float32), kv)
    q_decay = jnp.exp((pos + 1.0)[:, None] * log_g[None, :])
    o_inter = jnp.einsum('bnihd,nbhde,ih->bnihe', qc, s_prev, q_decay)
    return (o_intra + o_inter).reshape(b, s, h, dv)


def head_group_norm(o, g, bias):
    b, s, h, dv = o.shape
    mu = jnp.mean(o, axis=-1, keepdims=True)
    var = jnp.mean(jnp.square(o - mu), axis=-1, keepdims=True)
    y = ((o - mu) * lax.rsqrt(var + LN_EPS)).reshape(b, s, h * dv)
    return y * g.astype(jnp.float32) + bias.astype(jnp.float32)


def causal_depthwise_conv(x, w, bias):
    s = x.shape[1]
    xp = jnp.pad(x, ((0, 0), (CONV_WIDTH - 1, 0), (0, 0)))
    return bias + sum(xp[:, t:t + s] * w[t] for t in range(CONV_WIDTH))


def rg_lru(x, w_a, b_a, w_x, b_x, lam):
    b, s, w = x.shape
    xb = x.reshape(b, s, LRU_BLOCKS, LRU_BLOCK_DIM)
    r = jax.nn.sigmoid(jnp.einsum('bshi,hij->bshj', xb, w_a).reshape(b, s, w) + b_a)
    i = jax.nn.sigmoid(jnp.einsum('bshi,hij->bshj', xb, w_x).reshape(b, s, w) + b_x)
    log_a = -RG_LRU_C * r.astype(jnp.float32) * jax.nn.softplus(-lam.astype(jnp.float32))
    a = jnp.exp(log_a)
    u = jnp.sqrt(-jnp.expm1(2.0 * log_a)) * (i * x).astype(jnp.float32)

    def combine(left, right):
        a1, b1 = left
        a2, b2 = right
        return a1 * a2, a2 * b1 + b2

    _, hs = lax.associative_scan(combine, (a, u), axis=1)
    return hs.astype(x.dtype)


def setup_inputs(seed: int = 0) -> dict:
    key = jax.random.key(seed)
    ks = jax.random.split(key, 20)
    f32 = jnp.float32
    d = D_MODEL
    x = jax.random.normal(ks[0], (BATCH, SEQ, d), f32)
    ln_in_g = 1.0 + 0.02 * jax.random.normal(ks[1], (d,), f32)
    ln_in_b = 0.02 * jax.random.normal(ks[2], (d,), f32)
    col_scale = np.concatenate([np.full(n, DEEPNORM_BETA if idx == 2 else 1.0, np.float32)
                                for idx, n in enumerate(IN_SPLITS)])
    w_in = jax.random.normal(ks[3], (DEPTH, d, IN_WIDTH), f32) * (d ** -0.5) * jnp.asarray(col_scale)
    b_merge = 0.01 * jax.random.normal(ks[4], (DEPTH, 2, d), f32)
    ret_gn_g = 1.0 + 0.02 * jax.random.normal(ks[5], (DEPTH, RET_V_WIDTH), f32)
    ret_gn_b = 0.02 * jax.random.normal(ks[6], (DEPTH, RET_V_WIDTH), f32)
    w_ret_proj = jax.random.normal(ks[7], (DEPTH, RET_V_WIDTH, d), f32) * (RET_V_WIDTH ** -0.5) * DEEPNORM_BETA
    conv_w = jax.random.normal(ks[8], (DEPTH, CONV_WIDTH, LRU_WIDTH), f32) * (CONV_WIDTH ** -0.5)
    conv_b = 0.01 * jax.random.normal(ks[9], (DEPTH, LRU_WIDTH), f32)
    w_rg_a = jax.random.normal(ks[10], (DEPTH, LRU_BLOCKS, LRU_BLOCK_DIM, LRU_BLOCK_DIM), f32) * (LRU_BLOCK_DIM ** -0.5)
    b_rg_a = 0.01 * jax.random.normal(ks[11], (DEPTH, LRU_WIDTH), f32)
    w_rg_x = jax.random.normal(ks[12], (DEPTH, LRU_BLOCKS, LRU_BLOCK_DIM, LRU_BLOCK_DIM), f32) * (LRU_BLOCK_DIM ** -0.5)
    b_rg_x = 0.01 * jax.random.normal(ks[13], (DEPTH, LRU_WIDTH), f32)
    a0 = jax.random.uniform(ks[14], (DEPTH, LRU_WIDTH), f32, minval=0.9, maxval=0.999)
    a_base = a0 ** (1.0 / RG_LRU_C)
    lru_lambda = jnp.log(a_base) - jnp.log1p(-a_base)
    w_lru_proj = jax.random.normal(ks[15], (DEPTH, LRU_WIDTH, d), f32) * (LRU_WIDTH ** -0.5) * DEEPNORM_BETA
    w_out = jax.random.normal(ks[16], (DEPTH, d, d), f32) * (d ** -0.5) * DEEPNORM_BETA
    ln_out_g = 1.0 + 0.02 * jax.random.normal(ks[17], (DEPTH, d), f32)
    ln_out_b = 0.02 * jax.random.normal(ks[18], (DEPTH, d), f32)
    return {"x": x, "ln_in_g": ln_in_g, "ln_in_b": ln_in_b, "w_in": w_in, "b_merge": b_merge,
            "ret_gn_g": ret_gn_g, "ret_gn_b": ret_gn_b, "w_ret_proj": w_ret_proj,
            "conv_w": conv_w, "conv_b": conv_b, "w_rg_a": w_rg_a, "b_rg_a": b_rg_a,
            "w_rg_x": w_rg_x, "b_rg_x": b_rg_x, "lru_lambda": lru_lambda, "w_lru_proj": w_lru_proj,
            "w_out": w_out, "ln_out_g": ln_out_g, "ln_out_b": ln_out_b}


def reference(x, ln_in_g, ln_in_b, w_in, b_merge, ret_gn_g, ret_gn_b, w_ret_proj, conv_w, conv_b,
              w_rg_a, b_rg_a, w_rg_x, b_rg_x, lru_lambda, w_lru_proj, w_out, ln_out_g, ln_out_b):
    b, s, d = x.shape
    offsets = [int(c) for c in np.cumsum(IN_SPLITS)[:-1]]
    h = layer_norm(x, ln_in_g, ln_in_b)
    for layer in range(DEPTH):
        proj = h @ w_in[layer]
        q, k, v, g_ret, x_lru, g_lru, m_ret, m_lru = jnp.split(proj, offsets, axis=-1)
        qr = rotary(q.reshape(b, s, RET_HEADS, RET_QK_DIM))
        kr = rotary(k.reshape(b, s, RET_HEADS, RET_QK_DIM))
        ret = chunk_retention(qr, kr, v.reshape(b, s, RET_HEADS, RET_V_DIM))
        ret = head_group_norm(ret, ret_gn_g[layer], ret_gn_b[layer]).astype(h.dtype)
        ret_branch = (jax.nn.silu(g_ret) * ret) @ w_ret_proj[layer]
        xc = causal_depthwise_conv(x_lru, conv_w[layer], conv_b[layer])
        hl = rg_lru(xc, w_rg_a[layer], b_rg_a[layer], w_rg_x[layer], b_rg_x[layer], lru_lambda[layer])
        lru_branch = (jax.nn.silu(g_lru) * hl) @ w_lru_proj[layer]
        merged = (jax.nn.sigmoid(m_ret + b_merge[layer, 0]) * ret_branch
                  + jax.nn.sigmoid(m_lru + b_merge[layer, 1]) * lru_branch)
        y = merged @ w_out[layer]
        h = layer_norm(DEEPNORM_ALPHA * h + y, ln_out_g[layer], ln_out_b[layer])
    return h
```

```cpp
#include <hip/hip_runtime.h>
#include <cstdio>
#include <cstdint>
namespace pg8 {
#define PG8_LAS __attribute__((address_space(3)))
typedef unsigned short bf16_t;
typedef short bf16x8 __attribute__((ext_vector_type(8)));
typedef float f32x4 __attribute__((ext_vector_type(4)));
typedef unsigned u32x4 __attribute__((ext_vector_type(4)));
constexpr int BM = 256, BK = 64, HALF = 128, HTB = HALF * BK * 2  , STAGE_BYTES = 8 * HTB, NXCD = 8, WGM = 8;

__host__ __device__ __forceinline__ int lds_byte(int r, int c) { const int st = (r >> 4) * 2 + (c >> 5), rr = r & 15, cc = c & 31, ob = rr * 64 + cc * 2; return st * 1024 + (ob ^ (((ob >> 9) & 1) << 5)); }
__host__ __device__ __forceinline__ void stage_rc(int b, int& R, int& C) { const int st = b / 1024, sb = b % 1024, swz = sb ^ (((sb >> 9) & 1) << 5); R = (st >> 1) * 16 + swz / 64; C = (st & 1) * 32 + (swz % 64) / 2; }
__host__ __device__ __forceinline__ int perm32(int rho) { const int n = rho >> 4, i = rho & 15; return 8 * (i >> 2) + 4 * n + (i & 3); }

struct Unit { int pm, pn; };
struct Gemm { const bf16_t* A; const bf16_t* Bt; int M, N, K; int lda = 0, ldb = 0; };

struct StaticOrder {
    int nM, nN, nwg, G, c;
    __host__ __device__ void init(int M, int N, int G_, int c_) { nM = M / BM; nN = N / BM; nwg = nM * nN; G = G_; c = c_; }
    __host__ __device__ bool next(int i, Unit& u) const {
        const long L = (long)i * G + c; if (L >= nwg) return false;
        int wgid = (int)L; { const int q = nwg / NXCD, r = nwg % NXCD, xcd = wgid % NXCD, off = wgid / NXCD; wgid = (xcd < r ? xcd * (q + 1) : r * (q + 1) + (xcd - r) * q) + off; }
        const int nig = WGM * nN, gid = wgid / nig, fm = gid * WGM, gsz = (nM - fm) < WGM ? (nM - fm) : WGM;
        u.pm = fm + ((wgid % nig) % gsz); u.pn = (wgid % nig) / gsz; return true;
    }
    __device__ __forceinline__ void a_ready(const Unit&) const {}
    __device__ __forceinline__ void done(const Unit&) const {}
};

__device__ __forceinline__ unsigned cvt_pk_bf16(float lo, float hi) { unsigned r; asm volatile("v_cvt_pk_bf16_f32 %0, %1, %2" : "=v"(r) : "v"(lo), "v"(hi)); return r; }
typedef unsigned u32x2 __attribute__((ext_vector_type(2)));
__device__ __forceinline__ float bf_lo(unsigned w) { return __builtin_bit_cast(float, w << 16); }
__device__ __forceinline__ float bf_hi(unsigned w) { return __builtin_bit_cast(float, w & 0xffff0000u); }
__device__ __forceinline__ float fast_sigmoid(float x) { return __builtin_amdgcn_rcpf(1.0f + __builtin_amdgcn_exp2f(-1.4426950408889634f * x)); }

struct EpiF32 {
    static constexpr bool PERM = false, AFTER_DRAIN = false;
    float* C; int ldc;
    __device__ __forceinline__ void operator()(const f32x4 (&acc)[2][2][4][2], const Unit& u, int wr, int wc, int fr, int fq) const {
        const int row0 = u.pm * BM + wr * 64 + fr, col0 = u.pn * BM + wc * 32 + 4 * fq;
#pragma unroll
        for (int ai = 0; ai < 2; ++ai)
#pragma unroll
            for (int m = 0; m < 4; ++m) { float* rowp = C + (size_t)(row0 + ai * HALF + m * 16) * ldc + col0;
#pragma unroll
                for (int bj = 0; bj < 2; ++bj)
#pragma unroll
                    for (int n = 0; n < 2; ++n) *(f32x4*)(rowp + bj * HALF + n * 16) = acc[ai][bj][m][n]; }
    }
};
struct EpiGateF32 {
    static constexpr bool PERM = false, AFTER_DRAIN = false;
    float* C; const bf16_t* G; int ldc;
    __device__ __forceinline__ void operator()(const f32x4 (&acc)[2][2][4][2], const Unit& u, int wr, int wc, int fr, int fq) const {
        const int row0 = u.pm * BM + wr * 64 + fr, col0 = u.pn * BM + wc * 32 + 4 * fq;
#pragma unroll
        for (int ai = 0; ai < 2; ++ai)
#pragma unroll
            for (int m = 0; m < 4; ++m) { const size_t off = (size_t)(row0 + ai * HALF + m * 16) * ldc + col0;
#pragma unroll
                for (int bj = 0; bj < 2; ++bj)
#pragma unroll
                    for (int n = 0; n < 2; ++n) { const u32x2 g = *(const u32x2*)(G + off + bj * HALF + n * 16); const f32x4 a = acc[ai][bj][m][n];
                        f32x4 o; o[0] = bf_lo(g.x) * a[0]; o[1] = bf_hi(g.x) * a[1]; o[2] = bf_lo(g.y) * a[2]; o[3] = bf_hi(g.y) * a[3];
                        *(f32x4*)(C + off + bj * HALF + n * 16) = o; } }
    }
};
struct EpiMerge {
    static constexpr bool PERM = true, AFTER_DRAIN = false;
    bf16_t* O; const float* T1; const bf16_t* G; int ldc;
    __device__ __forceinline__ void operator()(const f32x4 (&acc)[2][2][4][2], const Unit& u, int wr, int wc, int fr, int fq) const {
        const int row0 = u.pm * BM + wr * 64 + fr, col0 = u.pn * BM + wc * 32 + 8 * fq;
#pragma unroll
        for (int ai = 0; ai < 2; ++ai)
#pragma unroll
            for (int m = 0; m < 4; ++m) { const size_t off = (size_t)(row0 + ai * HALF + m * 16) * ldc + col0;
#pragma unroll
                for (int bj = 0; bj < 2; ++bj) { const u32x4 g = *(const u32x4*)(G + off + bj * HALF);
                    const f32x4 t0 = *(const f32x4*)(T1 + off + bj * HALF), t1 = *(const f32x4*)(T1 + off + bj * HALF + 4);
                    const f32x4 a0 = acc[ai][bj][m][0], a1 = acc[ai][bj][m][1];
                    u32x4 w;
                    w.x = cvt_pk_bf16(t0[0] + bf_lo(g.x) * a0[0], t0[1] + bf_hi(g.x) * a0[1]);
                    w.y = cvt_pk_bf16(t0[2] + bf_lo(g.y) * a0[2], t0[3] + bf_hi(g.y) * a0[3]);
                    w.z = cvt_pk_bf16(t1[0] + bf_lo(g.z) * a1[0], t1[1] + bf_hi(g.z) * a1[1]);
                    w.w = cvt_pk_bf16(t1[2] + bf_lo(g.w) * a1[2], t1[3] + bf_hi(g.w) * a1[3]);
                    *(u32x4*)(O + off + bj * HALF) = w; } }
    }
};
struct EpiIn {
    static constexpr bool PERM = true, AFTER_DRAIN = false;
    bf16_t *Q, *Kb, *V, *SGR, *XL, *SGL, *GR, *GL; const float* rope; const float* bmerge;
    __device__ __forceinline__ void operator()(const f32x4 (&acc)[2][2][4][2], const Unit& u, int wr, int wc, int fr, int fq) const {
        const int row0 = u.pm * BM + wr * 64 + fr; const int pn = u.pn;
        if (pn < 4) {
            bf16_t* base = (pn < 2) ? Q : Kb; const int head = 2 * (pn & 1) + (wc >> 1), i0 = 32 * (wc & 1) + 8 * fq;
#pragma unroll
            for (int ai = 0; ai < 2; ++ai)
#pragma unroll
                for (int m = 0; m < 4; ++m) { const int row = row0 + ai * HALF + m * 16, pos = row & 8191;
                    const f32x4* cs = (const f32x4*)(rope + ((size_t)pos * 64 + i0) * 2);
                    const f32x4 c0 = cs[0], c1 = cs[1], c2 = cs[2], c3 = cs[3];
                    const f32x4 xa = acc[ai][0][m][0], xb = acc[ai][0][m][1], ya = acc[ai][1][m][0], yb = acc[ai][1][m][1];
                    u32x4 o1, o2;
                    o1.x = cvt_pk_bf16(xa[0] * c0[0] - ya[0] * c0[1], xa[1] * c0[2] - ya[1] * c0[3]);
                    o1.y = cvt_pk_bf16(xa[2] * c1[0] - ya[2] * c1[1], xa[3] * c1[2] - ya[3] * c1[3]);
                    o1.z = cvt_pk_bf16(xb[0] * c2[0] - yb[0] * c2[1], xb[1] * c2[2] - yb[1] * c2[3]);
                    o1.w = cvt_pk_bf16(xb[2] * c3[0] - yb[2] * c3[1], xb[3] * c3[2] - yb[3] * c3[3]);
                    o2.x = cvt_pk_bf16(ya[0] * c0[0] + xa[0] * c0[1], ya[1] * c0[2] + xa[1] * c0[3]);
                    o2.y = cvt_pk_bf16(ya[2] * c1[0] + xa[2] * c1[1], ya[3] * c1[2] + xa[3] * c1[3]);
                    o2.z = cvt_pk_bf16(yb[0] * c2[0] + xb[0] * c2[1], yb[1] * c2[2] + xb[1] * c2[3]);
                    o2.w = cvt_pk_bf16(yb[2] * c3[0] + xb[2] * c3[1], yb[3] * c3[2] + xb[3] * c3[3]);
                    bf16_t* rp = base + (size_t)row * 512 + head * 128 + i0;
                    *(u32x4*)rp = o1; *(u32x4*)(rp + 64) = o2; }
        } else {
            const int ty = (pn - 4) >> 2, colt = ((pn - 4) & 3) * BM, col0 = colt + wc * 32 + 8 * fq;
            bf16_t* base = ty == 0 ? V : ty == 1 ? SGR : ty == 2 ? XL : ty == 3 ? SGL : ty == 4 ? GR : GL;
            f32x4 bv[2][2];
#pragma unroll
            for (int bj = 0; bj < 2; ++bj)
#pragma unroll
                for (int n = 0; n < 2; ++n) bv[bj][n] = (ty >= 4) ? *(const f32x4*)(bmerge + (ty - 4) * 1024 + col0 + bj * HALF + 4 * n) : (f32x4){0.f, 0.f, 0.f, 0.f};
#pragma unroll
            for (int ai = 0; ai < 2; ++ai)
#pragma unroll
                for (int m = 0; m < 4; ++m) { bf16_t* rowp = base + (size_t)(row0 + ai * HALF + m * 16) * 1024 + col0;
#pragma unroll
                    for (int bj = 0; bj < 2; ++bj) { f32x4 v0 = acc[ai][bj][m][0] + bv[bj][0], v1 = acc[ai][bj][m][1] + bv[bj][1];
                        if (ty == 1 || ty == 3) {
#pragma unroll
                            for (int j = 0; j < 4; ++j) { v0[j] = v0[j] * fast_sigmoid(v0[j]); v1[j] = v1[j] * fast_sigmoid(v1[j]); } }
                        if (ty >= 4) {
#pragma unroll
                            for (int j = 0; j < 4; ++j) { v0[j] = fast_sigmoid(v0[j]); v1[j] = fast_sigmoid(v1[j]); } }
                        u32x4 w; w.x = cvt_pk_bf16(v0[0], v0[1]); w.y = cvt_pk_bf16(v0[2], v0[3]); w.z = cvt_pk_bf16(v1[0], v1[1]); w.w = cvt_pk_bf16(v1[2], v1[3]);
                        *(u32x4*)(rowp + bj * HALF) = w; } }
        }
    }
};

template <class Epi, class Sched, bool ALIGN_EPI = false, bool SP2 = false>
__device__ __forceinline__ void gemm_phase(PG8_LAS unsigned char* lds, const Gemm g, const Sched& S, const Epi& E) {
    const int tid = threadIdx.x, wid = __builtin_amdgcn_readfirstlane(tid >> 6), lane = tid & 63, wr = wid >> 2, wc = wid & 3, fr = lane & 15, fq = lane >> 4;
    const int K = g.K, nt = K / BK, lda = g.lda ? g.lda : K, ldb = g.ldb ? g.ldb : K;
    unsigned voffA[2], voffB[2];
#pragma unroll
    for (int i = 0; i < 2; ++i) { int R, C; stage_rc(tid * 16 + i * 8192, R, C); const int Rb = Epi::PERM ? ((R & ~31) + perm32(R & 31)) : R;
        voffA[i] = (unsigned)(R * lda + C) * 2u; voffB[i] = (unsigned)(Rb * ldb + C) * 2u; }
    const size_t kstep = (size_t)(BK * 2);
    const size_t hstepA = (size_t)HALF * lda * 2, hstepB = (size_t)HALF * ldb * 2;
    const size_t tstepA = 2 * hstepA, tstepB = 2 * hstepB;
    const unsigned ldsw = (unsigned)wid * 1024u;
    const int aoff = lds_byte(wr * 64 + fr, fq * 8), boff = lds_byte(wc * 32 + fr, fq * 8);
#define PG8_SA(b, h) (((b) * 2 + (h)) * HTB)
#define PG8_SB(b, h) ((4 + (b) * 2 + (h)) * HTB)
#define PG8_STAGE(bufoff, gbase, voff) do { _Pragma("unroll") for (int _i = 0; _i < 2; ++_i) \
        __builtin_amdgcn_global_load_lds((const unsigned*)((const char*)(gbase) + (voff)[_i]), (PG8_LAS unsigned*)(lds + (bufoff) + ldsw + _i * 8192), 16, 0, 0); } while (0)
#define PG8_LDA(dst, b, h) do { _Pragma("unroll") for (int m = 0; m < 4; ++m) _Pragma("unroll") for (int k = 0; k < 2; ++k) dst[m][k] = *(const PG8_LAS bf16x8*)(lds + PG8_SA(b, h) + aoff + m * 2048 + k * 1024); } while (0)
#define PG8_LDB(dst, b, h) do { _Pragma("unroll") for (int n = 0; n < 2; ++n) _Pragma("unroll") for (int k = 0; k < 2; ++k) dst[n][k] = *(const PG8_LAS bf16x8*)(lds + PG8_SB(b, h) + boff + n * 2048 + k * 1024); } while (0)
#define PG8_MMA(ai, bj, At, Bt) do { __builtin_amdgcn_s_setprio(1); _Pragma("unroll") for (int m = 0; m < 4; ++m) _Pragma("unroll") for (int n = 0; n < 2; ++n) _Pragma("unroll") for (int k = 0; k < 2; ++k) \
        acc[ai][bj][m][n] = __builtin_amdgcn_mfma_f32_16x16x32_bf16(Bt[n][k], At[m][k], acc[ai][bj][m][n], 0, 0, 0); __builtin_amdgcn_s_setprio(0); } while (0)
#define PG8_WAIT_V(n) asm volatile("s_waitcnt vmcnt(" #n ")" ::: "memory")
#define PG8_WAIT_L(n) asm volatile("s_waitcnt lgkmcnt(" #n ")" ::: "memory")
#define PG8_BAR __builtin_amdgcn_s_barrier()
#define PG8_SCHED __builtin_amdgcn_sched_barrier(0)
    Unit cur, nxt; int ui = 0;
    if (!S.next(0, cur)) return;
    f32x4 acc[2][2][4][2];
#pragma unroll
    for (int a = 0; a < 2; ++a)
#pragma unroll
        for (int b = 0; b < 2; ++b)
#pragma unroll
            for (int m = 0; m < 4; ++m)
#pragma unroll
                for (int n = 0; n < 2; ++n) acc[a][b][m][n] = (f32x4){0.f, 0.f, 0.f, 0.f};
    bf16x8 At[4][2], B0[2][2], B1[2][2];
    const char* cA = (const char*)g.A + (size_t)cur.pm * tstepA; const char* cB = (const char*)g.Bt + (size_t)cur.pn * tstepB;
    S.a_ready(cur);
    if constexpr (SP2) {
        PG8_STAGE(PG8_SB(0, 0), cB, voffB); PG8_STAGE(PG8_SB(0, 1), cB + hstepB, voffB); PG8_STAGE(PG8_SA(0, 0), cA, voffA); PG8_STAGE(PG8_SA(0, 1), cA + hstepA, voffA);
        if (wr == 1) PG8_BAR;
        PG8_WAIT_V(2); PG8_BAR;
        PG8_STAGE(PG8_SB(1, 0), cB + kstep, voffB); PG8_STAGE(PG8_SA(1, 0), cA + kstep, voffA); PG8_STAGE(PG8_SB(1, 1), cB + hstepB + kstep, voffB);
        PG8_WAIT_V(6); PG8_BAR;
    } else {
        PG8_STAGE(PG8_SB(0, 0), cB, voffB); PG8_STAGE(PG8_SA(0, 0), cA, voffA); PG8_STAGE(PG8_SB(0, 1), cB + hstepB, voffB); PG8_STAGE(PG8_SA(0, 1), cA + hstepA, voffA);
        if (wr == 1) PG8_BAR;
        PG8_WAIT_V(4); PG8_BAR;
        PG8_STAGE(PG8_SB(1, 0), cB + kstep, voffB); PG8_STAGE(PG8_SA(1, 0), cA + kstep, voffA); PG8_STAGE(PG8_SB(1, 1), cB + hstepB + kstep, voffB);
        PG8_WAIT_V(6); PG8_BAR;
    }
    for (;;) {
        const bool has_next = S.next(ui + 1, nxt);
        const char* nA = has_next ? (const char*)g.A + (size_t)nxt.pm * tstepA : cA; const char* nB = has_next ? (const char*)g.Bt + (size_t)nxt.pn * tstepB : cB;
        for (int t = 0; t < nt; t += 2) {
            const bool last = (t == nt - 2);
            const char* a1 = cA + (size_t)(t + 1) * kstep;
            const char* a2 = last ? nA : cA + (size_t)(t + 2) * kstep; const char* b2 = last ? nB : cB + (size_t)(t + 2) * kstep;
            const char* a3 = a2 + kstep; const char* b3 = b2 + kstep;
            if (last && has_next) S.a_ready(nxt);
            if constexpr (SP2) {
            PG8_LDB(B0, 0, 0); PG8_LDB(B1, 0, 1); PG8_SCHED; PG8_LDA(At, 0, 0); PG8_STAGE(PG8_SA(1, 1), a1 + hstepA, voffA);
            PG8_WAIT_V(8); PG8_WAIT_L(0); PG8_BAR; PG8_MMA(0, 0, At, B0); PG8_MMA(0, 1, At, B1); PG8_BAR; PG8_SCHED;
            PG8_LDA(At, 0, 1); PG8_STAGE(PG8_SB(0, 0), b2, voffB); PG8_STAGE(PG8_SB(0, 1), b2 + hstepB, voffB); PG8_STAGE(PG8_SA(0, 0), a2, voffA);
            PG8_WAIT_V(8); PG8_WAIT_L(0); PG8_BAR; PG8_MMA(1, 0, At, B0); PG8_MMA(1, 1, At, B1); PG8_BAR; PG8_SCHED;
            PG8_LDB(B0, 1, 0); PG8_LDB(B1, 1, 1); PG8_SCHED; PG8_LDA(At, 1, 0); PG8_STAGE(PG8_SA(0, 1), a2 + hstepA, voffA);
            PG8_WAIT_V(8); PG8_WAIT_L(0); PG8_BAR; PG8_MMA(0, 0, At, B0); PG8_MMA(0, 1, At, B1); PG8_BAR; PG8_SCHED;
            PG8_LDA(At, 1, 1); PG8_STAGE(PG8_SB(1, 0), b3, voffB); PG8_STAGE(PG8_SB(1, 1), b3 + hstepB, voffB); PG8_STAGE(PG8_SA(1, 0), a3, voffA);
            PG8_WAIT_V(8); PG8_WAIT_L(0); PG8_BAR; PG8_MMA(1, 0, At, B0); PG8_MMA(1, 1, At, B1); PG8_BAR; PG8_SCHED;
            } else {
            PG8_LDB(B0, 0, 0); PG8_SCHED; PG8_LDA(At, 0, 0); PG8_STAGE(PG8_SA(1, 1), a1 + hstepA, voffA);
            PG8_WAIT_L(8); PG8_BAR; PG8_WAIT_L(0); PG8_MMA(0, 0, At, B0); PG8_BAR; PG8_SCHED;
            PG8_LDB(B1, 0, 1); PG8_STAGE(PG8_SB(0, 0), b2, voffB);
            PG8_BAR; PG8_WAIT_L(0); PG8_MMA(0, 1, At, B1); PG8_BAR;
            PG8_LDA(At, 0, 1); PG8_STAGE(PG8_SA(0, 0), a2, voffA);
            PG8_BAR; PG8_WAIT_L(0); PG8_MMA(1, 0, At, B0); PG8_BAR; PG8_SCHED;
            PG8_STAGE(PG8_SB(0, 1), b2 + hstepB, voffB);
            PG8_WAIT_V(6); PG8_BAR; PG8_MMA(1, 1, At, B1); PG8_BAR;
            PG8_LDB(B0, 1, 0); PG8_SCHED; PG8_LDA(At, 1, 0); PG8_STAGE(PG8_SA(0, 1), a2 + hstepA, voffA);
            PG8_WAIT_L(8); PG8_BAR; PG8_WAIT_L(0); PG8_MMA(0, 0, At, B0); PG8_BAR; PG8_SCHED;
            PG8_LDB(B1, 1, 1); PG8_STAGE(PG8_SB(1, 0), b3, voffB);
            PG8_BAR; PG8_WAIT_L(0); PG8_MMA(0, 1, At, B1); PG8_BAR;
            PG8_LDA(At, 1, 1); PG8_STAGE(PG8_SA(1, 0), a3, voffA);
            PG8_BAR; PG8_WAIT_L(0); PG8_MMA(1, 0, At, B0); PG8_BAR; PG8_SCHED;
            PG8_STAGE(PG8_SB(1, 1), b3 + hstepB, voffB);
            PG8_WAIT_V(6); PG8_BAR; PG8_MMA(1, 1, At, B1); PG8_BAR;
            }
        }
        if constexpr (ALIGN_EPI) { if (wr == 0) PG8_BAR; }
        if constexpr (!Epi::AFTER_DRAIN) { E(acc, cur, wr, wc, fr, fq); S.done(cur); }
        if (!has_next) break;
#pragma unroll
        for (int a = 0; a < 2; ++a)
#pragma unroll
            for (int b = 0; b < 2; ++b)
#pragma unroll
                for (int m = 0; m < 4; ++m)
#pragma unroll
                    for (int n = 0; n < 2; ++n) acc[a][b][m][n] = (f32x4){0.f, 0.f, 0.f, 0.f};
        cur = nxt; cA = nA; cB = nB; ++ui;
        if constexpr (ALIGN_EPI) { if (wr == 1) PG8_BAR; }
    }
    PG8_WAIT_V(0);
    if constexpr (!ALIGN_EPI) { if (wr == 0) PG8_BAR; }
    PG8_BAR;
    if constexpr (Epi::AFTER_DRAIN) { E.fused(acc, cur, wr, wc, fr, fq, lds, wid, lane); S.done(cur); }
#undef PG8_SA
#undef PG8_SB
#undef PG8_STAGE
#undef PG8_LDA
#undef PG8_LDB
#undef PG8_MMA
#undef PG8_WAIT_V
#undef PG8_WAIT_L
#undef PG8_BAR
#undef PG8_SCHED
}
}

#ifndef PG8_SP2
#define PG8_SP2 true
#endif
#ifndef PG8_ALIGN
#define PG8_ALIGN true
#endif

constexpr int NWAVES = 8;
#ifndef MK_ONE_LAUNCH
#define MK_ONE_LAUNCH 0
#endif
constexpr int NPHASES = 8;

constexpr int BATCH = 8, SEQ = 8192, D = 1024, M = BATCH * SEQ, NIN = 7168;
constexpr int RH = 4, DK = 128, DV = 256, CH = 64, NCH = SEQ / CH;
constexpr float LN_EPS = 1e-5f;
constexpr float DN_ALPHA = 1.189207115002721f;

constexpr size_t MiB = 1u << 20;
constexpr size_t WS_CTL = 0, CTL_ZERO_BYTES = 1 * MiB;
constexpr size_t WS_WIN = 2 * MiB;
constexpr size_t WS_PCAT = 16 * MiB;
constexpr size_t WS_WOUT = 20 * MiB;
constexpr size_t WS_ROPE = 22 * MiB;
constexpr size_t WS_Q = 32 * MiB, WS_K = 96 * MiB, WS_V = 160 * MiB, WS_SGR = 288 * MiB, WS_XL = 416 * MiB, WS_SGL = 544 * MiB, WS_GR = 672 * MiB, WS_GL = 800 * MiB, WS_END = 928 * MiB;
constexpr size_t WS_MERGED = WS_Q;
constexpr int CW_TMO = 0, CW_CODE = 1, CW_BAR = 4096;

constexpr int RING_OFF = 0, RING_BYTES = 131072;
constexpr int LDSCTL_OFF = RING_BYTES, MISC_OFF = LDSCTL_OFF + 320;
constexpr int LDS_BYTES = 147456;
static_assert(MISC_OFF + 128 <= LDS_BYTES, "LDS map");

#define GAS __attribute__((address_space(1)))
#define LAS __attribute__((address_space(3)))
typedef unsigned short bf16;
typedef unsigned v4u __attribute__((ext_vector_type(4)));
typedef unsigned v2u __attribute__((ext_vector_type(2)));
typedef float f32x4 __attribute__((ext_vector_type(4)));
typedef GAS unsigned gu32;
#define RLX_AGENT __ATOMIC_RELAXED, __HIP_MEMORY_SCOPE_AGENT
#define LDS_WAIT() asm volatile("s_waitcnt lgkmcnt(0)" ::: "memory")
#define VM_WAIT() asm volatile("s_waitcnt vmcnt(0)" ::: "memory")
__device__ __forceinline__ unsigned f2bf(float f) { unsigned u = __builtin_bit_cast(unsigned, f); return (u + 0x7fffu + ((u >> 16) & 1u)) >> 16; }
__device__ __forceinline__ unsigned pk2(float lo, float hi) { return f2bf(lo) | (f2bf(hi) << 16); }
__device__ __forceinline__ float bflo(unsigned w) { return __builtin_bit_cast(float, w << 16); }
__device__ __forceinline__ float bfhi(unsigned w) { return __builtin_bit_cast(float, w & 0xffff0000u); }
__device__ __forceinline__ float bf2f(bf16 b) { return __builtin_bit_cast(float, ((unsigned)b) << 16); }

#define XB_TMO      128
#define XB_XCNT(j)  (256  + 64 * (j))
#define XB_XSUB(j)  (1280 + 64 * (j))
#define XB_XGEN(j)  (2304 + 64 * (j))
#define XB_TOP      3328
#define XB_TOPGEN   3392
#define XCD_BAR_WORDS 3456
#define XB_SPIN_CAP (1u << 18)

__device__ __forceinline__ unsigned xb_ld(unsigned* p)              { return __hip_atomic_load(p, __ATOMIC_RELAXED, __HIP_MEMORY_SCOPE_AGENT); }
__device__ __forceinline__ unsigned xb_add(unsigned* p, unsigned v) { return __hip_atomic_fetch_add(p, v, __ATOMIC_RELAXED, __HIP_MEMORY_SCOPE_AGENT); }
__device__ __forceinline__ unsigned xb_xcc_id() { return (unsigned)__builtin_amdgcn_s_getreg((3 << 11) | 20) & 0xFu; }
#define XB_SPIN(cond, bar) do { unsigned _sp = 0; while (cond) { __builtin_amdgcn_s_sleep(1); \
    if ((++_sp & 255u) == 0u) { if (xb_ld(&(bar)[XB_TMO])) break; if (_sp > XB_SPIN_CAP) { atomicAdd(&(bar)[XB_TMO], 1u); break; } } } } while (0)

struct XcdBarrier {
    unsigned* bar; unsigned x;
    volatile LAS unsigned* st;
};

__device__ __forceinline__ XcdBarrier xcd_barrier_post(unsigned* bar, volatile LAS unsigned* st) {
    XcdBarrier b; b.bar = bar; b.x = xb_xcc_id(); b.st = st;
    if (threadIdx.x == 0) (void)xb_add(&bar[XB_XCNT(b.x)], 1u);
    return b;
}
__device__ __forceinline__ void xcd_barrier_complete(unsigned* bar, unsigned x, unsigned& nloc, unsigned& nx) {
    const unsigned G = gridDim.x * gridDim.y * gridDim.z;
    unsigned sum, cnt, mine, sp = 0u;
    for (;;) {
        sum = 0u; cnt = 0u; mine = 0u;
#pragma unroll
        for (unsigned j = 0; j < 16; ++j) { const unsigned c = xb_ld(&bar[XB_XCNT(j)]); sum += c; cnt += (c > 0u) ? 1u : 0u; mine = (j == x) ? c : mine; }
        if (sum == G) break;
        __builtin_amdgcn_s_sleep(1);
        if ((++sp & 255u) == 0u) { if (xb_ld(&bar[XB_TMO])) break; if (sp > XB_SPIN_CAP) { atomicAdd(&bar[XB_TMO], 1u); break; } }
    }
    nloc = mine > 0u ? mine : 1u; nx = cnt > 0u ? cnt : 1u;
}

__device__ __forceinline__ void xcd_barrier(const XcdBarrier& b) {
    asm volatile("s_waitcnt vmcnt(0)" ::: "memory");
    __syncthreads();
    if (threadIdx.x == 0) {
        unsigned* bar = b.bar;
        __builtin_amdgcn_s_waitcnt(0);
        unsigned nloc = b.st[0], nx = b.st[1];
        if (nloc == 0u) { xcd_barrier_complete(bar, b.x, nloc, nx); b.st[0] = nloc; b.st[1] = nx; }
        const unsigned old = xb_add(&bar[XB_XSUB(b.x)], 1u);
        const unsigned gen = old / nloc;
        if (old + 1u == (gen + 1u) * nloc) {
            __builtin_amdgcn_fence(__ATOMIC_RELEASE, "agent");
            asm volatile("s_waitcnt vmcnt(0)" ::: "memory");
            const unsigned og = xb_add(&bar[XB_TOP], 1u);
            const unsigned tg = og / nx;
            if (og + 1u == (tg + 1u) * nx) xb_add(&bar[XB_TOPGEN], 1u);
            else XB_SPIN(xb_ld(&bar[XB_TOPGEN]) == tg, bar);
            __builtin_amdgcn_fence(__ATOMIC_ACQUIRE, "agent");
            xb_add(&bar[XB_XGEN(b.x)], 1u);
            asm volatile("s_waitcnt vmcnt(0)" ::: "memory");
        } else {
            XB_SPIN(xb_ld(&bar[XB_XGEN(b.x)]) == gen, bar);
            __builtin_amdgcn_fence(__ATOMIC_ACQUIRE, "agent");
            asm volatile("s_waitcnt vmcnt(0)" ::: "memory");
        }
    }
    __syncthreads();
}

struct Frame {
    LAS unsigned char* lds;
    volatile LAS unsigned* MISC;
    gu32* ctl;
    int tid, lane, wave;
    int vcu, G;
    const float* x; float* out;
    const float *ln_in_g, *ln_in_b, *w_in, *b_merge, *gn_g, *gn_b, *w_ret, *conv_w, *conv_b, *w_rg_a, *b_rg_a, *w_rg_x, *b_rg_x, *lam, *w_lru, *w_out, *ln_out_g, *ln_out_b;
    bf16 *WinT, *PcatT, *WoutT; float* rope;
    bf16 *Q, *K, *V, *SGR, *XL, *SGL, *GR, *GL, *MERGED, *XN;
};

__device__ __forceinline__ float wave_sum(float v) {
#pragma unroll
    for (int o = 1; o < 64; o <<= 1) v += __shfl_xor(v, o);
    return v;
}
__device__ __forceinline__ int win_dest_row(int c) {
    if (c >= 1024) return c;
    const int blk = c >> 9, cc = c & 511, head = cc >> 7, idx = cc & 127, bj = idx >> 6, i = idx & 63;
    return blk * 512 + (head >> 1) * 256 + 128 * bj + (head & 1) * 64 + i;
}
template <bool WIN>
__device__ __forceinline__ void p0_transpose_item(const float* W, int ldw, bf16* WT, int ldt, int koff, LAS float* scr, int k0, int n0, int lane) {
#pragma unroll 8
    for (int i = 0; i < 32; ++i) { const int kk = 2 * i + (lane >> 5); scr[kk * 33 + (lane & 31)] = W[(size_t)(k0 + kk) * ldw + n0 + (lane & 31)]; }
    LDS_WAIT(); asm volatile("" ::: "memory");
    const int c = lane & 7;
#pragma unroll
    for (int j = 0; j < 4; ++j) { const int n = (lane >> 3) + 8 * j; const LAS float* s = scr + (8 * c) * 33 + n;
        const int col = n0 + n; const int drow = WIN ? win_dest_row(col) : col;
        const float sc = (WIN && col >= 512 && col < 1024) ? 0.08838834764831845f : 1.0f;
        v4u o; o.x = pk2(s[0 * 33] * sc, s[1 * 33] * sc); o.y = pk2(s[2 * 33] * sc, s[3 * 33] * sc); o.z = pk2(s[4 * 33] * sc, s[5 * 33] * sc); o.w = pk2(s[6 * 33] * sc, s[7 * 33] * sc);
        *(GAS v4u*)(WT + (size_t)drow * ldt + koff + k0 + 8 * c) = o; }
    LDS_WAIT(); asm volatile("" ::: "memory");
}
__device__ __forceinline__ void p0_prologue(Frame& F) {
    LAS float* scr = (LAS float*)(F.lds + RING_OFF + F.wave * 16384);
    const int gw = F.vcu * NWAVES + F.wave, NGW = F.G * NWAVES;
    constexpr int I_IN = (D / 64) * (NIN / 32), I_SQ = (D / 64) * (D / 32);
    constexpr int NITEMS = I_IN + 3 * I_SQ;
    for (int it = gw; it < NITEMS; it += NGW) {
        int r = it;
        if (r < I_IN) { const int nblk = NIN / 32; p0_transpose_item<true>(F.w_in, NIN, F.WinT, D, 0, scr, 64 * (r / nblk), 32 * (r % nblk), F.lane); continue; } r -= I_IN;
        const int nblk = D / 32, k0 = 64 * ((r % I_SQ) / nblk), n0 = 32 * ((r % I_SQ) % nblk);
        if (r < I_SQ) { p0_transpose_item<false>(F.w_ret, D, F.PcatT, 2 * D, 0, scr, k0, n0, F.lane); continue; }
        if (r < 2 * I_SQ) { p0_transpose_item<false>(F.w_lru, D, F.PcatT, 2 * D, D, scr, k0, n0, F.lane); continue; }
        p0_transpose_item<false>(F.w_out, D, F.WoutT, D, 0, scr, k0, n0, F.lane);
    }
    for (int e = (F.vcu * NWAVES * 64) + F.tid; e < SEQ * 64; e += F.G * NWAVES * 64) {
        const int pos = e >> 6, i = e & 63;
        const double inv = exp(-(double)i * (9.210340371976184 / 64.0));
        const double ang = (double)pos * inv;
        const double n = rint(ang * 0.15915494309189535);
        double r = fma(-n, 6.283185307179586, ang); r = fma(-n, 2.4492935982947064e-16, r);
        const float rf = (float)r;
        typedef float f32x2 __attribute__((ext_vector_type(2)));
        f32x2 cs; cs.x = cosf(rf); cs.y = sinf(rf);
        *(GAS f32x2*)((GAS float*)F.rope + (size_t)e * 2) = cs;
    }
    f32x4 gv[4], bv[4];
#pragma unroll
    for (int j = 0; j < 4; ++j) { gv[j] = *((const GAS f32x4*)F.ln_in_g + F.lane + 64 * j); bv[j] = *((const GAS f32x4*)F.ln_in_b + F.lane + 64 * j); }
    for (int m = gw; m < M; m += NGW) {
        const GAS f32x4* xr = (const GAS f32x4*)(F.x + (size_t)m * D) + F.lane;
        f32x4 v[4]; float s = 0.f;
#pragma unroll
        for (int j = 0; j < 4; ++j) { v[j] = xr[64 * j]; s += (v[j].x + v[j].y) + (v[j].z + v[j].w); }
        const float mean = wave_sum(s) * (1.f / D); float s2 = 0.f;
#pragma unroll
        for (int j = 0; j < 4; ++j) { v[j] = v[j] - mean; s2 += (v[j].x * v[j].x + v[j].y * v[j].y) + (v[j].z * v[j].z + v[j].w * v[j].w); }
        const float rstd = 1.f / sqrtf(wave_sum(s2) * (1.f / D) + LN_EPS);
        GAS v2u* o8 = (GAS v2u*)(F.XN + (size_t)m * D) + F.lane;
#pragma unroll
        for (int j = 0; j < 4; ++j) { const f32x4 y = v[j] * rstd * gv[j] + bv[j]; v2u w; w.x = pk2(y.x, y.y); w.y = pk2(y.z, y.w); o8[64 * j] = w; }
    }
}

__device__ __forceinline__ void ret_simple(Frame& F, int item, float* RAW) {
    const int b = item >> 5, h = (item >> 3) & 3, es = item & 7, t = F.tid;
    LAS float* Qs = (LAS float*)(F.lds);
    LAS float* Ks = Qs + 64 * 129;
    LAS float* Vs = Ks + 64 * 129;
    LAS float* Ps = Vs + 64 * 32;
    LAS float* Ss = Ps + 64 * 65;
    const float lg = log1pf(-exp2f(-5.f - (float)h));
    for (int i = t; i < 128 * 32; i += 512) Ss[i] = 0.f;
    const float cdec = expf(lg * 64.f);
    for (int c = 0; c < NCH; ++c) {
        const size_t m0 = (size_t)b * SEQ + (size_t)c * CH;
        __syncthreads();
#pragma unroll
        for (int k = 0; k < 2; ++k) { const int id = t + 512 * k, row = id >> 4, c8 = id & 15;
            const v4u q = *(const GAS v4u*)(F.Q + (m0 + row) * 512 + h * 128 + c8 * 8), kk = *(const GAS v4u*)(F.K + (m0 + row) * 512 + h * 128 + c8 * 8);
            LAS float* qd = Qs + row * 129 + c8 * 8; LAS float* kd = Ks + row * 129 + c8 * 8;
            qd[0] = bflo(q.x); qd[1] = bfhi(q.x); qd[2] = bflo(q.y); qd[3] = bfhi(q.y); qd[4] = bflo(q.z); qd[5] = bfhi(q.z); qd[6] = bflo(q.w); qd[7] = bfhi(q.w);
            kd[0] = bflo(kk.x); kd[1] = bfhi(kk.x); kd[2] = bflo(kk.y); kd[3] = bfhi(kk.y); kd[4] = bflo(kk.z); kd[5] = bfhi(kk.z); kd[6] = bflo(kk.w); kd[7] = bfhi(kk.w); }
        if (t < 256) { const int row = t >> 2, c8 = t & 3;
            const v4u v = *(const GAS v4u*)(F.V + (m0 + row) * 1024 + h * 256 + es * 32 + c8 * 8);
            LAS float* vd = Vs + row * 32 + c8 * 8;
            vd[0] = bflo(v.x); vd[1] = bfhi(v.x); vd[2] = bflo(v.y); vd[3] = bfhi(v.y); vd[4] = bflo(v.z); vd[5] = bfhi(v.z); vd[6] = bflo(v.w); vd[7] = bfhi(v.w); }
        __syncthreads();
        {
            const int i = t >> 3, jg = t & 7; float a[8];
#pragma unroll
            for (int jj = 0; jj < 8; ++jj) a[jj] = 0.f;
            for (int d = 0; d < 128; ++d) { const float q = Qs[i * 129 + d];
#pragma unroll
                for (int jj = 0; jj < 8; ++jj) a[jj] += q * Ks[(jg * 8 + jj) * 129 + d]; }
#pragma unroll
            for (int jj = 0; jj < 8; ++jj) { const int j = jg * 8 + jj; const int dd = i > j ? i - j : j - i; Ps[i * 65 + j] = a[jj] * expf(lg * (float)dd); }
        }
        __syncthreads();
        {
            const int e = t & 31, ig = t >> 5;
#pragma unroll
            for (int ii = 0; ii < 4; ++ii) { const int i = ig * 4 + ii; float o1 = 0.f, o2 = 0.f;
                for (int j = 0; j < 64; ++j) o1 += Ps[i * 65 + j] * Vs[j * 32 + e];
                for (int d = 0; d < 128; ++d) o2 += Qs[i * 129 + d] * Ss[d * 32 + e];
                RAW[(m0 + i) * 1024 + h * 256 + es * 32 + e] = o1 + expf(lg * (float)(i + 1)) * o2; }
        }
        __syncthreads();
        {
            const int e = t & 31, dg = t >> 5; float a[8];
#pragma unroll
            for (int dd = 0; dd < 8; ++dd) a[dd] = 0.f;
            for (int j = 0; j < 64; ++j) { const float vd = Vs[j * 32 + e] * expf(lg * (float)(63 - j));
#pragma unroll
                for (int dd = 0; dd < 8; ++dd) a[dd] += Ks[j * 129 + dg * 8 + dd] * vd; }
#pragma unroll
            for (int dd = 0; dd < 8; ++dd) { const int d = dg * 8 + dd; Ss[d * 32 + e] = Ss[d * 32 + e] * cdec + a[dd]; }
        }
    }
    __syncthreads();
}

__device__ __forceinline__ void lru_simple(Frame& F, int item) {
    const int b = item >> 5, cb = (item >> 2) & 7, q = item & 3, t = F.tid;
    LAS float* Xs = (LAS float*)(F.lds);
    LAS float* XC = Xs + 67 * 128;
    LAS float* Wa = XC + 64 * 129;
    LAS float* Wx = Wa + 128 * 32;
    LAS float* AA = Wx + 128 * 32;
    LAS float* UU = AA + 64 * 32;
    LAS float* Hc = UU + 64 * 32;
    __syncthreads();
    for (int i = t; i < 128 * 32; i += 512) { const int r = i >> 5, c = i & 31;
        Wa[i] = F.w_rg_a[((size_t)cb * 128 + r) * 128 + q * 32 + c]; Wx[i] = F.w_rg_x[((size_t)cb * 128 + r) * 128 + q * 32 + c]; }
    if (t < 32) Hc[t] = 0.f;
    const int c = t & 31, tg = t >> 5, ch = cb * 128 + q * 32 + c;
    const float ba = F.b_rg_a[ch], bx = F.b_rg_x[ch];
    const float lamv = F.lam[ch];
    const float Lc = -8.0f * log1pf(expf(-lamv));
    for (int tile = 0; tile < SEQ / 64; ++tile) {
        const int t0 = tile * 64; const size_t m0 = (size_t)b * SEQ + t0;
        __syncthreads();
        for (int id = t; id < 67 * 16; id += 512) { const int r = id >> 4, c8 = id & 15; const int s = t0 - 3 + r;
            v4u v = (v4u){0u, 0u, 0u, 0u};
            if (s >= 0) v = *(const GAS v4u*)(F.XL + ((size_t)b * SEQ + s) * 1024 + cb * 128 + c8 * 8);
            LAS float* xd = Xs + r * 128 + c8 * 8;
            xd[0] = bflo(v.x); xd[1] = bfhi(v.x); xd[2] = bflo(v.y); xd[3] = bfhi(v.y); xd[4] = bflo(v.z); xd[5] = bfhi(v.z); xd[6] = bflo(v.w); xd[7] = bfhi(v.w); }
        __syncthreads();
#pragma unroll 4
        for (int k = 0; k < 16; ++k) { const int id = t + 512 * k, tt = id >> 7, i = id & 127, cc = cb * 128 + i;
            float a = F.conv_b[cc];
#pragma unroll
            for (int j = 0; j < 4; ++j) a += F.conv_w[j * 1024 + cc] * Xs[(tt + j) * 128 + i];
            XC[tt * 129 + i] = a; }
        __syncthreads();
#pragma unroll
        for (int k = 0; k < 4; ++k) { const int tt = tg * 4 + k; float rp = ba, ip = bx;
            for (int i = 0; i < 128; ++i) { const float xv = XC[tt * 129 + i]; rp += xv * Wa[i * 32 + c]; ip += xv * Wx[i * 32 + c]; }
            const float r = 1.0f / (1.0f + expf(-rp)), ig = 1.0f / (1.0f + expf(-ip));
            const float la = r * Lc;
            AA[tt * 32 + c] = expf(la);
            UU[tt * 32 + c] = sqrtf(-expm1f(2.0f * la)) * (ig * XC[tt * 129 + q * 32 + c]); }
        __syncthreads();
        if (t < 32) { float hh = Hc[t];
            for (int k = 0; k < 64; ++k) { hh = AA[k * 32 + t] * hh + UU[k * 32 + t]; UU[k * 32 + t] = hh; }
            Hc[t] = hh; }
        __syncthreads();
#pragma unroll
        for (int k = 0; k < 4; ++k) { const int id = t + 512 * k, tt = id >> 5, cc = id & 31; const size_t off = (m0 + tt) * 1024 + cb * 128 + q * 32 + cc;
            F.SGL[off] = (bf16)f2bf(bf2f(F.SGL[off]) * UU[tt * 32 + cc]); }
    }
    __syncthreads();
}

__device__ __forceinline__ void gn_gate(Frame& F, const float* RAW) {
    const int gw = F.vcu * NWAVES + F.wave, NGW = F.G * NWAVES;
    for (int m = gw; m < M; m += NGW) {
        const GAS f32x4* xr = (const GAS f32x4*)(RAW + (size_t)m * D) + F.lane;
        GAS v2u* sg = (GAS v2u*)(F.SGR + (size_t)m * D) + F.lane;
#pragma unroll
        for (int j = 0; j < 4; ++j) {
            f32x4 v = xr[64 * j];
            const float mean = wave_sum((v.x + v.y) + (v.z + v.w)) * (1.f / 256.f);
            v = v - mean;
            const float rstd = 1.f / sqrtf(wave_sum((v.x * v.x + v.y * v.y) + (v.z * v.z + v.w * v.w)) * (1.f / 256.f) + LN_EPS);
            const f32x4 g = *((const GAS f32x4*)F.gn_g + F.lane + 64 * j), bb = *((const GAS f32x4*)F.gn_b + F.lane + 64 * j);
            const f32x4 y = v * rstd * g + bb;
            const v2u s = sg[64 * j]; v2u w;
            w.x = pk2(bflo(s.x) * y.x, bfhi(s.x) * y.y); w.y = pk2(bflo(s.y) * y.z, bfhi(s.y) * y.w);
            sg[64 * j] = w;
        }
    }
}

__device__ __forceinline__ void final_ln(Frame& F) {
    const int gw = F.vcu * NWAVES + F.wave, NGW = F.G * NWAVES;
    for (int m = gw; m < M; m += NGW) {
        const GAS f32x4* xr = (const GAS f32x4*)(F.x + (size_t)m * D) + F.lane;
        GAS f32x4* yr = (GAS f32x4*)(F.out + (size_t)m * D) + F.lane;
        f32x4 v[4]; float s = 0.f;
#pragma unroll
        for (int j = 0; j < 4; ++j) { v[j] = xr[64 * j]; s += (v[j].x + v[j].y) + (v[j].z + v[j].w); }
        float mean = wave_sum(s) * (1.f / D); float s2 = 0.f;
#pragma unroll
        for (int j = 0; j < 4; ++j) { v[j] = v[j] - mean; s2 += (v[j].x * v[j].x + v[j].y * v[j].y) + (v[j].z * v[j].z + v[j].w * v[j].w); }
        float rstd = 1.f / sqrtf(wave_sum(s2) * (1.f / D) + LN_EPS);
        s = 0.f;
#pragma unroll
        for (int j = 0; j < 4; ++j) { const f32x4 g = *((const GAS f32x4*)F.ln_in_g + F.lane + 64 * j), bb = *((const GAS f32x4*)F.ln_in_b + F.lane + 64 * j);
            v[j] = (v[j] * rstd * g + bb) * DN_ALPHA + yr[64 * j]; s += (v[j].x + v[j].y) + (v[j].z + v[j].w); }
        mean = wave_sum(s) * (1.f / D); s2 = 0.f;
#pragma unroll
        for (int j = 0; j < 4; ++j) { v[j] = v[j] - mean; s2 += (v[j].x * v[j].x + v[j].y * v[j].y) + (v[j].z * v[j].z + v[j].w * v[j].w); }
        rstd = 1.f / sqrtf(wave_sum(s2) * (1.f / D) + LN_EPS);
#pragma unroll
        for (int j = 0; j < 4; ++j) { const f32x4 g = *((const GAS f32x4*)F.ln_out_g + F.lane + 64 * j), bb = *((const GAS f32x4*)F.ln_out_b + F.lane + 64 * j);
            yr[64 * j] = v[j] * rstd * g + bb; }
    }
}

struct Args { const float* in[19]; float* out; unsigned char* ws; int ph_lo, ph_hi, li, pad; };
__global__ void __launch_bounds__(NWAVES * 64, 2) fwd_kernel(Args args) {
    extern __shared__ __attribute__((aligned(16))) unsigned char lds[];
    Frame F;
    F.lds = (LAS unsigned char*)lds;
    F.MISC = (volatile LAS unsigned*)(F.lds + MISC_OFF);
    F.tid = threadIdx.x; F.lane = F.tid & 63; F.wave = __builtin_amdgcn_readfirstlane(F.tid >> 6);
    F.G = gridDim.x; { const int bx = blockIdx.x; F.vcu = (F.G % 8 == 0) ? (bx % 8) * (F.G / 8) + bx / 8 : bx; }
    unsigned char* ws = args.ws;
    F.ctl = (gu32*)(ws + WS_CTL);
    F.x = args.in[0]; F.ln_in_g = args.in[1]; F.ln_in_b = args.in[2]; F.w_in = args.in[3]; F.b_merge = args.in[4]; F.gn_g = args.in[5]; F.gn_b = args.in[6]; F.w_ret = args.in[7];
    F.conv_w = args.in[8]; F.conv_b = args.in[9]; F.w_rg_a = args.in[10]; F.b_rg_a = args.in[11]; F.w_rg_x = args.in[12]; F.b_rg_x = args.in[13]; F.lam = args.in[14]; F.w_lru = args.in[15];
    F.w_out = args.in[16]; F.ln_out_g = args.in[17]; F.ln_out_b = args.in[18]; F.out = args.out;
    F.WinT = (bf16*)(ws + WS_WIN); F.PcatT = (bf16*)(ws + WS_PCAT); F.WoutT = (bf16*)(ws + WS_WOUT); F.rope = (float*)(ws + WS_ROPE);
    F.Q = (bf16*)(ws + WS_Q); F.K = (bf16*)(ws + WS_K); F.V = (bf16*)(ws + WS_V); F.SGR = (bf16*)(ws + WS_SGR); F.XL = (bf16*)(ws + WS_XL); F.SGL = (bf16*)(ws + WS_SGL);
    F.GR = (bf16*)(ws + WS_GR); F.GL = (bf16*)(ws + WS_GL); F.MERGED = (bf16*)(ws + WS_MERGED); F.XN = (bf16*)args.out;
    for (int u = F.tid; u < (LDS_BYTES - LDSCTL_OFF) / 4; u += NWAVES * 64) ((LAS unsigned*)(F.lds + LDSCTL_OFF))[u] = 0u;
    __syncthreads();
    XcdBarrier bar; bar.bar = (unsigned*)(F.ctl + CW_BAR); bar.x = 0; bar.st = nullptr;
    if (MK_ONE_LAUNCH) bar = xcd_barrier_post((unsigned*)(F.ctl + CW_BAR), F.MISC + 8);
#define GRID_BAR(seam) do { if (!MK_ONE_LAUNCH) { if (F.tid == 0) __hip_atomic_store(F.ctl + CW_TMO, 0xBADBA0u | (unsigned)(seam), RLX_AGENT); } else { xcd_barrier(bar); } } while (0)
    const int lo = args.ph_lo, hi = args.ph_hi;
#define IN(k) (lo <= (k) && (k) < hi)
#define BOTH(k) (IN(k) && IN((k) + 1))

    if (IN(0)) { p0_prologue(F); if (BOTH(0)) GRID_BAR(0); }

    if (IN(1)) {
        pg8::Gemm g{F.XN, F.WinT, M, NIN, D}; pg8::StaticOrder S; S.init(M, NIN, F.G, (int)blockIdx.x);
        pg8::EpiIn E{F.Q, F.K, F.V, F.SGR, F.XL, F.SGL, F.GR, F.GL, F.rope, F.b_merge};
        pg8::gemm_phase<pg8::EpiIn, pg8::StaticOrder, PG8_ALIGN, PG8_SP2>(F.lds + RING_OFF, g, S, E);
        if (BOTH(1)) GRID_BAR(1);
    }

    if (IN(2)) {
        for (int it = F.vcu; it < 256; it += F.G) ret_simple(F, it, F.out);
        for (int it = F.vcu; it < 256; it += F.G) lru_simple(F, it);
        if (BOTH(2)) GRID_BAR(2);
    }

    if (IN(3)) { gn_gate(F, F.out); if (BOTH(3)) GRID_BAR(3); }

    if (IN(4)) {
        pg8::Gemm g{F.SGR, F.PcatT, M, D, D}; g.ldb = 2 * D; pg8::StaticOrder S; S.init(M, D, F.G, (int)blockIdx.x);
        pg8::EpiGateF32 E{F.out, F.GR, D};
        pg8::gemm_phase<pg8::EpiGateF32, pg8::StaticOrder, PG8_ALIGN, PG8_SP2>(F.lds + RING_OFF, g, S, E);
        if (BOTH(4)) GRID_BAR(4);
    }

    if (IN(5)) {
        pg8::Gemm g{F.SGL, F.PcatT + D, M, D, D}; g.ldb = 2 * D; pg8::StaticOrder S; S.init(M, D, F.G, (int)blockIdx.x);
        pg8::EpiMerge E{F.MERGED, F.out, F.GL, D};
        pg8::gemm_phase<pg8::EpiMerge, pg8::StaticOrder, PG8_ALIGN, PG8_SP2>(F.lds + RING_OFF, g, S, E);
        if (BOTH(5)) GRID_BAR(5);
    }

    if (IN(6)) {
        pg8::Gemm g{F.MERGED, F.WoutT, M, D, D}; pg8::StaticOrder S; S.init(M, D, F.G, (int)blockIdx.x);
        pg8::EpiF32 E{F.out, D};
        pg8::gemm_phase<pg8::EpiF32, pg8::StaticOrder, PG8_ALIGN, PG8_SP2>(F.lds + RING_OFF, g, S, E);
        if (BOTH(6)) GRID_BAR(6);
    }

    if (IN(7)) { final_ln(F); }
#undef IN
#undef BOTH
}

extern "C" void kernel_launch(void* const* d_in, const int* in_sizes, int n_in, void* d_out, int out_size, void* d_ws, size_t ws_size, hipStream_t stream) {
    static int grid = 0;
    if (grid == 0) {
        if (n_in != 19 || in_sizes[0] != M * D || out_size != M * D || ws_size < WS_END) { fprintf(stderr, "kernel_launch: unexpected shapes (n_in %d, in0 %d, out %d, ws %zu); nothing launched\n", n_in, n_in > 0 ? in_sizes[0] : -1, out_size, ws_size); grid = -1; return; }
        int dev = 0, cus = 0, per_cu = 0;
        if (hipGetDevice(&dev) != hipSuccess || hipDeviceGetAttribute(&cus, hipDeviceAttributeMultiprocessorCount, dev) != hipSuccess) { grid = -1; return; }
        if (hipFuncSetAttribute((const void*)fwd_kernel, hipFuncAttributeMaxDynamicSharedMemorySize, LDS_BYTES) != hipSuccess) { fprintf(stderr, "kernel_launch: hipFuncSetAttribute failed\n"); grid = -1; return; }
        if (hipOccupancyMaxActiveBlocksPerMultiprocessor(&per_cu, (const void*)fwd_kernel, NWAVES * 64, LDS_BYTES) != hipSuccess || per_cu < 1) { fprintf(stderr, "kernel_launch: occupancy query reports %d\n", per_cu); per_cu = 1; }
        (void)hipGetLastError();
        grid = cus;
    }
    if (grid < 0) return;
    if (hipMemsetAsync((char*)d_ws + WS_CTL, 0, CTL_ZERO_BYTES, stream) != hipSuccess) return;
    Args a{};
    for (int i = 0; i < 19; ++i) a.in[i] = (const float*)d_in[i];
    a.out = (float*)d_out; a.ws = (unsigned char*)d_ws;
    const int nl = MK_ONE_LAUNCH ? 1 : NPHASES;
    for (int li = 0; li < nl; ++li) {
        a.ph_lo = MK_ONE_LAUNCH ? 0 : li; a.ph_hi = MK_ONE_LAUNCH ? NPHASES : li + 1; a.li = li;
        hipLaunchKernelGGL(fwd_kernel, dim3(grid), dim3(NWAVES * 64), LDS_BYTES, stream, a);
        if (hipPeekAtLastError() != hipSuccess) break;
    }
}
```

```cpp
#include <hip/hip_runtime.h>
#include <cstdio>
#include <cstdint>
namespace pg8 {
#define PG8_LAS __attribute__((address_space(3)))
typedef unsigned short bf16_t;
typedef short bf16x8 __attribute__((ext_vector_type(8)));
typedef float f32x4 __attribute__((ext_vector_type(4)));
typedef unsigned u32x4 __attribute__((ext_vector_type(4)));
constexpr int BM = 256, BK = 64, HALF = 128, HTB = HALF * BK * 2  , STAGE_BYTES = 8 * HTB, NXCD = 8, WGM = 8;

__host__ __device__ __forceinline__ int lds_byte(int r, int c) { const int st = (r >> 4) * 2 + (c >> 5), rr = r & 15, cc = c & 31, ob = rr * 64 + cc * 2; return st * 1024 + (ob ^ (((ob >> 9) & 1) << 5)); }
__host__ __device__ __forceinline__ void stage_rc(int b, int& R, int& C) { const int st = b / 1024, sb = b % 1024, swz = sb ^ (((sb >> 9) & 1) << 5); R = (st >> 1) * 16 + swz / 64; C = (st & 1) * 32 + (swz % 64) / 2; }
__host__ __device__ __forceinline__ int perm32(int rho) { const int n = rho >> 4, i = rho & 15; return 8 * (i >> 2) + 4 * n + (i & 3); }

struct Unit { int pm, pn; };
struct Gemm { const bf16_t* A; const bf16_t* Bt; int M, N, K; int lda = 0, ldb = 0; };

struct StaticOrder {
    int nM, nN, nwg, G, c;
    __host__ __device__ void init(int M, int N, int G_, int c_) { nM = M / BM; nN = N / BM; nwg = nM * nN; G = G_; c = c_; }
    __host__ __device__ bool next(int i, Unit& u) const {
        const long L = (long)i * G + c; if (L >= nwg) return false;
        int wgid = (int)L; { const int q = nwg / NXCD, r = nwg % NXCD, xcd = wgid % NXCD, off = wgid / NXCD; wgid = (xcd < r ? xcd * (q + 1) : r * (q + 1) + (xcd - r) * q) + off; }
        const int nig = WGM * nN, gid = wgid / nig, fm = gid * WGM, gsz = (nM - fm) < WGM ? (nM - fm) : WGM;
        u.pm = fm + ((wgid % nig) % gsz); u.pn = (wgid % nig) / gsz; return true;
    }
    __device__ __forceinline__ void a_ready(const Unit&) const {}
    __device__ __forceinline__ void done(const Unit&) const {}
};

__device__ __forceinline__ unsigned cvt_pk_bf16(float lo, float hi) { unsigned r; asm volatile("v_cvt_pk_bf16_f32 %0, %1, %2" : "=v"(r) : "v"(lo), "v"(hi)); return r; }
typedef unsigned u32x2 __attribute__((ext_vector_type(2)));
__device__ __forceinline__ float bf_lo(unsigned w) { return __builtin_bit_cast(float, w << 16); }
__device__ __forceinline__ float bf_hi(unsigned w) { return __builtin_bit_cast(float, w & 0xffff0000u); }
__device__ __forceinline__ float fast_sigmoid(float x) { return __builtin_amdgcn_rcpf(1.0f + __builtin_amdgcn_exp2f(-1.4426950408889634f * x)); }

struct EpiF32 {
    static constexpr bool PERM = false, AFTER_DRAIN = false;
    float* C; int ldc;
    __device__ __forceinline__ void operator()(const f32x4 (&acc)[2][2][4][2], const Unit& u, int wr, int wc, int fr, int fq) const {
        const int row0 = u.pm * BM + wr * 64 + fr, col0 = u.pn * BM + wc * 32 + 4 * fq;
#pragma unroll
        for (int ai = 0; ai < 2; ++ai)
#pragma unroll
            for (int m = 0; m < 4; ++m) { float* rowp = C + (size_t)(row0 + ai * HALF + m * 16) * ldc + col0;
#pragma unroll
                for (int bj = 0; bj < 2; ++bj)
#pragma unroll
                    for (int n = 0; n < 2; ++n) *(f32x4*)(rowp + bj * HALF + n * 16) = acc[ai][bj][m][n]; }
    }
};
struct EpiGateF32 {
    static constexpr bool PERM = false, AFTER_DRAIN = false;
    float* C; const bf16_t* G; int ldc;
    __device__ __forceinline__ void operator()(const f32x4 (&acc)[2][2][4][2], const Unit& u, int wr, int wc, int fr, int fq) const {
        const int row0 = u.pm * BM + wr * 64 + fr, col0 = u.pn * BM + wc * 32 + 4 * fq;
#pragma unroll
        for (int ai = 0; ai < 2; ++ai)
#pragma unroll
            for (int m = 0; m < 4; ++m) { const size_t off = (size_t)(row0 + ai * HALF + m * 16) * ldc + col0;
#pragma unroll
                for (int bj = 0; bj < 2; ++bj)
#pragma unroll
                    for (int n = 0; n < 2; ++n) { const u32x2 g = *(const u32x2*)(G + off + bj * HALF + n * 16); const f32x4 a = acc[ai][bj][m][n];
                        f32x4 o; o[0] = bf_lo(g.x) * a[0]; o[1] = bf_hi(g.x) * a[1]; o[2] = bf_lo(g.y) * a[2]; o[3] = bf_hi(g.y) * a[3];
                        *(f32x4*)(C + off + bj * HALF + n * 16) = o; } }
    }
};
struct EpiMerge {
    static constexpr bool PERM = true, AFTER_DRAIN = false;
    bf16_t* O; const float* T1; const bf16_t* G; int ldc;
    __device__ __forceinline__ void operator()(const f32x4 (&acc)[2][2][4][2], const Unit& u, int wr, int wc, int fr, int fq) const {
        const int row0 = u.pm * BM + wr * 64 + fr, col0 = u.pn * BM + wc * 32 + 8 * fq;
#pragma unroll
        for (int ai = 0; ai < 2; ++ai)
#pragma unroll
            for (int m = 0; m < 4; ++m) { const size_t off = (size_t)(row0 + ai * HALF + m * 16) * ldc + col0;
#pragma unroll
                for (int bj = 0; bj < 2; ++bj) { const u32x4 g = *(const u32x4*)(G + off + bj * HALF);
                    const f32x4 t0 = *(const f32x4*)(T1 + off + bj * HALF), t1 = *(const f32x4*)(T1 + off + bj * HALF + 4);
                    const f32x4 a0 = acc[ai][bj][m][0], a1 = acc[ai][bj][m][1];
                    u32x4 w;
                    w.x = cvt_pk_bf16(t0[0] + bf_lo(g.x) * a0[0], t0[1] + bf_hi(g.x) * a0[1]);
                    w.y = cvt_pk_bf16(t0[2] + bf_lo(g.y) * a0[2], t0[3] + bf_hi(g.y) * a0[3]);
                    w.z = cvt_pk_bf16(t1[0] + bf_lo(g.z) * a1[0], t1[1] + bf_hi(g.z) * a1[1]);
                    w.w = cvt_pk_bf16(t1[2] + bf_lo(g.w) * a1[2], t1[3] + bf_hi(g.w) * a1[3]);
                    *(u32x4*)(O + off + bj * HALF) = w; } }
    }
};
struct EpiIn {
    static constexpr bool PERM = true, AFTER_DRAIN = false;
    bf16_t *Q, *Kb, *V, *SGR, *XL, *SGL, *GR, *GL; const float* rope; const float* bmerge;
    __device__ __forceinline__ void operator()(const f32x4 (&acc)[2][2][4][2], const Unit& u, int wr, int wc, int fr, int fq) const {
        const int row0 = u.pm * BM + wr * 64 + fr; const int pn = u.pn;
        if (pn < 4) {
            bf16_t* base = (pn < 2) ? Q : Kb; const int head = 2 * (pn & 1) + (wc >> 1), i0 = 32 * (wc & 1) + 8 * fq;
#pragma unroll
            for (int ai = 0; ai < 2; ++ai)
#pragma unroll
                for (int m = 0; m < 4; ++m) { const int row = row0 + ai * HALF + m * 16, pos = row & 8191;
                    const f32x4* cs = (const f32x4*)(rope + ((size_t)pos * 64 + i0) * 2);
                    const f32x4 c0 = cs[0], c1 = cs[1], c2 = cs[2], c3 = cs[3];
                    const f32x4 xa = acc[ai][0][m][0], xb = acc[ai][0][m][1], ya = acc[ai][1][m][0], yb = acc[ai][1][m][1];
                    u32x4 o1, o2;
                    o1.x = cvt_pk_bf16(xa[0] * c0[0] - ya[0] * c0[1], xa[1] * c0[2] - ya[1] * c0[3]);
                    o1.y = cvt_pk_bf16(xa[2] * c1[0] - ya[2] * c1[1], xa[3] * c1[2] - ya[3] * c1[3]);
                    o1.z = cvt_pk_bf16(xb[0] * c2[0] - yb[0] * c2[1], xb[1] * c2[2] - yb[1] * c2[3]);
                    o1.w = cvt_pk_bf16(xb[2] * c3[0] - yb[2] * c3[1], xb[3] * c3[2] - yb[3] * c3[3]);
                    o2.x = cvt_pk_bf16(ya[0] * c0[0] + xa[0] * c0[1], ya[1] * c0[2] + xa[1] * c0[3]);
                    o2.y = cvt_pk_bf16(ya[2] * c1[0] + xa[2] * c1[1], ya[3] * c1[2] + xa[3] * c1[3]);
                    o2.z = cvt_pk_bf16(yb[0] * c2[0] + xb[0] * c2[1], yb[1] * c2[2] + xb[1] * c2[3]);
                    o2.w = cvt_pk_bf16(yb[2] * c3[0] + xb[2] * c3[1], yb[3] * c3[2] + xb[3] * c3[3]);
                    bf16_t* rp = base + (size_t)row * 512 + head * 128 + i0;
                    *(u32x4*)rp = o1; *(u32x4*)(rp + 64) = o2; }
        } else {
            const int ty = (pn - 4) >> 2, colt = ((pn - 4) & 3) * BM, col0 = colt + wc * 32 + 8 * fq;
            bf16_t* base = ty == 0 ? V : ty == 1 ? SGR : ty == 2 ? XL : ty == 3 ? SGL : ty == 4 ? GR : GL;
            f32x4 bv[2][2];
#pragma unroll
            for (int bj = 0; bj < 2; ++bj)
#pragma unroll
                for (int n = 0; n < 2; ++n) bv[bj][n] = (ty >= 4) ? *(const f32x4*)(bmerge + (ty - 4) * 1024 + col0 + bj * HALF + 4 * n) : (f32x4){0.f, 0.f, 0.f, 0.f};
#pragma unroll
            for (int ai = 0; ai < 2; ++ai)
#pragma unroll
                for (int m = 0; m < 4; ++m) { bf16_t* rowp = base + (size_t)(row0 + ai * HALF + m * 16) * 1024 + col0;
#pragma unroll
                    for (int bj = 0; bj < 2; ++bj) { f32x4 v0 = acc[ai][bj][m][0] + bv[bj][0], v1 = acc[ai][bj][m][1] + bv[bj][1];
                        if (ty == 1 || ty == 3) {
#pragma unroll
                            for (int j = 0; j < 4; ++j) { v0[j] = v0[j] * fast_sigmoid(v0[j]); v1[j] = v1[j] * fast_sigmoid(v1[j]); } }
                        if (ty >= 4) {
#pragma unroll
                            for (int j = 0; j < 4; ++j) { v0[j] = fast_sigmoid(v0[j]); v1[j] = fast_sigmoid(v1[j]); } }
                        u32x4 w; w.x = cvt_pk_bf16(v0[0], v0[1]); w.y = cvt_pk_bf16(v0[2], v0[3]); w.z = cvt_pk_bf16(v1[0], v1[1]); w.w = cvt_pk_bf16(v1[2], v1[3]);
                        *(u32x4*)(rowp + bj * HALF) = w; } }
        }
    }
};

template <class Epi, class Sched, bool ALIGN_EPI = false, bool SP2 = false>
__device__ __forceinline__ void gemm_phase(PG8_LAS unsigned char* lds, const Gemm g, const Sched& S, const Epi& E) {
    const int tid = threadIdx.x, wid = __builtin_amdgcn_readfirstlane(tid >> 6), lane = tid & 63, wr = wid >> 2, wc = wid & 3, fr = lane & 15, fq = lane >> 4;
    const int K = g.K, nt = K / BK, lda = g.lda ? g.lda : K, ldb = g.ldb ? g.ldb : K;
    unsigned voffA[2], voffB[2];
#pragma unroll
    for (int i = 0; i < 2; ++i) { int R, C; stage_rc(tid * 16 + i * 8192, R, C); const int Rb = Epi::PERM ? ((R & ~31) + perm32(R & 31)) : R;
        voffA[i] = (unsigned)(R * lda + C) * 2u; voffB[i] = (unsigned)(Rb * ldb + C) * 2u; }
    const size_t kstep = (size_t)(BK * 2);
    const size_t hstepA = (size_t)HALF * lda * 2, hstepB = (size_t)HALF * ldb * 2;
    const size_t tstepA = 2 * hstepA, tstepB = 2 * hstepB;
    const unsigned ldsw = (unsigned)wid * 1024u;
    const int aoff = lds_byte(wr * 64 + fr, fq * 8), boff = lds_byte(wc * 32 + fr, fq * 8);
#define PG8_SA(b, h) (((b) * 2 + (h)) * HTB)
#define PG8_SB(b, h) ((4 + (b) * 2 + (h)) * HTB)
#define PG8_STAGE(bufoff, gbase, voff) do { _Pragma("unroll") for (int _i = 0; _i < 2; ++_i) \
        __builtin_amdgcn_global_load_lds((const unsigned*)((const char*)(gbase) + (voff)[_i]), (PG8_LAS unsigned*)(lds + (bufoff) + ldsw + _i * 8192), 16, 0, 0); } while (0)
#define PG8_LDA(dst, b, h) do { _Pragma("unroll") for (int m = 0; m < 4; ++m) _Pragma("unroll") for (int k = 0; k < 2; ++k) dst[m][k] = *(const PG8_LAS bf16x8*)(lds + PG8_SA(b, h) + aoff + m * 2048 + k * 1024); } while (0)
#define PG8_LDB(dst, b, h) do { _Pragma("unroll") for (int n = 0; n < 2; ++n) _Pragma("unroll") for (int k = 0; k < 2; ++k) dst[n][k] = *(const PG8_LAS bf16x8*)(lds + PG8_SB(b, h) + boff + n * 2048 + k * 1024); } while (0)
#define PG8_MMA(ai, bj, At, Bt) do { __builtin_amdgcn_s_setprio(1); _Pragma("unroll") for (int m = 0; m < 4; ++m) _Pragma("unroll") for (int n = 0; n < 2; ++n) _Pragma("unroll") for (int k = 0; k < 2; ++k) \
        acc[ai][bj][m][n] = __builtin_amdgcn_mfma_f32_16x16x32_bf16(Bt[n][k], At[m][k], acc[ai][bj][m][n], 0, 0, 0); __builtin_amdgcn_s_setprio(0); } while (0)
#define PG8_WAIT_V(n) asm volatile("s_waitcnt vmcnt(" #n ")" ::: "memory")
#define PG8_WAIT_L(n) asm volatile("s_waitcnt lgkmcnt(" #n ")" ::: "memory")
#define PG8_BAR __builtin_amdgcn_s_barrier()
#define PG8_SCHED __builtin_amdgcn_sched_barrier(0)
    Unit cur, nxt; int ui = 0;
    if (!S.next(0, cur)) return;
    f32x4 acc[2][2][4][2];
#pragma unroll
    for (int a = 0; a < 2; ++a)
#pragma unroll
        for (int b = 0; b < 2; ++b)
#pragma unroll
            for (int m = 0; m < 4; ++m)
#pragma unroll
                for (int n = 0; n < 2; ++n) acc[a][b][m][n] = (f32x4){0.f, 0.f, 0.f, 0.f};
    bf16x8 At[4][2], B0[2][2], B1[2][2];
    const char* cA = (const char*)g.A + (size_t)cur.pm * tstepA; const char* cB = (const char*)g.Bt + (size_t)cur.pn * tstepB;
    S.a_ready(cur);
    if constexpr (SP2) {
        PG8_STAGE(PG8_SB(0, 0), cB, voffB); PG8_STAGE(PG8_SB(0, 1), cB + hstepB, voffB); PG8_STAGE(PG8_SA(0, 0), cA, voffA); PG8_STAGE(PG8_SA(0, 1), cA + hstepA, voffA);
        if (wr == 1) PG8_BAR;
        PG8_WAIT_V(2); PG8_BAR;
        PG8_STAGE(PG8_SB(1, 0), cB + kstep, voffB); PG8_STAGE(PG8_SA(1, 0), cA + kstep, voffA); PG8_STAGE(PG8_SB(1, 1), cB + hstepB + kstep, voffB);
        PG8_WAIT_V(6); PG8_BAR;
    } else {
        PG8_STAGE(PG8_SB(0, 0), cB, voffB); PG8_STAGE(PG8_SA(0, 0), cA, voffA); PG8_STAGE(PG8_SB(0, 1), cB + hstepB, voffB); PG8_STAGE(PG8_SA(0, 1), cA + hstepA, voffA);
        if (wr == 1) PG8_BAR;
        PG8_WAIT_V(4); PG8_BAR;
        PG8_STAGE(PG8_SB(1, 0), cB + kstep, voffB); PG8_STAGE(PG8_SA(1, 0), cA + kstep, voffA); PG8_STAGE(PG8_SB(1, 1), cB + hstepB + kstep, voffB);
        PG8_WAIT_V(6); PG8_BAR;
    }
    for (;;) {
        const bool has_next = S.next(ui + 1, nxt);
        const char* nA = has_next ? (const char*)g.A + (size_t)nxt.pm * tstepA : cA; const char* nB = has_next ? (const char*)g.Bt + (size_t)nxt.pn * tstepB : cB;
        for (int t = 0; t < nt; t += 2) {
            const bool last = (t == nt - 2);
            const char* a1 = cA + (size_t)(t + 1) * kstep;
            const char* a2 = last ? nA : cA + (size_t)(t + 2) * kstep; const char* b2 = last ? nB : cB + (size_t)(t + 2) * kstep;
            const char* a3 = a2 + kstep; const char* b3 = b2 + kstep;
            if (last && has_next) S.a_ready(nxt);
            if constexpr (SP2) {
            PG8_LDB(B0, 0, 0); PG8_LDB(B1, 0, 1); PG8_SCHED; PG8_LDA(At, 0, 0); PG8_STAGE(PG8_SA(1, 1), a1 + hstepA, voffA);
            PG8_WAIT_V(8); PG8_WAIT_L(0); PG8_BAR; PG8_MMA(0, 0, At, B0); PG8_MMA(0, 1, At, B1); PG8_BAR; PG8_SCHED;
            PG8_LDA(At, 0, 1); PG8_STAGE(PG8_SB(0, 0), b2, voffB); PG8_STAGE(PG8_SB(0, 1), b2 + hstepB, voffB); PG8_STAGE(PG8_SA(0, 0), a2, voffA);
            PG8_WAIT_V(8); PG8_WAIT_L(0); PG8_BAR; PG8_MMA(1, 0, At, B0); PG8_MMA(1, 1, At, B1); PG8_BAR; PG8_SCHED;
            PG8_LDB(B0, 1, 0); PG8_LDB(B1, 1, 1); PG8_SCHED; PG8_LDA(At, 1, 0); PG8_STAGE(PG8_SA(0, 1), a2 + hstepA, voffA);
            PG8_WAIT_V(8); PG8_WAIT_L(0); PG8_BAR; PG8_MMA(0, 0, At, B0); PG8_MMA(0, 1, At, B1); PG8_BAR; PG8_SCHED;
            PG8_LDA(At, 1, 1); PG8_STAGE(PG8_SB(1, 0), b3, voffB); PG8_STAGE(PG8_SB(1, 1), b3 + hstepB, voffB); PG8_STAGE(PG8_SA(1, 0), a3, voffA);
            PG8_WAIT_V(8); PG8_WAIT_L(0); PG8_BAR; PG8_MMA(1, 0, At, B0); PG8_MMA(1, 1, At, B1); PG8_BAR; PG8_SCHED;
            } else {
            PG8_LDB(B0, 0, 0); PG8_SCHED; PG8_LDA(At, 0, 0); PG8_STAGE(PG8_SA(1, 1), a1 + hstepA, voffA);
            PG8_WAIT_L(8); PG8_BAR; PG8_WAIT_L(0); PG8_MMA(0, 0, At, B0); PG8_BAR; PG8_SCHED;
            PG8_LDB(B1, 0, 1); PG8_STAGE(PG8_SB(0, 0), b2, voffB);
            PG8_BAR; PG8_WAIT_L(0); PG8_MMA(0, 1, At, B1); PG8_BAR;
            PG8_LDA(At, 0, 1); PG8_STAGE(PG8_SA(0, 0), a2, voffA);
            PG8_BAR; PG8_WAIT_L(0); PG8_MMA(1, 0, At, B0); PG8_BAR; PG8_SCHED;
            PG8_STAGE(PG8_SB(0, 1), b2 + hstepB, voffB);
            PG8_WAIT_V(6); PG8_BAR; PG8_MMA(1, 1, At, B1); PG8_BAR;
            PG8_LDB(B0, 1, 0); PG8_SCHED; PG8_LDA(At, 1, 0); PG8_STAGE(PG8_SA(0, 1), a2 + hstepA, voffA);
            PG8_WAIT_L(8); PG8_BAR; PG8_WAIT_L(0); PG8_MMA(0, 0, At, B0); PG8_BAR; PG8_SCHED;
            PG8_LDB(B1, 1, 1); PG8_STAGE(PG8_SB(1, 0), b3, voffB);
            PG8_BAR; PG8_WAIT_L(0); PG8_MMA(0, 1, At, B1); PG8_BAR;
            PG8_LDA(At, 1, 1); PG8_STAGE(PG8_SA(1, 0), a3, voffA);
            PG8_BAR; PG8_WAIT_L(0); PG8_MMA(1, 0, At, B0); PG8_BAR; PG8_SCHED;
            PG8_STAGE(PG8_SB(1, 1), b3 + hstepB, voffB);
            PG8_WAIT_V(6); PG8_BAR; PG8_MMA(1, 1, At, B1); PG8_BAR;
            }
        }
        if constexpr (ALIGN_EPI) { if (wr == 0) PG8_BAR; }
        if constexpr (!Epi::AFTER_DRAIN) { E(acc, cur, wr, wc, fr, fq); S.done(cur); }
        if (!has_next) break;
#pragma unroll
        for (int a = 0; a < 2; ++a)
#pragma unroll
            for (int b = 0; b < 2; ++b)
#pragma unroll
                for (int m = 0; m < 4; ++m)
#pragma unroll
                    for (int n = 0; n < 2; ++n) acc[a][b][m][n] = (f32x4){0.f, 0.f, 0.f, 0.f};
        cur = nxt; cA = nA; cB = nB; ++ui;
        if constexpr (ALIGN_EPI) { if (wr == 1) PG8_BAR; }
    }
    PG8_WAIT_V(0);
    if constexpr (!ALIGN_EPI) { if (wr == 0) PG8_BAR; }
    PG8_BAR;
    if constexpr (Epi::AFTER_DRAIN) { E.fused(acc, cur, wr, wc, fr, fq, lds, wid, lane); S.done(cur); }
#undef PG8_SA
#undef PG8_SB
#undef PG8_STAGE
#undef PG8_LDA
#undef PG8_LDB
#undef PG8_MMA
#undef PG8_WAIT_V
#undef PG8_WAIT_L
#undef PG8_BAR
#undef PG8_SCHED
}
}

#ifndef PG8_SP2
#define PG8_SP2 true
#endif
#ifndef PG8_ALIGN
#define PG8_ALIGN true
#endif

constexpr int NWAVES = 8;
#ifndef MK_ONE_LAUNCH
#define MK_ONE_LAUNCH 1
#endif
constexpr int NPHASES = 8;

constexpr int BATCH = 8, SEQ = 8192, D = 1024, M = BATCH * SEQ, NIN = 7168;
constexpr int RH = 4, DK = 128, DV = 256, CH = 64, NCH = SEQ / CH;
constexpr float LN_EPS = 1e-5f;
constexpr float DN_ALPHA = 1.189207115002721f;

constexpr size_t MiB = 1u << 20;
constexpr size_t WS_CTL = 0, CTL_ZERO_BYTES = 1 * MiB;
constexpr size_t WS_WIN = 2 * MiB;
constexpr size_t WS_PCAT = 16 * MiB;
constexpr size_t WS_WOUT = 20 * MiB;
constexpr size_t WS_ROPE = 22 * MiB;
constexpr size_t WS_Q = 32 * MiB, WS_K = 96 * MiB, WS_V = 160 * MiB, WS_SGR = 288 * MiB, WS_XL = 416 * MiB, WS_SGL = 544 * MiB, WS_GR = 672 * MiB, WS_GL = 800 * MiB, WS_END = 928 * MiB;
constexpr size_t WS_MERGED = WS_Q;
constexpr int CW_TMO = 0, CW_CODE = 1, CW_BAR = 4096;

constexpr int RING_OFF = 0, RING_BYTES = 131072;
constexpr int LDSCTL_OFF = RING_BYTES, MISC_OFF = LDSCTL_OFF + 320;
constexpr int LDS_BYTES = 147456;
static_assert(MISC_OFF + 128 <= LDS_BYTES, "LDS map");

#define GAS __attribute__((address_space(1)))
#define LAS __attribute__((address_space(3)))
typedef unsigned short bf16;
typedef unsigned v4u __attribute__((ext_vector_type(4)));
typedef unsigned v2u __attribute__((ext_vector_type(2)));
typedef float f32x4 __attribute__((ext_vector_type(4)));
typedef GAS unsigned gu32;
#define RLX_AGENT __ATOMIC_RELAXED, __HIP_MEMORY_SCOPE_AGENT
#define LDS_WAIT() asm volatile("s_waitcnt lgkmcnt(0)" ::: "memory")
#define VM_WAIT() asm volatile("s_waitcnt vmcnt(0)" ::: "memory")
__device__ __forceinline__ unsigned f2bf(float f) { unsigned u = __builtin_bit_cast(unsigned, f); return (u + 0x7fffu + ((u >> 16) & 1u)) >> 16; }
__device__ __forceinline__ unsigned pk2(float lo, float hi) { return f2bf(lo) | (f2bf(hi) << 16); }
__device__ __forceinline__ float bflo(unsigned w) { return __builtin_bit_cast(float, w << 16); }
__device__ __forceinline__ float bfhi(unsigned w) { return __builtin_bit_cast(float, w & 0xffff0000u); }
__device__ __forceinline__ float bf2f(bf16 b) { return __builtin_bit_cast(float, ((unsigned)b) << 16); }

#define XB_TMO      128
#define XB_XCNT(j)  (256  + 64 * (j))
#define XB_XSUB(j)  (1280 + 64 * (j))
#define XB_XGEN(j)  (2304 + 64 * (j))
#define XB_TOP      3328
#define XB_TOPGEN   3392
#define XCD_BAR_WORDS 3456
#define XB_SPIN_CAP (1u << 18)

__device__ __forceinline__ unsigned xb_ld(unsigned* p)              { return __hip_atomic_load(p, __ATOMIC_RELAXED, __HIP_MEMORY_SCOPE_AGENT); }
__device__ __forceinline__ unsigned xb_add(unsigned* p, unsigned v) { return __hip_atomic_fetch_add(p, v, __ATOMIC_RELAXED, __HIP_MEMORY_SCOPE_AGENT); }
__device__ __forceinline__ unsigned xb_xcc_id() { return (unsigned)__builtin_amdgcn_s_getreg((3 << 11) | 20) & 0xFu; }
#define XB_SPIN(cond, bar) do { unsigned _sp = 0; while (cond) { __builtin_amdgcn_s_sleep(1); \
    if ((++_sp & 255u) == 0u) { if (xb_ld(&(bar)[XB_TMO])) break; if (_sp > XB_SPIN_CAP) { atomicAdd(&(bar)[XB_TMO], 1u); break; } } } } while (0)

struct XcdBarrier {
    unsigned* bar; unsigned x;
    volatile LAS unsigned* st;
};

__device__ __forceinline__ XcdBarrier xcd_barrier_post(unsigned* bar, volatile LAS unsigned* st) {
    XcdBarrier b; b.bar = bar; b.x = xb_xcc_id(); b.st = st;
    if (threadIdx.x == 0) (void)xb_add(&bar[XB_XCNT(b.x)], 1u);
    return b;
}
__device__ __forceinline__ void xcd_barrier_complete(unsigned* bar, unsigned x, unsigned& nloc, unsigned& nx) {
    const unsigned G = gridDim.x * gridDim.y * gridDim.z;
    unsigned sum, cnt, mine, sp = 0u;
    for (;;) {
        sum = 0u; cnt = 0u; mine = 0u;
#pragma unroll
        for (unsigned j = 0; j < 16; ++j) { const unsigned c = xb_ld(&bar[XB_XCNT(j)]); sum += c; cnt += (c > 0u) ? 1u : 0u; mine = (j == x) ? c : mine; }
        if (sum == G) break;
        __builtin_amdgcn_s_sleep(1);
        if ((++sp & 255u) == 0u) { if (xb_ld(&bar[XB_TMO])) break; if (sp > XB_SPIN_CAP) { atomicAdd(&bar[XB_TMO], 1u); break; } }
    }
    nloc = mine > 0u ? mine : 1u; nx = cnt > 0u ? cnt : 1u;
}

__device__ __forceinline__ void xcd_barrier(const XcdBarrier& b) {
    asm volatile("s_waitcnt vmcnt(0)" ::: "memory");
    __syncthreads();
    if (threadIdx.x == 0) {
        unsigned* bar = b.bar;
        __builtin_amdgcn_s_waitcnt(0);
        unsigned nloc = b.st[0], nx = b.st[1];
        if (nloc == 0u) { xcd_barrier_complete(bar, b.x, nloc, nx); b.st[0] = nloc; b.st[1] = nx; }
        const unsigned old = xb_add(&bar[XB_XSUB(b.x)], 1u);
        const unsigned gen = old / nloc;
        if (old + 1u == (gen + 1u) * nloc) {
            __builtin_amdgcn_fence(__ATOMIC_RELEASE, "agent");
            asm volatile("s_waitcnt vmcnt(0)" ::: "memory");
            const unsigned og = xb_add(&bar[XB_TOP], 1u);
            const unsigned tg = og / nx;
            if (og + 1u == (tg + 1u) * nx) xb_add(&bar[XB_TOPGEN], 1u);
            else XB_SPIN(xb_ld(&bar[XB_TOPGEN]) == tg, bar);
            __builtin_amdgcn_fence(__ATOMIC_ACQUIRE, "agent");
            xb_add(&bar[XB_XGEN(b.x)], 1u);
            asm volatile("s_waitcnt vmcnt(0)" ::: "memory");
        } else {
            XB_SPIN(xb_ld(&bar[XB_XGEN(b.x)]) == gen, bar);
            __builtin_amdgcn_fence(__ATOMIC_ACQUIRE, "agent");
            asm volatile("s_waitcnt vmcnt(0)" ::: "memory");
        }
    }
    __syncthreads();
}

struct Frame {
    LAS unsigned char* lds;
    volatile LAS unsigned* MISC;
    gu32* ctl;
    int tid, lane, wave;
    int vcu, G;
    const float* x; float* out;
    const float *ln_in_g, *ln_in_b, *w_in, *b_merge, *gn_g, *gn_b, *w_ret, *conv_w, *conv_b, *w_rg_a, *b_rg_a, *w_rg_x, *b_rg_x, *lam, *w_lru, *w_out, *ln_out_g, *ln_out_b;
    bf16 *WinT, *PcatT, *WoutT; float* rope;
    bf16 *Q, *K, *V, *SGR, *XL, *SGL, *GR, *GL, *MERGED, *XN;
};

__device__ __forceinline__ float wave_sum(float v) {
#pragma unroll
    for (int o = 1; o < 64; o <<= 1) v += __shfl_xor(v, o);
    return v;
}
__device__ __forceinline__ int win_dest_row(int c) {
    if (c >= 1024) return c;
    const int blk = c >> 9, cc = c & 511, head = cc >> 7, idx = cc & 127, bj = idx >> 6, i = idx & 63;
    return blk * 512 + (head >> 1) * 256 + 128 * bj + (head & 1) * 64 + i;
}
template <bool WIN>
__device__ __forceinline__ void p0_transpose_item(const float* W, int ldw, bf16* WT, int ldt, int koff, LAS float* scr, int k0, int n0, int lane) {
#pragma unroll 8
    for (int i = 0; i < 32; ++i) { const int kk = 2 * i + (lane >> 5); scr[kk * 33 + (lane & 31)] = W[(size_t)(k0 + kk) * ldw + n0 + (lane & 31)]; }
    LDS_WAIT(); asm volatile("" ::: "memory");
    const int c = lane & 7;
#pragma unroll
    for (int j = 0; j < 4; ++j) { const int n = (lane >> 3) + 8 * j; const LAS float* s = scr + (8 * c) * 33 + n;
        const int col = n0 + n; const int drow = WIN ? win_dest_row(col) : col;
        const float sc = (WIN && col >= 512 && col < 1024) ? 0.08838834764831845f : 1.0f;
        v4u o; o.x = pk2(s[0 * 33] * sc, s[1 * 33] * sc); o.y = pk2(s[2 * 33] * sc, s[3 * 33] * sc); o.z = pk2(s[4 * 33] * sc, s[5 * 33] * sc); o.w = pk2(s[6 * 33] * sc, s[7 * 33] * sc);
        *(GAS v4u*)(WT + (size_t)drow * ldt + koff + k0 + 8 * c) = o; }
    LDS_WAIT(); asm volatile("" ::: "memory");
}
__device__ __forceinline__ void p0_prologue(Frame& F) {
    LAS float* scr = (LAS float*)(F.lds + RING_OFF + F.wave * 16384);
    const int gw = F.vcu * NWAVES + F.wave, NGW = F.G * NWAVES;
    constexpr int I_IN = (D / 64) * (NIN / 32), I_SQ = (D / 64) * (D / 32);
    constexpr int NITEMS = I_IN + 3 * I_SQ;
    for (int it = gw; it < NITEMS; it += NGW) {
        int r = it;
        if (r < I_IN) { const int nblk = NIN / 32; p0_transpose_item<true>(F.w_in, NIN, F.WinT, D, 0, scr, 64 * (r / nblk), 32 * (r % nblk), F.lane); continue; } r -= I_IN;
        const int nblk = D / 32, k0 = 64 * ((r % I_SQ) / nblk), n0 = 32 * ((r % I_SQ) % nblk);
        if (r < I_SQ) { p0_transpose_item<false>(F.w_ret, D, F.PcatT, 2 * D, 0, scr, k0, n0, F.lane); continue; }
        if (r < 2 * I_SQ) { p0_transpose_item<false>(F.w_lru, D, F.PcatT, 2 * D, D, scr, k0, n0, F.lane); continue; }
        p0_transpose_item<false>(F.w_out, D, F.WoutT, D, 0, scr, k0, n0, F.lane);
    }
    for (int e = (F.vcu * NWAVES * 64) + F.tid; e < SEQ * 64; e += F.G * NWAVES * 64) {
        const int pos = e >> 6, i = e & 63;
        const double inv = exp(-(double)i * (9.210340371976184 / 64.0));
        const double ang = (double)pos * inv;
        const double n = rint(ang * 0.15915494309189535);
        double r = fma(-n, 6.283185307179586, ang); r = fma(-n, 2.4492935982947064e-16, r);
        const float rf = (float)r;
        typedef float f32x2 __attribute__((ext_vector_type(2)));
        f32x2 cs; cs.x = cosf(rf); cs.y = sinf(rf);
        *(GAS f32x2*)((GAS float*)F.rope + (size_t)e * 2) = cs;
    }
    f32x4 gv[4], bv[4];
#pragma unroll
    for (int j = 0; j < 4; ++j) { gv[j] = *((const GAS f32x4*)F.ln_in_g + F.lane + 64 * j); bv[j] = *((const GAS f32x4*)F.ln_in_b + F.lane + 64 * j); }
    for (int m = gw; m < M; m += NGW) {
        const GAS f32x4* xr = (const GAS f32x4*)(F.x + (size_t)m * D) + F.lane;
        f32x4 v[4]; float s = 0.f;
#pragma unroll
        for (int j = 0; j < 4; ++j) { v[j] = xr[64 * j]; s += (v[j].x + v[j].y) + (v[j].z + v[j].w); }
        const float mean = wave_sum(s) * (1.f / D); float s2 = 0.f;
#pragma unroll
        for (int j = 0; j < 4; ++j) { v[j] = v[j] - mean; s2 += (v[j].x * v[j].x + v[j].y * v[j].y) + (v[j].z * v[j].z + v[j].w * v[j].w); }
        const float rstd = 1.f / sqrtf(wave_sum(s2) * (1.f / D) + LN_EPS);
        GAS v2u* o8 = (GAS v2u*)(F.XN + (size_t)m * D) + F.lane;
#pragma unroll
        for (int j = 0; j < 4; ++j) { const f32x4 y = v[j] * rstd * gv[j] + bv[j]; v2u w; w.x = pk2(y.x, y.y); w.y = pk2(y.z, y.w); o8[64 * j] = w; }
    }
}

__device__ __forceinline__ void ret_simple(Frame& F, int item, float* RAW) {
    const int b = item >> 5, h = (item >> 3) & 3, es = item & 7, t = F.tid;
    LAS float* Qs = (LAS float*)(F.lds);
    LAS float* Ks = Qs + 64 * 129;
    LAS float* Vs = Ks + 64 * 129;
    LAS float* Ps = Vs + 64 * 32;
    LAS float* Ss = Ps + 64 * 65;
    const float lg = log1pf(-exp2f(-5.f - (float)h));
    for (int i = t; i < 128 * 32; i += 512) Ss[i] = 0.f;
    const float cdec = expf(lg * 64.f);
    for (int c = 0; c < NCH; ++c) {
        const size_t m0 = (size_t)b * SEQ + (size_t)c * CH;
        __syncthreads();
#pragma unroll
        for (int k = 0; k < 2; ++k) { const int id = t + 512 * k, row = id >> 4, c8 = id & 15;
            const v4u q = *(const GAS v4u*)(F.Q + (m0 + row) * 512 + h * 128 + c8 * 8), kk = *(const GAS v4u*)(F.K + (m0 + row) * 512 + h * 128 + c8 * 8);
            LAS float* qd = Qs + row * 129 + c8 * 8; LAS float* kd = Ks + row * 129 + c8 * 8;
            qd[0] = bflo(q.x); qd[1] = bfhi(q.x); qd[2] = bflo(q.y); qd[3] = bfhi(q.y); qd[4] = bflo(q.z); qd[5] = bfhi(q.z); qd[6] = bflo(q.w); qd[7] = bfhi(q.w);
            kd[0] = bflo(kk.x); kd[1] = bfhi(kk.x); kd[2] = bflo(kk.y); kd[3] = bfhi(kk.y); kd[4] = bflo(kk.z); kd[5] = bfhi(kk.z); kd[6] = bflo(kk.w); kd[7] = bfhi(kk.w); }
        if (t < 256) { const int row = t >> 2, c8 = t & 3;
            const v4u v = *(const GAS v4u*)(F.V + (m0 + row) * 1024 + h * 256 + es * 32 + c8 * 8);
            LAS float* vd = Vs + row * 32 + c8 * 8;
            vd[0] = bflo(v.x); vd[1] = bfhi(v.x); vd[2] = bflo(v.y); vd[3] = bfhi(v.y); vd[4] = bflo(v.z); vd[5] = bfhi(v.z); vd[6] = bflo(v.w); vd[7] = bfhi(v.w); }
        __syncthreads();
        {
            const int i = t >> 3, jg = t & 7; float a[8];
#pragma unroll
            for (int jj = 0; jj < 8; ++jj) a[jj] = 0.f;
            for (int d = 0; d < 128; ++d) { const float q = Qs[i * 129 + d];
#pragma unroll
                for (int jj = 0; jj < 8; ++jj) a[jj] += q * Ks[(jg * 8 + jj) * 129 + d]; }
#pragma unroll
            for (int jj = 0; jj < 8; ++jj) { const int j = jg * 8 + jj; const int dd = i > j ? i - j : j - i; Ps[i * 65 + j] = a[jj] * expf(lg * (float)dd); }
        }
        __syncthreads();
        {
            const int e = t & 31, ig = t >> 5;
#pragma unroll
            for (int ii = 0; ii < 4; ++ii) { const int i = ig * 4 + ii; float o1 = 0.f, o2 = 0.f;
                for (int j = 0; j < 64; ++j) o1 += Ps[i * 65 + j] * Vs[j * 32 + e];
                for (int d = 0; d < 128; ++d) o2 += Qs[i * 129 + d] * Ss[d * 32 + e];
                RAW[(m0 + i) * 1024 + h * 256 + es * 32 + e] = o1 + expf(lg * (float)(i + 1)) * o2; }
        }
        __syncthreads();
        {
            const int e = t & 31, dg = t >> 5; float a[8];
#pragma unroll
            for (int dd = 0; dd < 8; ++dd) a[dd] = 0.f;
            for (int j = 0; j < 64; ++j) { const float vd = Vs[j * 32 + e] * expf(lg * (float)(63 - j));
#pragma unroll
                for (int dd = 0; dd < 8; ++dd) a[dd] += Ks[j * 129 + dg * 8 + dd] * vd; }
#pragma unroll
            for (int dd = 0; dd < 8; ++dd) { const int d = dg * 8 + dd; Ss[d * 32 + e] = Ss[d * 32 + e] * cdec + a[dd]; }
        }
    }
    __syncthreads();
}

__device__ __forceinline__ void lru_simple(Frame& F, int item) {
    const int b = item >> 5, cb = (item >> 2) & 7, q = item & 3, t = F.tid;
    LAS float* Xs = (LAS float*)(F.lds);
    LAS float* XC = Xs + 67 * 128;
    LAS float* Wa = XC + 64 * 129;
    LAS float* Wx = Wa + 128 * 32;
    LAS float* AA = Wx + 128 * 32;
    LAS float* UU = AA + 64 * 32;
    LAS float* Hc = UU + 64 * 32;
    __syncthreads();
    for (int i = t; i < 128 * 32; i += 512) { const int r = i >> 5, c = i & 31;
        Wa[i] = F.w_rg_a[((size_t)cb * 128 + r) * 128 + q * 32 + c]; Wx[i] = F.w_rg_x[((size_t)cb * 128 + r) * 128 + q * 32 + c]; }
    if (t < 32) Hc[t] = 0.f;
    const int c = t & 31, tg = t >> 5, ch = cb * 128 + q * 32 + c;
    const float ba = F.b_rg_a[ch], bx = F.b_rg_x[ch];
    const float lamv = F.lam[ch];
    const float Lc = -8.0f * log1pf(expf(-lamv));
    for (int tile = 0; tile < SEQ / 64; ++tile) {
        const int t0 = tile * 64; const size_t m0 = (size_t)b * SEQ + t0;
        __syncthreads();
        for (int id = t; id < 67 * 16; id += 512) { const int r = id >> 4, c8 = id & 15; const int s = t0 - 3 + r;
            v4u v = (v4u){0u, 0u, 0u, 0u};
            if (s >= 0) v = *(const GAS v4u*)(F.XL + ((size_t)b * SEQ + s) * 1024 + cb * 128 + c8 * 8);
            LAS float* xd = Xs + r * 128 + c8 * 8;
            xd[0] = bflo(v.x); xd[1] = bfhi(v.x); xd[2] = bflo(v.y); xd[3] = bfhi(v.y); xd[4] = bflo(v.z); xd[5] = bfhi(v.z); xd[6] = bflo(v.w); xd[7] = bfhi(v.w); }
        __syncthreads();
#pragma unroll 4
        for (int k = 0; k < 16; ++k) { const int id = t + 512 * k, tt = id >> 7, i = id & 127, cc = cb * 128 + i;
            float a = F.conv_b[cc];
#pragma unroll
            for (int j = 0; j < 4; ++j) a += F.conv_w[j * 1024 + cc] * Xs[(tt + j) * 128 + i];
            XC[tt * 129 + i] = a; }
        __syncthreads();
#pragma unroll
        for (int k = 0; k < 4; ++k) { const int tt = tg * 4 + k; float rp = ba, ip = bx;
            for (int i = 0; i < 128; ++i) { const float xv = XC[tt * 129 + i]; rp += xv * Wa[i * 32 + c]; ip += xv * Wx[i * 32 + c]; }
            const float r = 1.0f / (1.0f + expf(-rp)), ig = 1.0f / (1.0f + expf(-ip));
            const float la = r * Lc;
            AA[tt * 32 + c] = expf(la);
            UU[tt * 32 + c] = sqrtf(-expm1f(2.0f * la)) * (ig * XC[tt * 129 + q * 32 + c]); }
        __syncthreads();
        if (t < 32) { float hh = Hc[t];
            for (int k = 0; k < 64; ++k) { hh = AA[k * 32 + t] * hh + UU[k * 32 + t]; UU[k * 32 + t] = hh; }
            Hc[t] = hh; }
        __syncthreads();
#pragma unroll
        for (int k = 0; k < 4; ++k) { const int id = t + 512 * k, tt = id >> 5, cc = id & 31; const size_t off = (m0 + tt) * 1024 + cb * 128 + q * 32 + cc;
            F.SGL[off] = (bf16)f2bf(bf2f(F.SGL[off]) * UU[tt * 32 + cc]); }
    }
    __syncthreads();
}

__device__ __forceinline__ void gn_gate(Frame& F, const float* RAW) {
    const int gw = F.vcu * NWAVES + F.wave, NGW = F.G * NWAVES;
    for (int m = gw; m < M; m += NGW) {
        const GAS f32x4* xr = (const GAS f32x4*)(RAW + (size_t)m * D) + F.lane;
        GAS v2u* sg = (GAS v2u*)(F.SGR + (size_t)m * D) + F.lane;
#pragma unroll
        for (int j = 0; j < 4; ++j) {
            f32x4 v = xr[64 * j];
            const float mean = wave_sum((v.x + v.y) + (v.z + v.w)) * (1.f / 256.f);
            v = v - mean;
            const float rstd = 1.f / sqrtf(wave_sum((v.x * v.x + v.y * v.y) + (v.z * v.z + v.w * v.w)) * (1.f / 256.f) + LN_EPS);
            const f32x4 g = *((const GAS f32x4*)F.gn_g + F.lane + 64 * j), bb = *((const GAS f32x4*)F.gn_b + F.lane + 64 * j);
            const f32x4 y = v * rstd * g + bb;
            const v2u s = sg[64 * j]; v2u w;
            w.x = pk2(bflo(s.x) * y.x, bfhi(s.x) * y.y); w.y = pk2(bflo(s.y) * y.z, bfhi(s.y) * y.w);
            sg[64 * j] = w;
        }
    }
}

__device__ __forceinline__ void final_ln(Frame& F) {
    const int gw = F.vcu * NWAVES + F.wave, NGW = F.G * NWAVES;
    for (int m = gw; m < M; m += NGW) {
        const GAS f32x4* xr = (const GAS f32x4*)(F.x + (size_t)m * D) + F.lane;
        GAS f32x4* yr = (GAS f32x4*)(F.out + (size_t)m * D) + F.lane;
        f32x4 v[4]; float s = 0.f;
#pragma unroll
        for (int j = 0; j < 4; ++j) { v[j] = xr[64 * j]; s += (v[j].x + v[j].y) + (v[j].z + v[j].w); }
        float mean = wave_sum(s) * (1.f / D); float s2 = 0.f;
#pragma unroll
        for (int j = 0; j < 4; ++j) { v[j] = v[j] - mean; s2 += (v[j].x * v[j].x + v[j].y * v[j].y) + (v[j].z * v[j].z + v[j].w * v[j].w); }
        float rstd = 1.f / sqrtf(wave_sum(s2) * (1.f / D) + LN_EPS);
        s = 0.f;
#pragma unroll
        for (int j = 0; j < 4; ++j) { const f32x4 g = *((const GAS f32x4*)F.ln_in_g + F.lane + 64 * j), bb = *((const GAS f32x4*)F.ln_in_b + F.lane + 64 * j);
            v[j] = (v[j] * rstd * g + bb) * DN_ALPHA + yr[64 * j]; s += (v[j].x + v[j].y) + (v[j].z + v[j].w); }
        mean = wave_sum(s) * (1.f / D); s2 = 0.f;
#pragma unroll
        for (int j = 0; j < 4; ++j) { v[j] = v[j] - mean; s2 += (v[j].x * v[j].x + v[j].y * v[j].y) + (v[j].z * v[j].z + v[j].w * v[j].w); }
        rstd = 1.f / sqrtf(wave_sum(s2) * (1.f / D) + LN_EPS);
#pragma unroll
        for (int j = 0; j < 4; ++j) { const f32x4 g = *((const GAS f32x4*)F.ln_out_g + F.lane + 64 * j), bb = *((const GAS f32x4*)F.ln_out_b + F.lane + 64 * j);
            yr[64 * j] = v[j] * rstd * g + bb; }
    }
}

struct Args { const float* in[19]; float* out; unsigned char* ws; int ph_lo, ph_hi, li, pad; };
__global__ void __launch_bounds__(NWAVES * 64, 2) fwd_kernel(Args args) {
    extern __shared__ __attribute__((aligned(16))) unsigned char lds[];
    Frame F;
    F.lds = (LAS unsigned char*)lds;
    F.MISC = (volatile LAS unsigned*)(F.lds + MISC_OFF);
    F.tid = threadIdx.x; F.lane = F.tid & 63; F.wave = __builtin_amdgcn_readfirstlane(F.tid >> 6);
    F.G = gridDim.x; { const int bx = blockIdx.x; F.vcu = (F.G % 8 == 0) ? (bx % 8) * (F.G / 8) + bx / 8 : bx; }
    unsigned char* ws = args.ws;
    F.ctl = (gu32*)(ws + WS_CTL);
    F.x = args.in[0]; F.ln_in_g = args.in[1]; F.ln_in_b = args.in[2]; F.w_in = args.in[3]; F.b_merge = args.in[4]; F.gn_g = args.in[5]; F.gn_b = args.in[6]; F.w_ret = args.in[7];
    F.conv_w = args.in[8]; F.conv_b = args.in[9]; F.w_rg_a = args.in[10]; F.b_rg_a = args.in[11]; F.w_rg_x = args.in[12]; F.b_rg_x = args.in[13]; F.lam = args.in[14]; F.w_lru = args.in[15];
    F.w_out = args.in[16]; F.ln_out_g = args.in[17]; F.ln_out_b = args.in[18]; F.out = args.out;
    F.WinT = (bf16*)(ws + WS_WIN); F.PcatT = (bf16*)(ws + WS_PCAT); F.WoutT = (bf16*)(ws + WS_WOUT); F.rope = (float*)(ws + WS_ROPE);
    F.Q = (bf16*)(ws + WS_Q); F.K = (bf16*)(ws + WS_K); F.V = (bf16*)(ws + WS_V); F.SGR = (bf16*)(ws + WS_SGR); F.XL = (bf16*)(ws + WS_XL); F.SGL = (bf16*)(ws + WS_SGL);
    F.GR = (bf16*)(ws + WS_GR); F.GL = (bf16*)(ws + WS_GL); F.MERGED = (bf16*)(ws + WS_MERGED); F.XN = (bf16*)args.out;
    for (int u = F.tid; u < (LDS_BYTES - LDSCTL_OFF) / 4; u += NWAVES * 64) ((LAS unsigned*)(F.lds + LDSCTL_OFF))[u] = 0u;
    __syncthreads();
    XcdBarrier bar; bar.bar = (unsigned*)(F.ctl + CW_BAR); bar.x = 0; bar.st = nullptr;
    if (MK_ONE_LAUNCH) bar = xcd_barrier_post((unsigned*)(F.ctl + CW_BAR), F.MISC + 8);
#define GRID_BAR(seam) do { if (!MK_ONE_LAUNCH) { if (F.tid == 0) __hip_atomic_store(F.ctl + CW_TMO, 0xBADBA0u | (unsigned)(seam), RLX_AGENT); } else { xcd_barrier(bar); } } while (0)
    const int lo = args.ph_lo, hi = args.ph_hi;
#define IN(k) (lo <= (k) && (k) < hi)
#define BOTH(k) (IN(k) && IN((k) + 1))

    if (IN(0)) { p0_prologue(F); if (BOTH(0)) GRID_BAR(0); }

    if (IN(1)) {
        pg8::Gemm g{F.XN, F.WinT, M, NIN, D}; pg8::StaticOrder S; S.init(M, NIN, F.G, (int)blockIdx.x);
        pg8::EpiIn E{F.Q, F.K, F.V, F.SGR, F.XL, F.SGL, F.GR, F.GL, F.rope, F.b_merge};
        pg8::gemm_phase<pg8::EpiIn, pg8::StaticOrder, PG8_ALIGN, PG8_SP2>(F.lds + RING_OFF, g, S, E);
        if (BOTH(1)) GRID_BAR(1);
    }

    if (IN(2)) {
        for (int it = F.vcu; it < 256; it += F.G) ret_simple(F, it, F.out);
        for (int it = F.vcu; it < 256; it += F.G) lru_simple(F, it);
        if (BOTH(2)) GRID_BAR(2);
    }

    if (IN(3)) { gn_gate(F, F.out); if (BOTH(3)) GRID_BAR(3); }

    if (IN(4)) {
        pg8::Gemm g{F.SGR, F.PcatT, M, D, D}; g.ldb = 2 * D; pg8::StaticOrder S; S.init(M, D, F.G, (int)blockIdx.x);
        pg8::EpiGateF32 E{F.out, F.GR, D};
        pg8::gemm_phase<pg8::EpiGateF32, pg8::StaticOrder, PG8_ALIGN, PG8_SP2>(F.lds + RING_OFF, g, S, E);
        if (BOTH(4)) GRID_BAR(4);
    }

    if (IN(5)) {
        pg8::Gemm g{F.SGL, F.PcatT + D, M, D, D}; g.ldb = 2 * D; pg8::StaticOrder S; S.init(M, D, F.G, (int)blockIdx.x);
        pg8::EpiMerge E{F.MERGED, F.out, F.GL, D};
        pg8::gemm_phase<pg8::EpiMerge, pg8::StaticOrder, PG8_ALIGN, PG8_SP2>(F.lds + RING_OFF, g, S, E);
        if (BOTH(5)) GRID_BAR(5);
    }

    if (IN(6)) {
        pg8::Gemm g{F.MERGED, F.WoutT, M, D, D}; pg8::StaticOrder S; S.init(M, D, F.G, (int)blockIdx.x);
        pg8::EpiF32 E{F.out, D};
        pg8::gemm_phase<pg8::EpiF32, pg8::StaticOrder, PG8_ALIGN, PG8_SP2>(F.lds + RING_OFF, g, S, E);
        if (BOTH(6)) GRID_BAR(6);
    }

    if (IN(7)) { final_ln(F); }
#undef IN
#undef BOTH
}

extern "C" void kernel_launch(void* const* d_in, const int* in_sizes, int n_in, void* d_out, int out_size, void* d_ws, size_t ws_size, hipStream_t stream) {
    static int grid = 0;
    if (grid == 0) {
        if (n_in != 19 || in_sizes[0] != M * D || out_size != M * D || ws_size < WS_END) { fprintf(stderr, "kernel_launch: unexpected shapes (n_in %d, in0 %d, out %d, ws %zu); nothing launched\n", n_in, n_in > 0 ? in_sizes[0] : -1, out_size, ws_size); grid = -1; return; }
        int dev = 0, cus = 0, per_cu = 0;
        if (hipGetDevice(&dev) != hipSuccess || hipDeviceGetAttribute(&cus, hipDeviceAttributeMultiprocessorCount, dev) != hipSuccess) { grid = -1; return; }
        if (hipFuncSetAttribute((const void*)fwd_kernel, hipFuncAttributeMaxDynamicSharedMemorySize, LDS_BYTES) != hipSuccess) { fprintf(stderr, "kernel_launch: hipFuncSetAttribute failed\n"); grid = -1; return; }
        if (hipOccupancyMaxActiveBlocksPerMultiprocessor(&per_cu, (const void*)fwd_kernel, NWAVES * 64, LDS_BYTES) != hipSuccess || per_cu < 1) { fprintf(stderr, "kernel_launch: occupancy query reports %d\n", per_cu); per_cu = 1; }
        (void)hipGetLastError();
        grid = cus;
    }
    if (grid < 0) return;
    if (hipMemsetAsync((char*)d_ws + WS_CTL, 0, CTL_ZERO_BYTES, stream) != hipSuccess) return;
    Args a{};
    for (int i = 0; i < 19; ++i) a.in[i] = (const float*)d_in[i];
    a.out = (float*)d_out; a.ws = (unsigned char*)d_ws;
    const int nl = MK_ONE_LAUNCH ? 1 : NPHASES;
    for (int li = 0; li < nl; ++li) {
        a.ph_lo = MK_ONE_LAUNCH ? 0 : li; a.ph_hi = MK_ONE_LAUNCH ? NPHASES : li + 1; a.li = li;
        hipLaunchKernelGGL(fwd_kernel, dim3(grid), dim3(NWAVES * 64), LDS_BYTES, stream, a);
        if (hipPeekAtLastError() != hipSuccess) break;
    }
}
```

```cpp
#include <hip/hip_runtime.h>
#include <cstdio>
#include <cstdint>
namespace pg8 {
#define PG8_LAS __attribute__((address_space(3)))
typedef unsigned short bf16_t;
typedef short bf16x8 __attribute__((ext_vector_type(8)));
typedef float f32x4 __attribute__((ext_vector_type(4)));
typedef unsigned u32x4 __attribute__((ext_vector_type(4)));
constexpr int BM = 256, BK = 64, HALF = 128, HTB = HALF * BK * 2  , STAGE_BYTES = 8 * HTB, NXCD = 8, WGM = 8;

__host__ __device__ __forceinline__ int lds_byte(int r, int c) { const int st = (r >> 4) * 2 + (c >> 5), rr = r & 15, cc = c & 31, ob = rr * 64 + cc * 2; return st * 1024 + (ob ^ (((ob >> 9) & 1) << 5)); }
__host__ __device__ __forceinline__ void stage_rc(int b, int& R, int& C) { const int st = b / 1024, sb = b % 1024, swz = sb ^ (((sb >> 9) & 1) << 5); R = (st >> 1) * 16 + swz / 64; C = (st & 1) * 32 + (swz % 64) / 2; }
__host__ __device__ __forceinline__ int perm32(int rho) { const int n = rho >> 4, i = rho & 15; return 8 * (i >> 2) + 4 * n + (i & 3); }

struct Unit { int pm, pn; };
struct Gemm { const bf16_t* A; const bf16_t* Bt; int M, N, K; int lda = 0, ldb = 0; };

struct StaticOrder {
    int nM, nN, nwg, G, c;
    __host__ __device__ void init(int M, int N, int G_, int c_) { nM = M / BM; nN = N / BM; nwg = nM * nN; G = G_; c = c_; }
    __host__ __device__ bool next(int i, Unit& u) const {
        const long L = (long)i * G + c; if (L >= nwg) return false;
        int wgid = (int)L; { const int q = nwg / NXCD, r = nwg % NXCD, xcd = wgid % NXCD, off = wgid / NXCD; wgid = (xcd < r ? xcd * (q + 1) : r * (q + 1) + (xcd - r) * q) + off; }
        const int nig = WGM * nN, gid = wgid / nig, fm = gid * WGM, gsz = (nM - fm) < WGM ? (nM - fm) : WGM;
        u.pm = fm + ((wgid % nig) % gsz); u.pn = (wgid % nig) / gsz; return true;
    }
    __device__ __forceinline__ void a_ready(const Unit&) const {}
    __device__ __forceinline__ void done(const Unit&) const {}
};

__device__ __forceinline__ unsigned cvt_pk_bf16(float lo, float hi) { unsigned r; asm volatile("v_cvt_pk_bf16_f32 %0, %1, %2" : "=v"(r) : "v"(lo), "v"(hi)); return r; }
typedef unsigned u32x2 __attribute__((ext_vector_type(2)));
__device__ __forceinline__ float bf_lo(unsigned w) { return __builtin_bit_cast(float, w << 16); }
__device__ __forceinline__ float bf_hi(unsigned w) { return __builtin_bit_cast(float, w & 0xffff0000u); }
__device__ __forceinline__ float fast_sigmoid(float x) { return __builtin_amdgcn_rcpf(1.0f + __builtin_amdgcn_exp2f(-1.4426950408889634f * x)); }

struct EpiF32 {
    static constexpr bool PERM = false, AFTER_DRAIN = false;
    float* C; int ldc;
    __device__ __forceinline__ void operator()(const f32x4 (&acc)[2][2][4][2], const Unit& u, int wr, int wc, int fr, int fq) const {
        const int row0 = u.pm * BM + wr * 64 + fr, col0 = u.pn * BM + wc * 32 + 4 * fq;
#pragma unroll
        for (int ai = 0; ai < 2; ++ai)
#pragma unroll
            for (int m = 0; m < 4; ++m) { float* rowp = C + (size_t)(row0 + ai * HALF + m * 16) * ldc + col0;
#pragma unroll
                for (int bj = 0; bj < 2; ++bj)
#pragma unroll
                    for (int n = 0; n < 2; ++n) *(f32x4*)(rowp + bj * HALF + n * 16) = acc[ai][bj][m][n]; }
    }
};
struct EpiGateF32 {
    static constexpr bool PERM = false, AFTER_DRAIN = false;
    float* C; const bf16_t* G; int ldc;
    __device__ __forceinline__ void operator()(const f32x4 (&acc)[2][2][4][2], const Unit& u, int wr, int wc, int fr, int fq) const {
        const int row0 = u.pm * BM + wr * 64 + fr, col0 = u.pn * BM + wc * 32 + 4 * fq;
#pragma unroll
        for (int ai = 0; ai < 2; ++ai)
#pragma unroll
            for (int m = 0; m < 4; ++m) { const size_t off = (size_t)(row0 + ai * HALF + m * 16) * ldc + col0;
#pragma unroll
                for (int bj = 0; bj < 2; ++bj)
#pragma unroll
                    for (int n = 0; n < 2; ++n) { const u32x2 g = *(const u32x2*)(G + off + bj * HALF + n * 16); const f32x4 a = acc[ai][bj][m][n];
                        f32x4 o; o[0] = bf_lo(g.x) * a[0]; o[1] = bf_hi(g.x) * a[1]; o[2] = bf_lo(g.y) * a[2]; o[3] = bf_hi(g.y) * a[3];
                        *(f32x4*)(C + off + bj * HALF + n * 16) = o; } }
    }
};
struct EpiMerge {
    static constexpr bool PERM = true, AFTER_DRAIN = false;
    bf16_t* O; const float* T1; const bf16_t* G; int ldc;
    __device__ __forceinline__ void operator()(const f32x4 (&acc)[2][2][4][2], const Unit& u, int wr, int wc, int fr, int fq) const {
        const int row0 = u.pm * BM + wr * 64 + fr, col0 = u.pn * BM + wc * 32 + 8 * fq;
#pragma unroll
        for (int ai = 0; ai < 2; ++ai)
#pragma unroll
            for (int m = 0; m < 4; ++m) { const size_t off = (size_t)(row0 + ai * HALF + m * 16) * ldc + col0;
#pragma unroll
                for (int bj = 0; bj < 2; ++bj) { const u32x4 g = *(const u32x4*)(G + off + bj * HALF);
                    const f32x4 t0 = *(const f32x4*)(T1 + off + bj * HALF), t1 = *(const f32x4*)(T1 + off + bj * HALF + 4);
                    const f32x4 a0 = acc[ai][bj][m][0], a1 = acc[ai][bj][m][1];
                    u32x4 w;
                    w.x = cvt_pk_bf16(t0[0] + bf_lo(g.x) * a0[0], t0[1] + bf_hi(g.x) * a0[1]);
                    w.y = cvt_pk_bf16(t0[2] + bf_lo(g.y) * a0[2], t0[3] + bf_hi(g.y) * a0[3]);
                    w.z = cvt_pk_bf16(t1[0] + bf_lo(g.z) * a1[0], t1[1] + bf_hi(g.z) * a1[1]);
                    w.w = cvt_pk_bf16(t1[2] + bf_lo(g.w) * a1[2], t1[3] + bf_hi(g.w) * a1[3]);
                    *(u32x4*)(O + off + bj * HALF) = w; } }
    }
};
struct EpiIn {
    static constexpr bool PERM = true, AFTER_DRAIN = false;
    bf16_t *Q, *Kb, *V, *SGR, *XL, *SGL, *GR, *GL; const float* rope; const float* bmerge;
    __device__ __forceinline__ void operator()(const f32x4 (&acc)[2][2][4][2], const Unit& u, int wr, int wc, int fr, int fq) const {
        const int row0 = u.pm * BM + wr * 64 + fr; const int pn = u.pn;
        if (pn < 4) {
            bf16_t* base = (pn < 2) ? Q : Kb; const int head = 2 * (pn & 1) + (wc >> 1), i0 = 32 * (wc & 1) + 8 * fq;
#pragma unroll
            for (int ai = 0; ai < 2; ++ai)
#pragma unroll
                for (int m = 0; m < 4; ++m) { const int row = row0 + ai * HALF + m * 16, pos = row & 8191;
                    const f32x4* cs = (const f32x4*)(rope + ((size_t)pos * 64 + i0) * 2);
                    const f32x4 c0 = cs[0], c1 = cs[1], c2 = cs[2], c3 = cs[3];
                    const f32x4 xa = acc[ai][0][m][0], xb = acc[ai][0][m][1], ya = acc[ai][1][m][0], yb = acc[ai][1][m][1];
                    u32x4 o1, o2;
                    o1.x = cvt_pk_bf16(xa[0] * c0[0] - ya[0] * c0[1], xa[1] * c0[2] - ya[1] * c0[3]);
                    o1.y = cvt_pk_bf16(xa[2] * c1[0] - ya[2] * c1[1], xa[3] * c1[2] - ya[3] * c1[3]);
                    o1.z = cvt_pk_bf16(xb[0] * c2[0] - yb[0] * c2[1], xb[1] * c2[2] - yb[1] * c2[3]);
                    o1.w = cvt_pk_bf16(xb[2] * c3[0] - yb[2] * c3[1], xb[3] * c3[2] - yb[3] * c3[3]);
                    o2.x = cvt_pk_bf16(ya[0] * c0[0] + xa[0] * c0[1], ya[1] * c0[2] + xa[1] * c0[3]);
                    o2.y = cvt_pk_bf16(ya[2] * c1[0] + xa[2] * c1[1], ya[3] * c1[2] + xa[3] * c1[3]);
                    o2.z = cvt_pk_bf16(yb[0] * c2[0] + xb[0] * c2[1], yb[1] * c2[2] + xb[1] * c2[3]);
                    o2.w = cvt_pk_bf16(yb[2] * c3[0] + xb[2] * c3[1], yb[3] * c3[2] + xb[3] * c3[3]);
                    bf16_t* rp = base + (size_t)row * 512 + head * 128 + i0;
                    *(u32x4*)rp = o1; *(u32x4*)(rp + 64) = o2; }
        } else {
            const int ty = (pn - 4) >> 2, colt = ((pn - 4) & 3) * BM, col0 = colt + wc * 32 + 8 * fq;
            bf16_t* base = ty == 0 ? V : ty == 1 ? SGR : ty == 2 ? XL : ty == 3 ? SGL : ty == 4 ? GR : GL;
            f32x4 bv[2][2];
#pragma unroll
            for (int bj = 0; bj < 2; ++bj)
#pragma unroll
                for (int n = 0; n < 2; ++n) bv[bj][n] = (ty >= 4) ? *(const f32x4*)(bmerge + (ty - 4) * 1024 + col0 + bj * HALF + 4 * n) : (f32x4){0.f, 0.f, 0.f, 0.f};
#pragma unroll
            for (int ai = 0; ai < 2; ++ai)
#pragma unroll
                for (int m = 0; m < 4; ++m) { bf16_t* rowp = base + (size_t)(row0 + ai * HALF + m * 16) * 1024 + col0;
#pragma unroll
                    for (int bj = 0; bj < 2; ++bj) { f32x4 v0 = acc[ai][bj][m][0] + bv[bj][0], v1 = acc[ai][bj][m][1] + bv[bj][1];
                        if (ty == 1 || ty == 3) {
#pragma unroll
                            for (int j = 0; j < 4; ++j) { v0[j] = v0[j] * fast_sigmoid(v0[j]); v1[j] = v1[j] * fast_sigmoid(v1[j]); } }
                        if (ty >= 4) {
#pragma unroll
                            for (int j = 0; j < 4; ++j) { v0[j] = fast_sigmoid(v0[j]); v1[j] = fast_sigmoid(v1[j]); } }
                        u32x4 w; w.x = cvt_pk_bf16(v0[0], v0[1]); w.y = cvt_pk_bf16(v0[2], v0[3]); w.z = cvt_pk_bf16(v1[0], v1[1]); w.w = cvt_pk_bf16(v1[2], v1[3]);
                        *(u32x4*)(rowp + bj * HALF) = w; } }
        }
    }
};

template <class Epi, class Sched, bool ALIGN_EPI = false, bool SP2 = false>
__device__ __forceinline__ void gemm_phase(PG8_LAS unsigned char* lds, const Gemm g, const Sched& S, const Epi& E) {
    const int tid = threadIdx.x, wid = __builtin_amdgcn_readfirstlane(tid >> 6), lane = tid & 63, wr = wid >> 2, wc = wid & 3, fr = lane & 15, fq = lane >> 4;
    const int K = g.K, nt = K / BK, lda = g.lda ? g.lda : K, ldb = g.ldb ? g.ldb : K;
    unsigned voffA[2], voffB[2];
#pragma unroll
    for (int i = 0; i < 2; ++i) { int R, C; stage_rc(tid * 16 + i * 8192, R, C); const int Rb = Epi::PERM ? ((R & ~31) + perm32(R & 31)) : R;
        voffA[i] = (unsigned)(R * lda + C) * 2u; voffB[i] = (unsigned)(Rb * ldb + C) * 2u; }
    const size_t kstep = (size_t)(BK * 2);
    const size_t hstepA = (size_t)HALF * lda * 2, hstepB = (size_t)HALF * ldb * 2;
    const size_t tstepA = 2 * hstepA, tstepB = 2 * hstepB;
    const unsigned ldsw = (unsigned)wid * 1024u;
    const int aoff = lds_byte(wr * 64 + fr, fq * 8), boff = lds_byte(wc * 32 + fr, fq * 8);
#define PG8_SA(b, h) (((b) * 2 + (h)) * HTB)
#define PG8_SB(b, h) ((4 + (b) * 2 + (h)) * HTB)
#define PG8_STAGE(bufoff, gbase, voff) do { _Pragma("unroll") for (int _i = 0; _i < 2; ++_i) \
        __builtin_amdgcn_global_load_lds((const unsigned*)((const char*)(gbase) + (voff)[_i]), (PG8_LAS unsigned*)(lds + (bufoff) + ldsw + _i * 8192), 16, 0, 0); } while (0)
#define PG8_LDA(dst, b, h) do { _Pragma("unroll") for (int m = 0; m < 4; ++m) _Pragma("unroll") for (int k = 0; k < 2; ++k) dst[m][k] = *(const PG8_LAS bf16x8*)(lds + PG8_SA(b, h) + aoff + m * 2048 + k * 1024); } while (0)
#define PG8_LDB(dst, b, h) do { _Pragma("unroll") for (int n = 0; n < 2; ++n) _Pragma("unroll") for (int k = 0; k < 2; ++k) dst[n][k] = *(const PG8_LAS bf16x8*)(lds + PG8_SB(b, h) + boff + n * 2048 + k * 1024); } while (0)
#define PG8_MMA(ai, bj, At, Bt) do { __builtin_amdgcn_s_setprio(1); _Pragma("unroll") for (int m = 0; m < 4; ++m) _Pragma("unroll") for (int n = 0; n < 2; ++n) _Pragma("unroll") for (int k = 0; k < 2; ++k) \
        acc[ai][bj][m][n] = __builtin_amdgcn_mfma_f32_16x16x32_bf16(Bt[n][k], At[m][k], acc[ai][bj][m][n], 0, 0, 0); __builtin_amdgcn_s_setprio(0); } while (0)
#define PG8_WAIT_V(n) asm volatile("s_waitcnt vmcnt(" #n ")" ::: "memory")
#define PG8_WAIT_L(n) asm volatile("s_waitcnt lgkmcnt(" #n ")" ::: "memory")
#define PG8_BAR __builtin_amdgcn_s_barrier()
#define PG8_SCHED __builtin_amdgcn_sched_barrier(0)
    Unit cur, nxt; int ui = 0;
    if (!S.next(0, cur)) return;
    f32x4 acc[2][2][4][2];
#pragma unroll
    for (int a = 0; a < 2; ++a)
#pragma unroll
        for (int b = 0; b < 2; ++b)
#pragma unroll
            for (int m = 0; m < 4; ++m)
#pragma unroll
                for (int n = 0; n < 2; ++n) acc[a][b][m][n] = (f32x4){0.f, 0.f, 0.f, 0.f};
    bf16x8 At[4][2], B0[2][2], B1[2][2];
    const char* cA = (const char*)g.A + (size_t)cur.pm * tstepA; const char* cB = (const char*)g.Bt + (size_t)cur.pn * tstepB;
    S.a_ready(cur);
    if constexpr (SP2) {
        PG8_STAGE(PG8_SB(0, 0), cB, voffB); PG8_STAGE(PG8_SB(0, 1), cB + hstepB, voffB); PG8_STAGE(PG8_SA(0, 0), cA, voffA); PG8_STAGE(PG8_SA(0, 1), cA + hstepA, voffA);
        if (wr == 1) PG8_BAR;
        PG8_WAIT_V(2); PG8_BAR;
        PG8_STAGE(PG8_SB(1, 0), cB + kstep, voffB); PG8_STAGE(PG8_SA(1, 0), cA + kstep, voffA); PG8_STAGE(PG8_SB(1, 1), cB + hstepB + kstep, voffB);
        PG8_WAIT_V(6); PG8_BAR;
    } else {
        PG8_STAGE(PG8_SB(0, 0), cB, voffB); PG8_STAGE(PG8_SA(0, 0), cA, voffA); PG8_STAGE(PG8_SB(0, 1), cB + hstepB, voffB); PG8_STAGE(PG8_SA(0, 1), cA + hstepA, voffA);
        if (wr == 1) PG8_BAR;
        PG8_WAIT_V(4); PG8_BAR;
        PG8_STAGE(PG8_SB(1, 0), cB + kstep, voffB); PG8_STAGE(PG8_SA(1, 0), cA + kstep, voffA); PG8_STAGE(PG8_SB(1, 1), cB + hstepB + kstep, voffB);
        PG8_WAIT_V(6); PG8_BAR;
    }
    for (;;) {
        const bool has_next = S.next(ui + 1, nxt);
        const char* nA = has_next ? (const char*)g.A + (size_t)nxt.pm * tstepA : cA; const char* nB = has_next ? (const char*)g.Bt + (size_t)nxt.pn * tstepB : cB;
        for (int t = 0; t < nt; t += 2) {
            const bool last = (t == nt - 2);
            const char* a1 = cA + (size_t)(t + 1) * kstep;
            const char* a2 = last ? nA : cA + (size_t)(t + 2) * kstep; const char* b2 = last ? nB : cB + (size_t)(t + 2) * kstep;
            const char* a3 = a2 + kstep; const char* b3 = b2 + kstep;
            if (last && has_next) S.a_ready(nxt);
            if constexpr (SP2) {
            PG8_LDB(B0, 0, 0); PG8_LDB(B1, 0, 1); PG8_SCHED; PG8_LDA(At, 0, 0); PG8_STAGE(PG8_SA(1, 1), a1 + hstepA, voffA);
            PG8_WAIT_V(8); PG8_WAIT_L(0); PG8_BAR; PG8_MMA(0, 0, At, B0); PG8_MMA(0, 1, At, B1); PG8_BAR; PG8_SCHED;
            PG8_LDA(At, 0, 1); PG8_STAGE(PG8_SB(0, 0), b2, voffB); PG8_STAGE(PG8_SB(0, 1), b2 + hstepB, voffB); PG8_STAGE(PG8_SA(0, 0), a2, voffA);
            PG8_WAIT_V(8); PG8_WAIT_L(0); PG8_BAR; PG8_MMA(1, 0, At, B0); PG8_MMA(1, 1, At, B1); PG8_BAR; PG8_SCHED;
            PG8_LDB(B0, 1, 0); PG8_LDB(B1, 1, 1); PG8_SCHED; PG8_LDA(At, 1, 0); PG8_STAGE(PG8_SA(0, 1), a2 + hstepA, voffA);
            PG8_WAIT_V(8); PG8_WAIT_L(0); PG8_BAR; PG8_MMA(0, 0, At, B0); PG8_MMA(0, 1, At, B1); PG8_BAR; PG8_SCHED;
            PG8_LDA(At, 1, 1); PG8_STAGE(PG8_SB(1, 0), b3, voffB); PG8_STAGE(PG8_SB(1, 1), b3 + hstepB, voffB); PG8_STAGE(PG8_SA(1, 0), a3, voffA);
            PG8_WAIT_V(8); PG8_WAIT_L(0); PG8_BAR; PG8_MMA(1, 0, At, B0); PG8_MMA(1, 1, At, B1); PG8_BAR; PG8_SCHED;
            } else {
            PG8_LDB(B0, 0, 0); PG8_SCHED; PG8_LDA(At, 0, 0); PG8_STAGE(PG8_SA(1, 1), a1 + hstepA, voffA);
            PG8_WAIT_L(8); PG8_BAR; PG8_WAIT_L(0); PG8_MMA(0, 0, At, B0); PG8_BAR; PG8_SCHED;
            PG8_LDB(B1, 0, 1); PG8_STAGE(PG8_SB(0, 0), b2, voffB);
            PG8_BAR; PG8_WAIT_L(0); PG8_MMA(0, 1, At, B1); PG8_BAR;
            PG8_LDA(At, 0, 1); PG8_STAGE(PG8_SA(0, 0), a2, voffA);
            PG8_BAR; PG8_WAIT_L(0); PG8_MMA(1, 0, At, B0); PG8_BAR; PG8_SCHED;
            PG8_STAGE(PG8_SB(0, 1), b2 + hstepB, voffB);
            PG8_WAIT_V(6); PG8_BAR; PG8_MMA(1, 1, At, B1); PG8_BAR;
            PG8_LDB(B0, 1, 0); PG8_SCHED; PG8_LDA(At, 1, 0); PG8_STAGE(PG8_SA(0, 1), a2 + hstepA, voffA);
            PG8_WAIT_L(8); PG8_BAR; PG8_WAIT_L(0); PG8_MMA(0, 0, At, B0); PG8_BAR; PG8_SCHED;
            PG8_LDB(B1, 1, 1); PG8_STAGE(PG8_SB(1, 0), b3, voffB);
            PG8_BAR; PG8_WAIT_L(0); PG8_MMA(0, 1, At, B1); PG8_BAR;
            PG8_LDA(At, 1, 1); PG8_STAGE(PG8_SA(1, 0), a3, voffA);
            PG8_BAR; PG8_WAIT_L(0); PG8_MMA(1, 0, At, B0); PG8_BAR; PG8_SCHED;
            PG8_STAGE(PG8_SB(1, 1), b3 + hstepB, voffB);
            PG8_WAIT_V(6); PG8_BAR; PG8_MMA(1, 1, At, B1); PG8_BAR;
            }
        }
        if constexpr (ALIGN_EPI) { if (wr == 0) PG8_BAR; }
        if constexpr (!Epi::AFTER_DRAIN) { E(acc, cur, wr, wc, fr, fq); S.done(cur); }
        if (!has_next) break;
#pragma unroll
        for (int a = 0; a < 2; ++a)
#pragma unroll
            for (int b = 0; b < 2; ++b)
#pragma unroll
                for (int m = 0; m < 4; ++m)
#pragma unroll
                    for (int n = 0; n < 2; ++n) acc[a][b][m][n] = (f32x4){0.f, 0.f, 0.f, 0.f};
        cur = nxt; cA = nA; cB = nB; ++ui;
        if constexpr (ALIGN_EPI) { if (wr == 1) PG8_BAR; }
    }
    PG8_WAIT_V(0);
    if constexpr (!ALIGN_EPI) { if (wr == 0) PG8_BAR; }
    PG8_BAR;
    if constexpr (Epi::AFTER_DRAIN) { E.fused(acc, cur, wr, wc, fr, fq, lds, wid, lane); S.done(cur); }
#undef PG8_SA
#undef PG8_SB
#undef PG8_STAGE
#undef PG8_LDA
#undef PG8_LDB
#undef PG8_MMA
#undef PG8_WAIT_V
#undef PG8_WAIT_L
#undef PG8_BAR
#undef PG8_SCHED
}
}

#ifndef PG8_SP2
#define PG8_SP2 true
#endif
#ifndef PG8_ALIGN
#define PG8_ALIGN true
#endif

constexpr int NWAVES = 8;
#ifndef MK_ONE_LAUNCH
#define MK_ONE_LAUNCH 1
#endif
constexpr int NPHASES = 8;

constexpr int BATCH = 8, SEQ = 8192, D = 1024, M = BATCH * SEQ, NIN = 7168;
constexpr int RH = 4, DK = 128, DV = 256, CH = 64, NCH = SEQ / CH;
constexpr float LN_EPS = 1e-5f;
constexpr float DN_ALPHA = 1.189207115002721f;

constexpr size_t MiB = 1u << 20;
constexpr size_t WS_CTL = 0, CTL_ZERO_BYTES = 1 * MiB;
constexpr size_t WS_WIN = 2 * MiB;
constexpr size_t WS_PCAT = 16 * MiB;
constexpr size_t WS_WOUT = 20 * MiB;
constexpr size_t WS_ROPE = 22 * MiB;
constexpr size_t WS_Q = 32 * MiB, WS_K = 96 * MiB, WS_V = 160 * MiB, WS_SGR = 288 * MiB, WS_XL = 416 * MiB, WS_SGL = 544 * MiB, WS_GR = 672 * MiB, WS_GL = 800 * MiB, WS_END = 928 * MiB;
constexpr size_t WS_SLOC = 928 * MiB, WS_END2 = 960 * MiB;
constexpr size_t WS_MERGED = WS_Q;
constexpr int CW_TMO = 0, CW_CODE = 1, CW_BAR = 4096;

constexpr int RING_OFF = 0, RING_BYTES = 131072;
constexpr int LDSCTL_OFF = RING_BYTES, MISC_OFF = LDSCTL_OFF + 320;
constexpr int LDS_BYTES = 147456;
static_assert(MISC_OFF + 128 <= LDS_BYTES, "LDS map");

#define GAS __attribute__((address_space(1)))
#define LAS __attribute__((address_space(3)))
typedef unsigned short bf16;
typedef unsigned v4u __attribute__((ext_vector_type(4)));
typedef unsigned v2u __attribute__((ext_vector_type(2)));
typedef float f32x4 __attribute__((ext_vector_type(4)));
typedef GAS unsigned gu32;
#define RLX_AGENT __ATOMIC_RELAXED, __HIP_MEMORY_SCOPE_AGENT
#define LDS_WAIT() asm volatile("s_waitcnt lgkmcnt(0)" ::: "memory")
#define VM_WAIT() asm volatile("s_waitcnt vmcnt(0)" ::: "memory")
__device__ __forceinline__ unsigned f2bf(float f) { unsigned u = __builtin_bit_cast(unsigned, f); return (u + 0x7fffu + ((u >> 16) & 1u)) >> 16; }
__device__ __forceinline__ unsigned pk2(float lo, float hi) { return f2bf(lo) | (f2bf(hi) << 16); }
__device__ __forceinline__ float bflo(unsigned w) { return __builtin_bit_cast(float, w << 16); }
__device__ __forceinline__ float bfhi(unsigned w) { return __builtin_bit_cast(float, w & 0xffff0000u); }
__device__ __forceinline__ float bf2f(bf16 b) { return __builtin_bit_cast(float, ((unsigned)b) << 16); }

#define XB_TMO      128
#define XB_XCNT(j)  (256  + 64 * (j))
#define XB_XSUB(j)  (1280 + 64 * (j))
#define XB_XGEN(j)  (2304 + 64 * (j))
#define XB_TOP      3328
#define XB_TOPGEN   3392
#define XCD_BAR_WORDS 3456
#define XB_SPIN_CAP (1u << 18)

__device__ __forceinline__ unsigned xb_ld(unsigned* p)              { return __hip_atomic_load(p, __ATOMIC_RELAXED, __HIP_MEMORY_SCOPE_AGENT); }
__device__ __forceinline__ unsigned xb_add(unsigned* p, unsigned v) { return __hip_atomic_fetch_add(p, v, __ATOMIC_RELAXED, __HIP_MEMORY_SCOPE_AGENT); }
__device__ __forceinline__ unsigned xb_xcc_id() { return (unsigned)__builtin_amdgcn_s_getreg((3 << 11) | 20) & 0xFu; }
#define XB_SPIN(cond, bar) do { unsigned _sp = 0; while (cond) { __builtin_amdgcn_s_sleep(1); \
    if ((++_sp & 255u) == 0u) { if (xb_ld(&(bar)[XB_TMO])) break; if (_sp > XB_SPIN_CAP) { atomicAdd(&(bar)[XB_TMO], 1u); break; } } } } while (0)

struct XcdBarrier {
    unsigned* bar; unsigned x;
    volatile LAS unsigned* st;
};

__device__ __forceinline__ XcdBarrier xcd_barrier_post(unsigned* bar, volatile LAS unsigned* st) {
    XcdBarrier b; b.bar = bar; b.x = xb_xcc_id(); b.st = st;
    if (threadIdx.x == 0) (void)xb_add(&bar[XB_XCNT(b.x)], 1u);
    return b;
}
__device__ __forceinline__ void xcd_barrier_complete(unsigned* bar, unsigned x, unsigned& nloc, unsigned& nx) {
    const unsigned G = gridDim.x * gridDim.y * gridDim.z;
    unsigned sum, cnt, mine, sp = 0u;
    for (;;) {
        sum = 0u; cnt = 0u; mine = 0u;
#pragma unroll
        for (unsigned j = 0; j < 16; ++j) { const unsigned c = xb_ld(&bar[XB_XCNT(j)]); sum += c; cnt += (c > 0u) ? 1u : 0u; mine = (j == x) ? c : mine; }
        if (sum == G) break;
        __builtin_amdgcn_s_sleep(1);
        if ((++sp & 255u) == 0u) { if (xb_ld(&bar[XB_TMO])) break; if (sp > XB_SPIN_CAP) { atomicAdd(&bar[XB_TMO], 1u); break; } }
    }
    nloc = mine > 0u ? mine : 1u; nx = cnt > 0u ? cnt : 1u;
}

__device__ __forceinline__ void xcd_barrier(const XcdBarrier& b) {
    asm volatile("s_waitcnt vmcnt(0)" ::: "memory");
    __syncthreads();
    if (threadIdx.x == 0) {
        unsigned* bar = b.bar;
        __builtin_amdgcn_s_waitcnt(0);
        unsigned nloc = b.st[0], nx = b.st[1];
        if (nloc == 0u) { xcd_barrier_complete(bar, b.x, nloc, nx); b.st[0] = nloc; b.st[1] = nx; }
        const unsigned old = xb_add(&bar[XB_XSUB(b.x)], 1u);
        const unsigned gen = old / nloc;
        if (old + 1u == (gen + 1u) * nloc) {
            __builtin_amdgcn_fence(__ATOMIC_RELEASE, "agent");
            asm volatile("s_waitcnt vmcnt(0)" ::: "memory");
            const unsigned og = xb_add(&bar[XB_TOP], 1u);
            const unsigned tg = og / nx;
            if (og + 1u == (tg + 1u) * nx) xb_add(&bar[XB_TOPGEN], 1u);
            else XB_SPIN(xb_ld(&bar[XB_TOPGEN]) == tg, bar);
            __builtin_amdgcn_fence(__ATOMIC_ACQUIRE, "agent");
            xb_add(&bar[XB_XGEN(b.x)], 1u);
            asm volatile("s_waitcnt vmcnt(0)" ::: "memory");
        } else {
            XB_SPIN(xb_ld(&bar[XB_XGEN(b.x)]) == gen, bar);
            __builtin_amdgcn_fence(__ATOMIC_ACQUIRE, "agent");
            asm volatile("s_waitcnt vmcnt(0)" ::: "memory");
        }
    }
    __syncthreads();
}


namespace rt {
#define RT_DI __device__ __forceinline__
typedef short bf16x8 __attribute__((ext_vector_type(8)));
typedef short s16x4 __attribute__((ext_vector_type(4)));
typedef short v4i16_t __attribute__((ext_vector_type(4)));
typedef float f32x16 __attribute__((ext_vector_type(16)));
typedef float f32x2_t __attribute__((ext_vector_type(2)));
typedef __bf16 bf16x2_t __attribute__((ext_vector_type(2)));
typedef LAS const char* lds_cptr;
constexpr int NSEG = 8, CPS = NCH / NSEG;
constexpr int L_QT = 0, L_KT = 16384, L_VT = 32768, L_PT = 65536, L_ST = 73728, L_GB = 77824;
RT_DI unsigned cvtpk(float lo, float hi) { f32x2_t v = {lo, hi}; bf16x2_t b = __builtin_convertvector(v, bf16x2_t); return __builtin_bit_cast(unsigned, b); }
RT_DI unsigned off_b(unsigned row, unsigned ch) { return 256u * row + 16u * (ch ^ (((row & 3u) << 2) | ((row >> 2) & 3u))); }
RT_DI unsigned off_p(unsigned row, unsigned ch) { return 128u * row + 16u * (ch ^ ((row >> 1) & 7u)); }
RT_DI s16x4 trd(lds_cptr p) { return __builtin_bit_cast(s16x4, __builtin_amdgcn_ds_read_tr16_b64_v4i16((LAS v4i16_t*)p)); }
RT_DI bf16x8 tr8(lds_cptr tile, unsigned lane, unsigned c, unsigned ks) {
    const unsigned hh = lane >> 5, blk = (lane >> 4) & 1u, q = (lane & 15u) >> 2, p = lane & 3u;
    const s16x4 lo = trd(tile + off_b(16 * ks + 8 * hh + q, 4 * c + 2 * blk + (p >> 1)) + 8 * (p & 1u));
    const s16x4 hi = trd(tile + off_b(16 * ks + 8 * hh + 4 + q, 4 * c + 2 * blk + (p >> 1)) + 8 * (p & 1u));
    return __builtin_shufflevector(lo, hi, 0, 1, 2, 3, 4, 5, 6, 7);
}
RT_DI bf16x8 scale_frag(bf16x8 v, const float (&f)[8]) {
    const v4u w = __builtin_bit_cast(v4u, v); v4u o;
    o.x = cvtpk(bflo(w.x) * f[0], bfhi(w.x) * f[1]); o.y = cvtpk(bflo(w.y) * f[2], bfhi(w.y) * f[3]);
    o.z = cvtpk(bflo(w.z) * f[4], bfhi(w.z) * f[5]); o.w = cvtpk(bflo(w.w) * f[6], bfhi(w.w) * f[7]);
    return __builtin_bit_cast(bf16x8, o);
}
RT_DI bf16x8 pack8(const f32x16& x, int s) {
    v4u o; o.x = cvtpk(x[8 * s], x[8 * s + 1]); o.y = cvtpk(x[8 * s + 2], x[8 * s + 3]); o.z = cvtpk(x[8 * s + 4], x[8 * s + 5]); o.w = cvtpk(x[8 * s + 6], x[8 * s + 7]);
    return __builtin_bit_cast(bf16x8, o);
}
#define RT_MFMA32(a, b, c) __builtin_amdgcn_mfma_f32_32x32x16_bf16((a), (b), (c), 0, 0, 0)
#define RT_MFMA16(a, b, c) __builtin_amdgcn_mfma_f32_16x16x32_bf16((a), (b), (c), 0, 0, 0)

struct Stage { v4u q[2], k[2], v[4]; };
template <bool WITH_Q>
RT_DI void stage_load(Stage& st, const bf16* Q, const bf16* K, const bf16* V, size_t m0, int h, int t) {
    const char* qb = (const char*)(Q + m0 * 512 + h * 128); const char* kb = (const char*)(K + m0 * 512 + h * 128); const char* vb = (const char*)(V + m0 * 1024 + h * 256);
#pragma unroll
    for (int k = 0; k < 2; ++k) { const int id = t + 512 * k, row = id >> 4, ch = id & 15; const unsigned off = (unsigned)(row * 512 + ch * 8) * 2u;
        if (WITH_Q) st.q[k] = *(const GAS v4u*)(qb + off);
        st.k[k] = *(const GAS v4u*)(kb + off); }
#pragma unroll
    for (int k = 0; k < 4; ++k) { const int id = t + 512 * k, row = id >> 5, c32 = id & 31; const unsigned off = (unsigned)(row * 1024 + c32 * 8) * 2u;
        st.v[k] = *(const GAS v4u*)(vb + off); }
}
template <bool WITH_Q>
RT_DI void stage_write(const Stage& st, LAS unsigned char* lds, int t) {
#pragma unroll
    for (int k = 0; k < 2; ++k) { const int id = t + 512 * k, row = id >> 4, ch = id & 15;
        if (WITH_Q) *(LAS v4u*)(lds + L_QT + off_b(row, ch)) = st.q[k];
        *(LAS v4u*)(lds + L_KT + off_b(row, ch)) = st.k[k]; }
#pragma unroll
    for (int k = 0; k < 4; ++k) { const int id = t + 512 * k, row = id >> 5, c32 = id & 31;
        *(LAS v4u*)(lds + L_VT + (c32 >> 4) * 16384 + off_b(row, c32 & 15)) = st.v[k]; }
}
RT_DI void kv_update(f32x16 (&S)[4], const bf16x8 (&vf)[4], lds_cptr KT, unsigned lane, float cdec, const float (&wj)[8], const float (&fk)[4]) {
#pragma unroll
    for (int dt = 0; dt < 4; ++dt) S[dt] = S[dt] * cdec;
#pragma unroll
    for (int ks = 0; ks < 4; ++ks) {
        float f[8];
#pragma unroll
        for (int jj = 0; jj < 8; ++jj) f[jj] = wj[jj] * fk[ks];
        const bf16x8 vs = scale_frag(vf[ks], f);
#pragma unroll
        for (int dt = 0; dt < 4; ++dt) { const bf16x8 kf = tr8(KT, lane, dt, ks); S[dt] = RT_MFMA32(kf, vs, S[dt]); }
    }
}
RT_DI int crow(int reg, int hh) { return (reg & 3) + 8 * (reg >> 2) + 4 * hh; }

RT_DI void pass1(LAS unsigned char* lds, int tid, int wave, int item, const bf16* K, const bf16* V, float* SLOC) {
    const int chain = item >> 3, seg = item & 7, b = chain >> 2, h = chain & 3;
    if (seg == NSEG - 1) return;
    const unsigned lane = tid & 63, r = lane & 31, hh = lane >> 5;
    const float lg = log1pf(-exp2f(-5.f - (float)h));
    const float cdec = expf(lg * 64.f);
    float wj[8], fk[4];
#pragma unroll
    for (int jj = 0; jj < 8; ++jj) wj[jj] = expf(lg * (float)(7 - jj));
#pragma unroll
    for (int ks = 0; ks < 4; ++ks) fk[ks] = expf(lg * (float)(56 - 16 * ks - 8 * (int)hh));
    f32x16 S[4];
#pragma unroll
    for (int dt = 0; dt < 4; ++dt)
#pragma unroll
        for (int i = 0; i < 16; ++i) S[dt][i] = 0.f;
    lds_cptr KT = (lds_cptr)(lds + L_KT), VT = (lds_cptr)(lds + L_VT + (wave >> 2) * 16384);
    Stage st;
    const size_t mseg = (size_t)b * SEQ + (size_t)seg * CPS * CH;
    stage_load<false>(st, nullptr, K, V, mseg, h, tid);
    for (int c = 0; c < CPS; ++c) {
        __syncthreads();
        stage_write<false>(st, lds, tid);
        __syncthreads();
        if (c + 1 < CPS) stage_load<false>(st, nullptr, K, V, mseg + (size_t)(c + 1) * CH, h, tid);
        bf16x8 vf[4];
#pragma unroll
        for (int ks = 0; ks < 4; ++ks) vf[ks] = tr8(VT, lane, wave & 3, ks);
        kv_update(S, vf, KT, lane, cdec, wj, fk);
    }
    float* dst = SLOC + (size_t)item * (128 * 256) + wave * 4096 + lane;
#pragma unroll
    for (int dt = 0; dt < 4; ++dt)
#pragma unroll
        for (int i = 0; i < 16; ++i) dst[(dt * 16 + i) * 64] = S[dt][i];
}

RT_DI void pass2(LAS unsigned char* lds, int tid_, int wave, int item, const bf16* Q, const bf16* K, const bf16* V, bf16* SGR, const float* SLOC, const float* gn_g, const float* gn_b) {
    const int chain = item >> 3, seg = item & 7, b = chain >> 2, h = chain & 3;
    const unsigned lane_ = tid_ & 63; const int tid = tid_;
    float cdec, lg2; const int it16 = wave >> 1, jt0 = 2 * (wave & 1);
    f32x16 S[4];
    {
    const unsigned lane = lane_;
    const float lg = log1pf(-exp2f(-5.f - (float)h));
    cdec = expf(lg * 64.f); lg2 = lg * 1.4426950408889634f;
#pragma unroll
    for (int dt = 0; dt < 4; ++dt)
#pragma unroll
        for (int i = 0; i < 16; ++i) S[dt][i] = 0.f;
    {
        const float sdec = expf(lg * (float)(CPS * CH));
        for (int g = 0; g < seg; ++g) { const float* src = SLOC + (size_t)(chain * NSEG + g) * (128 * 256) + wave * 4096 + lane;
#pragma unroll
            for (int dt = 0; dt < 4; ++dt)
#pragma unroll
                for (int i = 0; i < 16; ++i) S[dt][i] = S[dt][i] * sdec + src[(dt * 16 + i) * 64]; }
    }
    }
    __syncthreads();
    for (int i = tid; i < 512; i += 512) ((LAS float*)(lds + L_GB))[i] = (i < 256) ? gn_g[h * 256 + i] : gn_b[h * 256 + i - 256];
    lds_cptr QT = (lds_cptr)(lds + L_QT), KT = (lds_cptr)(lds + L_KT), VT = (lds_cptr)(lds + L_VT + (wave >> 2) * 16384), PT = (lds_cptr)(lds + L_PT);
    Stage st;
    const size_t mseg = (size_t)b * SEQ + (size_t)seg * CPS * CH;
    stage_load<true>(st, Q, K, V, mseg, h, tid);
    for (int c = 0; c < CPS; ++c) {
        const size_t m0 = mseg + (size_t)c * CH;
        int tid = tid_; asm volatile("" : "+v"(tid));
        const unsigned lane = tid & 63, r = lane & 31, hh = lane >> 5, fr = lane & 15, fq = lane >> 4;
        float wj[8], fk[4], pdec[2][4];
#pragma unroll
        for (int jj = 0; jj < 8; ++jj) wj[jj] = __builtin_amdgcn_exp2f(lg2 * (float)(7 - jj));
#pragma unroll
        for (int ks = 0; ks < 4; ++ks) fk[ks] = __builtin_amdgcn_exp2f(lg2 * (float)(56 - 16 * ks - 8 * (int)hh));
        const float qd0 = __builtin_amdgcn_exp2f(lg2 * (float)(r + 1)), qd1 = __builtin_amdgcn_exp2f(lg2 * (float)(r + 33));
#pragma unroll
        for (int tt = 0; tt < 2; ++tt)
#pragma unroll
            for (int e = 0; e < 4; ++e) { const int i = 16 * it16 + (int)fr, j = 16 * (jt0 + tt) + 4 * (int)fq + e; pdec[tt][e] = __builtin_amdgcn_exp2f(lg2 * (float)(i > j ? i - j : j - i)); }
        stage_write<true>(st, lds, tid);
        __syncthreads();
        {
            f32x4 p[2] = {(f32x4){0.f, 0.f, 0.f, 0.f}, (f32x4){0.f, 0.f, 0.f, 0.f}};
#pragma unroll
            for (int s = 0; s < 4; ++s) {
                const bf16x8 qf = *(const LAS bf16x8*)(QT + off_b(fr + 16 * it16, 4 * s + fq));
#pragma unroll
                for (int tt = 0; tt < 2; ++tt) { const bf16x8 kf = *(const LAS bf16x8*)(KT + off_b(fr + 16 * (jt0 + tt), 4 * s + fq)); p[tt] = RT_MFMA16(kf, qf, p[tt]); }
            }
#pragma unroll
            for (int tt = 0; tt < 2; ++tt) { v2u w; w.x = cvtpk(p[tt][0] * pdec[tt][0], p[tt][1] * pdec[tt][1]); w.y = cvtpk(p[tt][2] * pdec[tt][2], p[tt][3] * pdec[tt][3]);
                *(LAS v2u*)(lds + L_PT + off_p(16 * it16 + fr, 2 * (jt0 + tt) + (fq >> 1)) + 8 * (fq & 1)) = w; }
        }
        __syncthreads();
        f32x16 z[2];
#pragma unroll
        for (int it = 0; it < 2; ++it)
#pragma unroll
            for (int i = 0; i < 16; ++i) z[it][i] = 0.f;
#pragma unroll
        for (int dt = 0; dt < 4; ++dt)
#pragma unroll
            for (int s = 0; s < 2; ++s) {
                const bf16x8 xs = pack8(S[dt], s);
#pragma unroll
                for (int it = 0; it < 2; ++it) {
                    const s16x4 lo = *(const LAS s16x4*)(QT + off_b(32 * it + r, 4 * dt + 2 * s) + 8 * hh);
                    const s16x4 hi = *(const LAS s16x4*)(QT + off_b(32 * it + r, 4 * dt + 2 * s + 1) + 8 * hh);
                    const bf16x8 qb = __builtin_shufflevector(lo, hi, 0, 1, 2, 3, 4, 5, 6, 7);
                    z[it] = RT_MFMA32(xs, qb, z[it]);
                }
            }
        z[0] = z[0] * qd0; z[1] = z[1] * qd1;
        bf16x8 vf[4];
#pragma unroll
        for (int ks = 0; ks < 4; ++ks) vf[ks] = tr8(VT, lane, wave & 3, ks);
#pragma unroll
        for (int ks = 0; ks < 4; ++ks)
#pragma unroll
            for (int it = 0; it < 2; ++it) { const bf16x8 pf = *(const LAS bf16x8*)(PT + off_p(32 * it + r, 2 * ks + hh)); z[it] = RT_MFMA32(vf[ks], pf, z[it]); }
        kv_update(S, vf, KT, lane, cdec, wj, fk);
        if (c + 1 < CPS) stage_load<true>(st, Q, K, V, m0 + CH, h, tid);
        bf16* orow0 = SGR + (m0 + r) * 1024 + h * 256 + 32 * wave + 4 * hh;
        v2u sg[2][4];
#pragma unroll
        for (int it = 0; it < 2; ++it)
#pragma unroll
            for (int g4 = 0; g4 < 4; ++g4) sg[it][g4] = *(const GAS v2u*)(orow0 + (size_t)it * 32 * 1024 + 8 * g4);
        typedef float f2 __attribute__((ext_vector_type(2)));
#pragma unroll
        for (int it = 0; it < 2; ++it) {
            float s1 = 0.f;
#pragma unroll
            for (int i = 0; i < 16; ++i) s1 += z[it][i];
            s1 += __shfl_xor(s1, 32);
            const float mw = s1 * (1.f / 32.f); float m2 = 0.f;
#pragma unroll
            for (int i = 0; i < 16; ++i) { const float d = z[it][i] - mw; m2 += d * d; }
            m2 += __shfl_xor(m2, 32);
            if (hh == 0) *(LAS f2*)(lds + L_ST + ((32 * it + r) * 8 + wave) * 8) = (f2){mw, m2};
        }
        __syncthreads();
#pragma unroll
        for (int it = 0; it < 2; ++it) {
            const LAS f32x4* sp = (const LAS f32x4*)(lds + L_ST + (32 * it + r) * 64);
            const f32x4 a0 = sp[0], a1 = sp[1], a2 = sp[2], a3 = sp[3];
            const float mean = ((a0[0] + a0[2]) + (a1[0] + a1[2]) + (a2[0] + a2[2]) + (a3[0] + a3[2])) * 0.125f;
            float q = (a0[1] + a0[3]) + (a1[1] + a1[3]) + (a2[1] + a2[3]) + (a3[1] + a3[3]);
            { const float d0 = a0[0] - mean, d1 = a0[2] - mean, d2 = a1[0] - mean, d3 = a1[2] - mean, d4 = a2[0] - mean, d5 = a2[2] - mean, d6 = a3[0] - mean, d7 = a3[2] - mean;
              q += 32.f * ((d0 * d0 + d1 * d1) + (d2 * d2 + d3 * d3) + (d4 * d4 + d5 * d5) + (d6 * d6 + d7 * d7)); }
            const float rstd = 1.f / sqrtf(q * (1.f / 256.f) + LN_EPS);
#pragma unroll
            for (int g4 = 0; g4 < 4; ++g4) {
                const f32x4 gg = *(const LAS f32x4*)(lds + L_GB + (32 * wave + 8 * g4 + 4 * hh) * 4), bb = *(const LAS f32x4*)(lds + L_GB + 1024 + (32 * wave + 8 * g4 + 4 * hh) * 4);
                const float y0 = (z[it][4 * g4 + 0] - mean) * rstd * gg[0] + bb[0], y1 = (z[it][4 * g4 + 1] - mean) * rstd * gg[1] + bb[1];
                const float y2 = (z[it][4 * g4 + 2] - mean) * rstd * gg[2] + bb[2], y3 = (z[it][4 * g4 + 3] - mean) * rstd * gg[3] + bb[3];
                v2u w; w.x = cvtpk(bflo(sg[it][g4].x) * y0, bfhi(sg[it][g4].x) * y1); w.y = cvtpk(bflo(sg[it][g4].y) * y2, bfhi(sg[it][g4].y) * y3);
                *(GAS v2u*)(orow0 + (size_t)it * 32 * 1024 + 8 * g4) = w;
            }
        }
    }
    __syncthreads();
}
#undef RT_MFMA32
#undef RT_MFMA16
#undef RT_DI
}

struct Frame {
    LAS unsigned char* lds;
    volatile LAS unsigned* MISC;
    gu32* ctl;
    int tid, lane, wave;
    int vcu, G;
    const float* x; float* out;
    const float *ln_in_g, *ln_in_b, *w_in, *b_merge, *gn_g, *gn_b, *w_ret, *conv_w, *conv_b, *w_rg_a, *b_rg_a, *w_rg_x, *b_rg_x, *lam, *w_lru, *w_out, *ln_out_g, *ln_out_b;
    bf16 *WinT, *PcatT, *WoutT; float* rope;
    bf16 *Q, *K, *V, *SGR, *XL, *SGL, *GR, *GL, *MERGED, *XN;
};

__device__ __forceinline__ float wave_sum(float v) {
#pragma unroll
    for (int o = 1; o < 64; o <<= 1) v += __shfl_xor(v, o);
    return v;
}
__device__ __forceinline__ int win_dest_row(int c) {
    if (c >= 1024) return c;
    const int blk = c >> 9, cc = c & 511, head = cc >> 7, idx = cc & 127, bj = idx >> 6, i = idx & 63;
    return blk * 512 + (head >> 1) * 256 + 128 * bj + (head & 1) * 64 + i;
}
template <bool WIN>
__device__ __forceinline__ void p0_transpose_item(const float* W, int ldw, bf16* WT, int ldt, int koff, LAS float* scr, int k0, int n0, int lane) {
#pragma unroll 8
    for (int i = 0; i < 32; ++i) { const int kk = 2 * i + (lane >> 5); scr[kk * 33 + (lane & 31)] = W[(size_t)(k0 + kk) * ldw + n0 + (lane & 31)]; }
    LDS_WAIT(); asm volatile("" ::: "memory");
    const int c = lane & 7;
#pragma unroll
    for (int j = 0; j < 4; ++j) { const int n = (lane >> 3) + 8 * j; const LAS float* s = scr + (8 * c) * 33 + n;
        const int col = n0 + n; const int drow = WIN ? win_dest_row(col) : col;
        const float sc = (WIN && col >= 512 && col < 1024) ? 0.08838834764831845f : 1.0f;
        v4u o; o.x = pk2(s[0 * 33] * sc, s[1 * 33] * sc); o.y = pk2(s[2 * 33] * sc, s[3 * 33] * sc); o.z = pk2(s[4 * 33] * sc, s[5 * 33] * sc); o.w = pk2(s[6 * 33] * sc, s[7 * 33] * sc);
        *(GAS v4u*)(WT + (size_t)drow * ldt + koff + k0 + 8 * c) = o; }
    LDS_WAIT(); asm volatile("" ::: "memory");
}
__device__ __forceinline__ void p0_prologue(Frame& F) {
    LAS float* scr = (LAS float*)(F.lds + RING_OFF + F.wave * 16384);
    const int gw = F.vcu * NWAVES + F.wave, NGW = F.G * NWAVES;
    constexpr int I_IN = (D / 64) * (NIN / 32), I_SQ = (D / 64) * (D / 32);
    constexpr int NITEMS = I_IN + 3 * I_SQ;
    for (int it = gw; it < NITEMS; it += NGW) {
        int r = it;
        if (r < I_IN) { const int nblk = NIN / 32; p0_transpose_item<true>(F.w_in, NIN, F.WinT, D, 0, scr, 64 * (r / nblk), 32 * (r % nblk), F.lane); continue; } r -= I_IN;
        const int nblk = D / 32, k0 = 64 * ((r % I_SQ) / nblk), n0 = 32 * ((r % I_SQ) % nblk);
        if (r < I_SQ) { p0_transpose_item<false>(F.w_ret, D, F.PcatT, 2 * D, 0, scr, k0, n0, F.lane); continue; }
        if (r < 2 * I_SQ) { p0_transpose_item<false>(F.w_lru, D, F.PcatT, 2 * D, D, scr, k0, n0, F.lane); continue; }
        p0_transpose_item<false>(F.w_out, D, F.WoutT, D, 0, scr, k0, n0, F.lane);
    }
    for (int e = (F.vcu * NWAVES * 64) + F.tid; e < SEQ * 64; e += F.G * NWAVES * 64) {
        const int pos = e >> 6, i = e & 63;
        const double inv = exp(-(double)i * (9.210340371976184 / 64.0));
        const double ang = (double)pos * inv;
        const double n = rint(ang * 0.15915494309189535);
        double r = fma(-n, 6.283185307179586, ang); r = fma(-n, 2.4492935982947064e-16, r);
        const float rf = (float)r;
        typedef float f32x2 __attribute__((ext_vector_type(2)));
        f32x2 cs; cs.x = cosf(rf); cs.y = sinf(rf);
        *(GAS f32x2*)((GAS float*)F.rope + (size_t)e * 2) = cs;
    }
    f32x4 gv[4], bv[4];
#pragma unroll
    for (int j = 0; j < 4; ++j) { gv[j] = *((const GAS f32x4*)F.ln_in_g + F.lane + 64 * j); bv[j] = *((const GAS f32x4*)F.ln_in_b + F.lane + 64 * j); }
    for (int m = gw; m < M; m += NGW) {
        const GAS f32x4* xr = (const GAS f32x4*)(F.x + (size_t)m * D) + F.lane;
        f32x4 v[4]; float s = 0.f;
#pragma unroll
        for (int j = 0; j < 4; ++j) { v[j] = xr[64 * j]; s += (v[j].x + v[j].y) + (v[j].z + v[j].w); }
        const float mean = wave_sum(s) * (1.f / D); float s2 = 0.f;
#pragma unroll
        for (int j = 0; j < 4; ++j) { v[j] = v[j] - mean; s2 += (v[j].x * v[j].x + v[j].y * v[j].y) + (v[j].z * v[j].z + v[j].w * v[j].w); }
        const float rstd = 1.f / sqrtf(wave_sum(s2) * (1.f / D) + LN_EPS);
        GAS v2u* o8 = (GAS v2u*)(F.XN + (size_t)m * D) + F.lane;
#pragma unroll
        for (int j = 0; j < 4; ++j) { const f32x4 y = v[j] * rstd * gv[j] + bv[j]; v2u w; w.x = pk2(y.x, y.y); w.y = pk2(y.z, y.w); o8[64 * j] = w; }
    }
}

__device__ __forceinline__ void ret_simple(Frame& F, int item, float* RAW) {
    const int b = item >> 5, h = (item >> 3) & 3, es = item & 7, t = F.tid;
    LAS float* Qs = (LAS float*)(F.lds);
    LAS float* Ks = Qs + 64 * 129;
    LAS float* Vs = Ks + 64 * 129;
    LAS float* Ps = Vs + 64 * 32;
    LAS float* Ss = Ps + 64 * 65;
    const float lg = log1pf(-exp2f(-5.f - (float)h));
    for (int i = t; i < 128 * 32; i += 512) Ss[i] = 0.f;
    const float cdec = expf(lg * 64.f);
    for (int c = 0; c < NCH; ++c) {
        const size_t m0 = (size_t)b * SEQ + (size_t)c * CH;
        __syncthreads();
#pragma unroll
        for (int k = 0; k < 2; ++k) { const int id = t + 512 * k, row = id >> 4, c8 = id & 15;
            const v4u q = *(const GAS v4u*)(F.Q + (m0 + row) * 512 + h * 128 + c8 * 8), kk = *(const GAS v4u*)(F.K + (m0 + row) * 512 + h * 128 + c8 * 8);
            LAS float* qd = Qs + row * 129 + c8 * 8; LAS float* kd = Ks + row * 129 + c8 * 8;
            qd[0] = bflo(q.x); qd[1] = bfhi(q.x); qd[2] = bflo(q.y); qd[3] = bfhi(q.y); qd[4] = bflo(q.z); qd[5] = bfhi(q.z); qd[6] = bflo(q.w); qd[7] = bfhi(q.w);
            kd[0] = bflo(kk.x); kd[1] = bfhi(kk.x); kd[2] = bflo(kk.y); kd[3] = bfhi(kk.y); kd[4] = bflo(kk.z); kd[5] = bfhi(kk.z); kd[6] = bflo(kk.w); kd[7] = bfhi(kk.w); }
        if (t < 256) { const int row = t >> 2, c8 = t & 3;
            const v4u v = *(const GAS v4u*)(F.V + (m0 + row) * 1024 + h * 256 + es * 32 + c8 * 8);
            LAS float* vd = Vs + row * 32 + c8 * 8;
            vd[0] = bflo(v.x); vd[1] = bfhi(v.x); vd[2] = bflo(v.y); vd[3] = bfhi(v.y); vd[4] = bflo(v.z); vd[5] = bfhi(v.z); vd[6] = bflo(v.w); vd[7] = bfhi(v.w); }
        __syncthreads();
        {
            const int i = t >> 3, jg = t & 7; float a[8];
#pragma unroll
            for (int jj = 0; jj < 8; ++jj) a[jj] = 0.f;
            for (int d = 0; d < 128; ++d) { const float q = Qs[i * 129 + d];
#pragma unroll
                for (int jj = 0; jj < 8; ++jj) a[jj] += q * Ks[(jg * 8 + jj) * 129 + d]; }
#pragma unroll
            for (int jj = 0; jj < 8; ++jj) { const int j = jg * 8 + jj; const int dd = i > j ? i - j : j - i; Ps[i * 65 + j] = a[jj] * expf(lg * (float)dd); }
        }
        __syncthreads();
        {
            const int e = t & 31, ig = t >> 5;
#pragma unroll
            for (int ii = 0; ii < 4; ++ii) { const int i = ig * 4 + ii; float o1 = 0.f, o2 = 0.f;
                for (int j = 0; j < 64; ++j) o1 += Ps[i * 65 + j] * Vs[j * 32 + e];
                for (int d = 0; d < 128; ++d) o2 += Qs[i * 129 + d] * Ss[d * 32 + e];
                RAW[(m0 + i) * 1024 + h * 256 + es * 32 + e] = o1 + expf(lg * (float)(i + 1)) * o2; }
        }
        __syncthreads();
        {
            const int e = t & 31, dg = t >> 5; float a[8];
#pragma unroll
            for (int dd = 0; dd < 8; ++dd) a[dd] = 0.f;
            for (int j = 0; j < 64; ++j) { const float vd = Vs[j * 32 + e] * expf(lg * (float)(63 - j));
#pragma unroll
                for (int dd = 0; dd < 8; ++dd) a[dd] += Ks[j * 129 + dg * 8 + dd] * vd; }
#pragma unroll
            for (int dd = 0; dd < 8; ++dd) { const int d = dg * 8 + dd; Ss[d * 32 + e] = Ss[d * 32 + e] * cdec + a[dd]; }
        }
    }
    __syncthreads();
}

__device__ __forceinline__ void lru_simple(Frame& F, int item) {
    const int b = item >> 5, cb = (item >> 2) & 7, q = item & 3, t = F.tid;
    LAS float* Xs = (LAS float*)(F.lds);
    LAS float* XC = Xs + 67 * 128;
    LAS float* Wa = XC + 64 * 129;
    LAS float* Wx = Wa + 128 * 32;
    LAS float* AA = Wx + 128 * 32;
    LAS float* UU = AA + 64 * 32;
    LAS float* Hc = UU + 64 * 32;
    __syncthreads();
    for (int i = t; i < 128 * 32; i += 512) { const int r = i >> 5, c = i & 31;
        Wa[i] = F.w_rg_a[((size_t)cb * 128 + r) * 128 + q * 32 + c]; Wx[i] = F.w_rg_x[((size_t)cb * 128 + r) * 128 + q * 32 + c]; }
    if (t < 32) Hc[t] = 0.f;
    const int c = t & 31, tg = t >> 5, ch = cb * 128 + q * 32 + c;
    const float ba = F.b_rg_a[ch], bx = F.b_rg_x[ch];
    const float lamv = F.lam[ch];
    const float Lc = -8.0f * log1pf(expf(-lamv));
    for (int tile = 0; tile < SEQ / 64; ++tile) {
        const int t0 = tile * 64; const size_t m0 = (size_t)b * SEQ + t0;
        __syncthreads();
        for (int id = t; id < 67 * 16; id += 512) { const int r = id >> 4, c8 = id & 15; const int s = t0 - 3 + r;
            v4u v = (v4u){0u, 0u, 0u, 0u};
            if (s >= 0) v = *(const GAS v4u*)(F.XL + ((size_t)b * SEQ + s) * 1024 + cb * 128 + c8 * 8);
            LAS float* xd = Xs + r * 128 + c8 * 8;
            xd[0] = bflo(v.x); xd[1] = bfhi(v.x); xd[2] = bflo(v.y); xd[3] = bfhi(v.y); xd[4] = bflo(v.z); xd[5] = bfhi(v.z); xd[6] = bflo(v.w); xd[7] = bfhi(v.w); }
        __syncthreads();
#pragma unroll 4
        for (int k = 0; k < 16; ++k) { const int id = t + 512 * k, tt = id >> 7, i = id & 127, cc = cb * 128 + i;
            float a = F.conv_b[cc];
#pragma unroll
            for (int j = 0; j < 4; ++j) a += F.conv_w[j * 1024 + cc] * Xs[(tt + j) * 128 + i];
            XC[tt * 129 + i] = a; }
        __syncthreads();
#pragma unroll
        for (int k = 0; k < 4; ++k) { const int tt = tg * 4 + k; float rp = ba, ip = bx;
            for (int i = 0; i < 128; ++i) { const float xv = XC[tt * 129 + i]; rp += xv * Wa[i * 32 + c]; ip += xv * Wx[i * 32 + c]; }
            const float r = 1.0f / (1.0f + expf(-rp)), ig = 1.0f / (1.0f + expf(-ip));
            const float la = r * Lc;
            AA[tt * 32 + c] = expf(la);
            UU[tt * 32 + c] = sqrtf(-expm1f(2.0f * la)) * (ig * XC[tt * 129 + q * 32 + c]); }
        __syncthreads();
        if (t < 32) { float hh = Hc[t];
            for (int k = 0; k < 64; ++k) { hh = AA[k * 32 + t] * hh + UU[k * 32 + t]; UU[k * 32 + t] = hh; }
            Hc[t] = hh; }
        __syncthreads();
#pragma unroll
        for (int k = 0; k < 4; ++k) { const int id = t + 512 * k, tt = id >> 5, cc = id & 31; const size_t off = (m0 + tt) * 1024 + cb * 128 + q * 32 + cc;
            F.SGL[off] = (bf16)f2bf(bf2f(F.SGL[off]) * UU[tt * 32 + cc]); }
    }
    __syncthreads();
}

__device__ __forceinline__ void gn_gate(Frame& F, const float* RAW) {
    const int gw = F.vcu * NWAVES + F.wave, NGW = F.G * NWAVES;
    for (int m = gw; m < M; m += NGW) {
        const GAS f32x4* xr = (const GAS f32x4*)(RAW + (size_t)m * D) + F.lane;
        GAS v2u* sg = (GAS v2u*)(F.SGR + (size_t)m * D) + F.lane;
#pragma unroll
        for (int j = 0; j < 4; ++j) {
            f32x4 v = xr[64 * j];
            const float mean = wave_sum((v.x + v.y) + (v.z + v.w)) * (1.f / 256.f);
            v = v - mean;
            const float rstd = 1.f / sqrtf(wave_sum((v.x * v.x + v.y * v.y) + (v.z * v.z + v.w * v.w)) * (1.f / 256.f) + LN_EPS);
            const f32x4 g = *((const GAS f32x4*)F.gn_g + F.lane + 64 * j), bb = *((const GAS f32x4*)F.gn_b + F.lane + 64 * j);
            const f32x4 y = v * rstd * g + bb;
            const v2u s = sg[64 * j]; v2u w;
            w.x = pk2(bflo(s.x) * y.x, bfhi(s.x) * y.y); w.y = pk2(bflo(s.y) * y.z, bfhi(s.y) * y.w);
            sg[64 * j] = w;
        }
    }
}

__device__ __forceinline__ void final_ln(Frame& F) {
    const int gw = F.vcu * NWAVES + F.wave, NGW = F.G * NWAVES;
    for (int m = gw; m < M; m += NGW) {
        const GAS f32x4* xr = (const GAS f32x4*)(F.x + (size_t)m * D) + F.lane;
        GAS f32x4* yr = (GAS f32x4*)(F.out + (size_t)m * D) + F.lane;
        f32x4 v[4]; float s = 0.f;
#pragma unroll
        for (int j = 0; j < 4; ++j) { v[j] = xr[64 * j]; s += (v[j].x + v[j].y) + (v[j].z + v[j].w); }
        float mean = wave_sum(s) * (1.f / D); float s2 = 0.f;
#pragma unroll
        for (int j = 0; j < 4; ++j) { v[j] = v[j] - mean; s2 += (v[j].x * v[j].x + v[j].y * v[j].y) + (v[j].z * v[j].z + v[j].w * v[j].w); }
        float rstd = 1.f / sqrtf(wave_sum(s2) * (1.f / D) + LN_EPS);
        s = 0.f;
#pragma unroll
        for (int j = 0; j < 4; ++j) { const f32x4 g = *((const GAS f32x4*)F.ln_in_g + F.lane + 64 * j), bb = *((const GAS f32x4*)F.ln_in_b + F.lane + 64 * j);
            v[j] = (v[j] * rstd * g + bb) * DN_ALPHA + yr[64 * j]; s += (v[j].x + v[j].y) + (v[j].z + v[j].w); }
        mean = wave_sum(s) * (1.f / D); s2 = 0.f;
#pragma unroll
        for (int j = 0; j < 4; ++j) { v[j] = v[j] - mean; s2 += (v[j].x * v[j].x + v[j].y * v[j].y) + (v[j].z * v[j].z + v[j].w * v[j].w); }
        rstd = 1.f / sqrtf(wave_sum(s2) * (1.f / D) + LN_EPS);
#pragma unroll
        for (int j = 0; j < 4; ++j) { const f32x4 g = *((const GAS f32x4*)F.ln_out_g + F.lane + 64 * j), bb = *((const GAS f32x4*)F.ln_out_b + F.lane + 64 * j);
            yr[64 * j] = v[j] * rstd * g + bb; }
    }
}

struct Args { const float* in[19]; float* out; unsigned char* ws; int ph_lo, ph_hi, li, pad; };
__global__ void __launch_bounds__(NWAVES * 64, 2) fwd_kernel(Args args) {
    extern __shared__ __attribute__((aligned(16))) unsigned char lds[];
    Frame F;
    F.lds = (LAS unsigned char*)lds;
    F.MISC = (volatile LAS unsigned*)(F.lds + MISC_OFF);
    F.tid = threadIdx.x; F.lane = F.tid & 63; F.wave = __builtin_amdgcn_readfirstlane(F.tid >> 6);
    F.G = gridDim.x; { const int bx = blockIdx.x; F.vcu = (F.G % 8 == 0) ? (bx % 8) * (F.G / 8) + bx / 8 : bx; }
    unsigned char* ws = args.ws;
    F.ctl = (gu32*)(ws + WS_CTL);
    F.x = args.in[0]; F.ln_in_g = args.in[1]; F.ln_in_b = args.in[2]; F.w_in = args.in[3]; F.b_merge = args.in[4]; F.gn_g = args.in[5]; F.gn_b = args.in[6]; F.w_ret = args.in[7];
    F.conv_w = args.in[8]; F.conv_b = args.in[9]; F.w_rg_a = args.in[10]; F.b_rg_a = args.in[11]; F.w_rg_x = args.in[12]; F.b_rg_x = args.in[13]; F.lam = args.in[14]; F.w_lru = args.in[15];
    F.w_out = args.in[16]; F.ln_out_g = args.in[17]; F.ln_out_b = args.in[18]; F.out = args.out;
    F.WinT = (bf16*)(ws + WS_WIN); F.PcatT = (bf16*)(ws + WS_PCAT); F.WoutT = (bf16*)(ws + WS_WOUT); F.rope = (float*)(ws + WS_ROPE);
    F.Q = (bf16*)(ws + WS_Q); F.K = (bf16*)(ws + WS_K); F.V = (bf16*)(ws + WS_V); F.SGR = (bf16*)(ws + WS_SGR); F.XL = (bf16*)(ws + WS_XL); F.SGL = (bf16*)(ws + WS_SGL);
    F.GR = (bf16*)(ws + WS_GR); F.GL = (bf16*)(ws + WS_GL); F.MERGED = (bf16*)(ws + WS_MERGED); F.XN = (bf16*)args.out;
    for (int u = F.tid; u < (LDS_BYTES - LDSCTL_OFF) / 4; u += NWAVES * 64) ((LAS unsigned*)(F.lds + LDSCTL_OFF))[u] = 0u;
    __syncthreads();
    XcdBarrier bar; bar.bar = (unsigned*)(F.ctl + CW_BAR); bar.x = 0; bar.st = nullptr;
    if (MK_ONE_LAUNCH) bar = xcd_barrier_post((unsigned*)(F.ctl + CW_BAR), F.MISC + 8);
#define GRID_BAR(seam) do { if (!MK_ONE_LAUNCH) { if (F.tid == 0) __hip_atomic_store(F.ctl + CW_TMO, 0xBADBA0u | (unsigned)(seam), RLX_AGENT); } else { xcd_barrier(bar); } } while (0)
    const int lo = args.ph_lo, hi = args.ph_hi;
#define IN(k) (lo <= (k) && (k) < hi)
#define BOTH(k) (IN(k) && IN((k) + 1))

    if (IN(0)) { p0_prologue(F); if (BOTH(0)) GRID_BAR(0); }

    if (IN(1)) {
        pg8::Gemm g{F.XN, F.WinT, M, NIN, D}; pg8::StaticOrder S; S.init(M, NIN, F.G, (int)blockIdx.x);
        pg8::EpiIn E{F.Q, F.K, F.V, F.SGR, F.XL, F.SGL, F.GR, F.GL, F.rope, F.b_merge};
        pg8::gemm_phase<pg8::EpiIn, pg8::StaticOrder, PG8_ALIGN, PG8_SP2>(F.lds + RING_OFF, g, S, E);
        if (BOTH(1)) GRID_BAR(1);
    }

    if (IN(2)) {
        for (int it = F.vcu; it < 256; it += F.G) rt::pass1(F.lds, F.tid, F.wave, it, F.K, F.V, (float*)(ws + WS_SLOC));
        for (int it = F.vcu; it < 256; it += F.G) lru_simple(F, it);
        if (BOTH(2)) GRID_BAR(2);
    }

    if (IN(3)) {
        for (int it = F.vcu; it < 256; it += F.G) rt::pass2(F.lds, F.tid, F.wave, it, F.Q, F.K, F.V, F.SGR, (const float*)(ws + WS_SLOC), F.gn_g, F.gn_b);
        if (BOTH(3)) GRID_BAR(3);
    }

    if (IN(4)) {
        pg8::Gemm g{F.SGR, F.PcatT, M, D, D}; g.ldb = 2 * D; pg8::StaticOrder S; S.init(M, D, F.G, (int)blockIdx.x);
        pg8::EpiGateF32 E{F.out, F.GR, D};
        pg8::gemm_phase<pg8::EpiGateF32, pg8::StaticOrder, PG8_ALIGN, PG8_SP2>(F.lds + RING_OFF, g, S, E);
        if (BOTH(4)) GRID_BAR(4);
    }

    if (IN(5)) {
        pg8::Gemm g{F.SGL, F.PcatT + D, M, D, D}; g.ldb = 2 * D; pg8::StaticOrder S; S.init(M, D, F.G, (int)blockIdx.x);
        pg8::EpiMerge E{F.MERGED, F.out, F.GL, D};
        pg8::gemm_phase<pg8::EpiMerge, pg8::StaticOrder, PG8_ALIGN, PG8_SP2>(F.lds + RING_OFF, g, S, E);
        if (BOTH(5)) GRID_BAR(5);
    }

    if (IN(6)) {
        pg8::Gemm g{F.MERGED, F.WoutT, M, D, D}; pg8::StaticOrder S; S.init(M, D, F.G, (int)blockIdx.x);
        pg8::EpiF32 E{F.out, D};
        pg8::gemm_phase<pg8::EpiF32, pg8::StaticOrder, PG8_ALIGN, PG8_SP2>(F.lds + RING_OFF, g, S, E);
        if (BOTH(6)) GRID_BAR(6);
    }

    if (IN(7)) { final_ln(F); }
#undef IN
#undef BOTH
}

extern "C" void kernel_launch(void* const* d_in, const int* in_sizes, int n_in, void* d_out, int out_size, void* d_ws, size_t ws_size, hipStream_t stream) {
    static int grid = 0;
    if (grid == 0) {
        if (n_in != 19 || in_sizes[0] != M * D || out_size != M * D || ws_size < WS_END2) { fprintf(stderr, "kernel_launch: unexpected shapes (n_in %d, in0 %d, out %d, ws %zu); nothing launched\n", n_in, n_in > 0 ? in_sizes[0] : -1, out_size, ws_size); grid = -1; return; }
        int dev = 0, cus = 0, per_cu = 0;
        if (hipGetDevice(&dev) != hipSuccess || hipDeviceGetAttribute(&cus, hipDeviceAttributeMultiprocessorCount, dev) != hipSuccess) { grid = -1; return; }
        if (hipFuncSetAttribute((const void*)fwd_kernel, hipFuncAttributeMaxDynamicSharedMemorySize, LDS_BYTES) != hipSuccess) { fprintf(stderr, "kernel_launch: hipFuncSetAttribute failed\n"); grid = -1; return; }
        if (hipOccupancyMaxActiveBlocksPerMultiprocessor(&per_cu, (const void*)fwd_kernel, NWAVES * 64, LDS_BYTES) != hipSuccess || per_cu < 1) { fprintf(stderr, "kernel_launch: occupancy query reports %d\n", per_cu); per_cu = 1; }
        (void)hipGetLastError();
        grid = cus;
    }
    if (grid < 0) return;
    if (hipMemsetAsync((char*)d_ws + WS_CTL, 0, CTL_ZERO_BYTES, stream) != hipSuccess) return;
    Args a{};
    for (int i = 0; i < 19; ++i) a.in[i] = (const float*)d_in[i];
    a.out = (float*)d_out; a.ws = (unsigned char*)d_ws;
    const int nl = MK_ONE_LAUNCH ? 1 : NPHASES;
    for (int li = 0; li < nl; ++li) {
        a.ph_lo = MK_ONE_LAUNCH ? 0 : li; a.ph_hi = MK_ONE_LAUNCH ? NPHASES : li + 1; a.li = li;
        hipLaunchKernelGGL(fwd_kernel, dim3(grid), dim3(NWAVES * 64), LDS_BYTES, stream, a);
        if (hipPeekAtLastError() != hipSuccess) break;
    }
}
```

```cpp
#include <hip/hip_runtime.h>
#include <cstdio>
#include <cstdint>
namespace pg8 {
#define PG8_LAS __attribute__((address_space(3)))
typedef unsigned short bf16_t;
typedef short bf16x8 __attribute__((ext_vector_type(8)));
typedef float f32x4 __attribute__((ext_vector_type(4)));
typedef unsigned u32x4 __attribute__((ext_vector_type(4)));
constexpr int BM = 256, BK = 64, HALF = 128, HTB = HALF * BK * 2  , STAGE_BYTES = 8 * HTB, NXCD = 8, WGM = 8;

__host__ __device__ __forceinline__ int lds_byte(int r, int c) { const int st = (r >> 4) * 2 + (c >> 5), rr = r & 15, cc = c & 31, ob = rr * 64 + cc * 2; return st * 1024 + (ob ^ (((ob >> 9) & 1) << 5)); }
__host__ __device__ __forceinline__ void stage_rc(int b, int& R, int& C) { const int st = b / 1024, sb = b % 1024, swz = sb ^ (((sb >> 9) & 1) << 5); R = (st >> 1) * 16 + swz / 64; C = (st & 1) * 32 + (swz % 64) / 2; }
__host__ __device__ __forceinline__ int perm32(int rho) { const int n = rho >> 4, i = rho & 15; return 8 * (i >> 2) + 4 * n + (i & 3); }

struct Unit { int pm, pn; };
struct Gemm { const bf16_t* A; const bf16_t* Bt; int M, N, K; int lda = 0, ldb = 0; };

struct StaticOrder {
    int nM, nN, nwg, G, c;
    __host__ __device__ void init(int M, int N, int G_, int c_) { nM = M / BM; nN = N / BM; nwg = nM * nN; G = G_; c = c_; }
    __host__ __device__ bool next(int i, Unit& u) const {
        const long L = (long)i * G + c; if (L >= nwg) return false;
        int wgid = (int)L; { const int q = nwg / NXCD, r = nwg % NXCD, xcd = wgid % NXCD, off = wgid / NXCD; wgid = (xcd < r ? xcd * (q + 1) : r * (q + 1) + (xcd - r) * q) + off; }
        const int nig = WGM * nN, gid = wgid / nig, fm = gid * WGM, gsz = (nM - fm) < WGM ? (nM - fm) : WGM;
        u.pm = fm + ((wgid % nig) % gsz); u.pn = (wgid % nig) / gsz; return true;
    }
    __device__ __forceinline__ void a_ready(const Unit&) const {}
    __device__ __forceinline__ void done(const Unit&) const {}
};

__device__ __forceinline__ unsigned cvt_pk_bf16(float lo, float hi) { unsigned r; asm volatile("v_cvt_pk_bf16_f32 %0, %1, %2" : "=v"(r) : "v"(lo), "v"(hi)); return r; }
typedef unsigned u32x2 __attribute__((ext_vector_type(2)));
__device__ __forceinline__ float bf_lo(unsigned w) { return __builtin_bit_cast(float, w << 16); }
__device__ __forceinline__ float bf_hi(unsigned w) { return __builtin_bit_cast(float, w & 0xffff0000u); }
__device__ __forceinline__ float fast_sigmoid(float x) { return __builtin_amdgcn_rcpf(1.0f + __builtin_amdgcn_exp2f(-1.4426950408889634f * x)); }

struct EpiF32 {
    static constexpr bool PERM = false, AFTER_DRAIN = false;
    float* C; int ldc;
    __device__ __forceinline__ void operator()(const f32x4 (&acc)[2][2][4][2], const Unit& u, int wr, int wc, int fr, int fq) const {
        const int row0 = u.pm * BM + wr * 64 + fr, col0 = u.pn * BM + wc * 32 + 4 * fq;
#pragma unroll
        for (int ai = 0; ai < 2; ++ai)
#pragma unroll
            for (int m = 0; m < 4; ++m) { float* rowp = C + (size_t)(row0 + ai * HALF + m * 16) * ldc + col0;
#pragma unroll
                for (int bj = 0; bj < 2; ++bj)
#pragma unroll
                    for (int n = 0; n < 2; ++n) *(f32x4*)(rowp + bj * HALF + n * 16) = acc[ai][bj][m][n]; }
    }
};
struct EpiGateF32 {
    static constexpr bool PERM = false, AFTER_DRAIN = false;
    float* C; const bf16_t* G; int ldc;
    __device__ __forceinline__ void operator()(const f32x4 (&acc)[2][2][4][2], const Unit& u, int wr, int wc, int fr, int fq) const {
        const int row0 = u.pm * BM + wr * 64 + fr, col0 = u.pn * BM + wc * 32 + 4 * fq;
#pragma unroll
        for (int ai = 0; ai < 2; ++ai)
#pragma unroll
            for (int m = 0; m < 4; ++m) { const size_t off = (size_t)(row0 + ai * HALF + m * 16) * ldc + col0;
#pragma unroll
                for (int bj = 0; bj < 2; ++bj)
#pragma unroll
                    for (int n = 0; n < 2; ++n) { const u32x2 g = *(const u32x2*)(G + off + bj * HALF + n * 16); const f32x4 a = acc[ai][bj][m][n];
                        f32x4 o; o[0] = bf_lo(g.x) * a[0]; o[1] = bf_hi(g.x) * a[1]; o[2] = bf_lo(g.y) * a[2]; o[3] = bf_hi(g.y) * a[3];
                        *(f32x4*)(C + off + bj * HALF + n * 16) = o; } }
    }
};
struct EpiMerge {
    static constexpr bool PERM = true, AFTER_DRAIN = false;
    bf16_t* O; const float* T1; const bf16_t* G; int ldc;
    __device__ __forceinline__ void operator()(const f32x4 (&acc)[2][2][4][2], const Unit& u, int wr, int wc, int fr, int fq) const {
        const int row0 = u.pm * BM + wr * 64 + fr, col0 = u.pn * BM + wc * 32 + 8 * fq;
#pragma unroll
        for (int ai = 0; ai < 2; ++ai)
#pragma unroll
            for (int m = 0; m < 4; ++m) { const size_t off = (size_t)(row0 + ai * HALF + m * 16) * ldc + col0;
#pragma unroll
                for (int bj = 0; bj < 2; ++bj) { const u32x4 g = *(const u32x4*)(G + off + bj * HALF);
                    const f32x4 t0 = *(const f32x4*)(T1 + off + bj * HALF), t1 = *(const f32x4*)(T1 + off + bj * HALF + 4);
                    const f32x4 a0 = acc[ai][bj][m][0], a1 = acc[ai][bj][m][1];
                    u32x4 w;
                    w.x = cvt_pk_bf16(t0[0] + bf_lo(g.x) * a0[0], t0[1] + bf_hi(g.x) * a0[1]);
                    w.y = cvt_pk_bf16(t0[2] + bf_lo(g.y) * a0[2], t0[3] + bf_hi(g.y) * a0[3]);
                    w.z = cvt_pk_bf16(t1[0] + bf_lo(g.z) * a1[0], t1[1] + bf_hi(g.z) * a1[1]);
                    w.w = cvt_pk_bf16(t1[2] + bf_lo(g.w) * a1[2], t1[3] + bf_hi(g.w) * a1[3]);
                    *(u32x4*)(O + off + bj * HALF) = w; } }
    }
};
struct EpiIn {
    static constexpr bool PERM = true, AFTER_DRAIN = false;
    bf16_t *Q, *Kb, *V, *SGR, *XL, *SGL, *GR, *GL; const float* rope; const float* bmerge;
    __device__ __forceinline__ void operator()(const f32x4 (&acc)[2][2][4][2], const Unit& u, int wr, int wc, int fr, int fq) const {
        const int row0 = u.pm * BM + wr * 64 + fr; const int pn = u.pn;
        if (pn < 4) {
            bf16_t* base = (pn < 2) ? Q : Kb; const int head = 2 * (pn & 1) + (wc >> 1), i0 = 32 * (wc & 1) + 8 * fq;
#pragma unroll
            for (int ai = 0; ai < 2; ++ai)
#pragma unroll
                for (int m = 0; m < 4; ++m) { const int row = row0 + ai * HALF + m * 16, pos = row & 8191;
                    const f32x4* cs = (const f32x4*)(rope + ((size_t)pos * 64 + i0) * 2);
                    const f32x4 c0 = cs[0], c1 = cs[1], c2 = cs[2], c3 = cs[3];
                    const f32x4 xa = acc[ai][0][m][0], xb = acc[ai][0][m][1], ya = acc[ai][1][m][0], yb = acc[ai][1][m][1];
                    u32x4 o1, o2;
                    o1.x = cvt_pk_bf16(xa[0] * c0[0] - ya[0] * c0[1], xa[1] * c0[2] - ya[1] * c0[3]);
                    o1.y = cvt_pk_bf16(xa[2] * c1[0] - ya[2] * c1[1], xa[3] * c1[2] - ya[3] * c1[3]);
                    o1.z = cvt_pk_bf16(xb[0] * c2[0] - yb[0] * c2[1], xb[1] * c2[2] - yb[1] * c2[3]);
                    o1.w = cvt_pk_bf16(xb[2] * c3[0] - yb[2] * c3[1], xb[3] * c3[2] - yb[3] * c3[3]);
                    o2.x = cvt_pk_bf16(ya[0] * c0[0] + xa[0] * c0[1], ya[1] * c0[2] + xa[1] * c0[3]);
                    o2.y = cvt_pk_bf16(ya[2] * c1[0] + xa[2] * c1[1], ya[3] * c1[2] + xa[3] * c1[3]);
                    o2.z = cvt_pk_bf16(yb[0] * c2[0] + xb[0] * c2[1], yb[1] * c2[2] + xb[1] * c2[3]);
                    o2.w = cvt_pk_bf16(yb[2] * c3[0] + xb[2] * c3[1], yb[3] * c3[2] + xb[3] * c3[3]);
                    bf16_t* rp = base + (size_t)row * 512 + head * 128 + i0;
                    *(u32x4*)rp = o1; *(u32x4*)(rp + 64) = o2; }
        } else {
            const int ty = (pn - 4) >> 2, colt = ((pn - 4) & 3) * BM, col0 = colt + wc * 32 + 8 * fq;
            bf16_t* base = ty == 0 ? V : ty == 1 ? SGR : ty == 2 ? XL : ty == 3 ? SGL : ty == 4 ? GR : GL;
            f32x4 bv[2][2];
#pragma unroll
            for (int bj = 0; bj < 2; ++bj)
#pragma unroll
                for (int n = 0; n < 2; ++n) bv[bj][n] = (ty >= 4) ? *(const f32x4*)(bmerge + (ty - 4) * 1024 + col0 + bj * HALF + 4 * n) : (f32x4){0.f, 0.f, 0.f, 0.f};
#pragma unroll
            for (int ai = 0; ai < 2; ++ai)
#pragma unroll
                for (int m = 0; m < 4; ++m) { bf16_t* rowp = base + (size_t)(row0 + ai * HALF + m * 16) * 1024 + col0;
#pragma unroll
                    for (int bj = 0; bj < 2; ++bj) { f32x4 v0 = acc[ai][bj][m][0] + bv[bj][0], v1 = acc[ai][bj][m][1] + bv[bj][1];
                        if (ty == 1 || ty == 3) {
#pragma unroll
                            for (int j = 0; j < 4; ++j) { v0[j] = v0[j] * fast_sigmoid(v0[j]); v1[j] = v1[j] * fast_sigmoid(v1[j]); } }
                        if (ty >= 4) {
#pragma unroll
                            for (int j = 0; j < 4; ++j) { v0[j] = fast_sigmoid(v0[j]); v1[j] = fast_sigmoid(v1[j]); } }
                        u32x4 w; w.x = cvt_pk_bf16(v0[0], v0[1]); w.y = cvt_pk_bf16(v0[2], v0[3]); w.z = cvt_pk_bf16(v1[0], v1[1]); w.w = cvt_pk_bf16(v1[2], v1[3]);
                        *(u32x4*)(rowp + bj * HALF) = w; } }
        }
    }
};

template <class Epi, class Sched, bool ALIGN_EPI = false, bool SP2 = false>
__device__ __forceinline__ void gemm_phase(PG8_LAS unsigned char* lds, const Gemm g, const Sched& S, const Epi& E) {
    const int tid = threadIdx.x, wid = __builtin_amdgcn_readfirstlane(tid >> 6), lane = tid & 63, wr = wid >> 2, wc = wid & 3, fr = lane & 15, fq = lane >> 4;
    const int K = g.K, nt = K / BK, lda = g.lda ? g.lda : K, ldb = g.ldb ? g.ldb : K;
    unsigned voffA[2], voffB[2];
#pragma unroll
    for (int i = 0; i < 2; ++i) { int R, C; stage_rc(tid * 16 + i * 8192, R, C); const int Rb = Epi::PERM ? ((R & ~31) + perm32(R & 31)) : R;
        voffA[i] = (unsigned)(R * lda + C) * 2u; voffB[i] = (unsigned)(Rb * ldb + C) * 2u; }
    const size_t kstep = (size_t)(BK * 2);
    const size_t hstepA = (size_t)HALF * lda * 2, hstepB = (size_t)HALF * ldb * 2;
    const size_t tstepA = 2 * hstepA, tstepB = 2 * hstepB;
    const unsigned ldsw = (unsigned)wid * 1024u;
    const int aoff = lds_byte(wr * 64 + fr, fq * 8), boff = lds_byte(wc * 32 + fr, fq * 8);
#define PG8_SA(b, h) (((b) * 2 + (h)) * HTB)
#define PG8_SB(b, h) ((4 + (b) * 2 + (h)) * HTB)
#define PG8_STAGE(bufoff, gbase, voff) do { _Pragma("unroll") for (int _i = 0; _i < 2; ++_i) \
        __builtin_amdgcn_global_load_lds((const unsigned*)((const char*)(gbase) + (voff)[_i]), (PG8_LAS unsigned*)(lds + (bufoff) + ldsw + _i * 8192), 16, 0, 0); } while (0)
#define PG8_LDA(dst, b, h) do { _Pragma("unroll") for (int m = 0; m < 4; ++m) _Pragma("unroll") for (int k = 0; k < 2; ++k) dst[m][k] = *(const PG8_LAS bf16x8*)(lds + PG8_SA(b, h) + aoff + m * 2048 + k * 1024); } while (0)
#define PG8_LDB(dst, b, h) do { _Pragma("unroll") for (int n = 0; n < 2; ++n) _Pragma("unroll") for (int k = 0; k < 2; ++k) dst[n][k] = *(const PG8_LAS bf16x8*)(lds + PG8_SB(b, h) + boff + n * 2048 + k * 1024); } while (0)
#define PG8_MMA(ai, bj, At, Bt) do { __builtin_amdgcn_s_setprio(1); _Pragma("unroll") for (int m = 0; m < 4; ++m) _Pragma("unroll") for (int n = 0; n < 2; ++n) _Pragma("unroll") for (int k = 0; k < 2; ++k) \
        acc[ai][bj][m][n] = __builtin_amdgcn_mfma_f32_16x16x32_bf16(Bt[n][k], At[m][k], acc[ai][bj][m][n], 0, 0, 0); __builtin_amdgcn_s_setprio(0); } while (0)
#define PG8_WAIT_V(n) asm volatile("s_waitcnt vmcnt(" #n ")" ::: "memory")
#define PG8_WAIT_L(n) asm volatile("s_waitcnt lgkmcnt(" #n ")" ::: "memory")
#define PG8_BAR __builtin_amdgcn_s_barrier()
#define PG8_SCHED __builtin_amdgcn_sched_barrier(0)
    Unit cur, nxt; int ui = 0;
    if (!S.next(0, cur)) return;
    f32x4 acc[2][2][4][2];
#pragma unroll
    for (int a = 0; a < 2; ++a)
#pragma unroll
        for (int b = 0; b < 2; ++b)
#pragma unroll
            for (int m = 0; m < 4; ++m)
#pragma unroll
                for (int n = 0; n < 2; ++n) acc[a][b][m][n] = (f32x4){0.f, 0.f, 0.f, 0.f};
    bf16x8 At[4][2], B0[2][2], B1[2][2];
    const char* cA = (const char*)g.A + (size_t)cur.pm * tstepA; const char* cB = (const char*)g.Bt + (size_t)cur.pn * tstepB;
    S.a_ready(cur);
    if constexpr (SP2) {
        PG8_STAGE(PG8_SB(0, 0), cB, voffB); PG8_STAGE(PG8_SB(0, 1), cB + hstepB, voffB); PG8_STAGE(PG8_SA(0, 0), cA, voffA); PG8_STAGE(PG8_SA(0, 1), cA + hstepA, voffA);
        if (wr == 1) PG8_BAR;
        PG8_WAIT_V(2); PG8_BAR;
        PG8_STAGE(PG8_SB(1, 0), cB + kstep, voffB); PG8_STAGE(PG8_SA(1, 0), cA + kstep, voffA); PG8_STAGE(PG8_SB(1, 1), cB + hstepB + kstep, voffB);
        PG8_WAIT_V(6); PG8_BAR;
    } else {
        PG8_STAGE(PG8_SB(0, 0), cB, voffB); PG8_STAGE(PG8_SA(0, 0), cA, voffA); PG8_STAGE(PG8_SB(0, 1), cB + hstepB, voffB); PG8_STAGE(PG8_SA(0, 1), cA + hstepA, voffA);
        if (wr == 1) PG8_BAR;
        PG8_WAIT_V(4); PG8_BAR;
        PG8_STAGE(PG8_SB(1, 0), cB + kstep, voffB); PG8_STAGE(PG8_SA(1, 0), cA + kstep, voffA); PG8_STAGE(PG8_SB(1, 1), cB + hstepB + kstep, voffB);
        PG8_WAIT_V(6); PG8_BAR;
    }
    for (;;) {
        const bool has_next = S.next(ui + 1, nxt);
        const char* nA = has_next ? (const char*)g.A + (size_t)nxt.pm * tstepA : cA; const char* nB = has_next ? (const char*)g.Bt + (size_t)nxt.pn * tstepB : cB;
        for (int t = 0; t < nt; t += 2) {
            const bool last = (t == nt - 2);
            const char* a1 = cA + (size_t)(t + 1) * kstep;
            const char* a2 = last ? nA : cA + (size_t)(t + 2) * kstep; const char* b2 = last ? nB : cB + (size_t)(t + 2) * kstep;
            const char* a3 = a2 + kstep; const char* b3 = b2 + kstep;
            if (last && has_next) S.a_ready(nxt);
            if constexpr (SP2) {
            PG8_LDB(B0, 0, 0); PG8_LDB(B1, 0, 1); PG8_SCHED; PG8_LDA(At, 0, 0); PG8_STAGE(PG8_SA(1, 1), a1 + hstepA, voffA);
            PG8_WAIT_V(8); PG8_WAIT_L(0); PG8_BAR; PG8_MMA(0, 0, At, B0); PG8_MMA(0, 1, At, B1); PG8_BAR; PG8_SCHED;
            PG8_LDA(At, 0, 1); PG8_STAGE(PG8_SB(0, 0), b2, voffB); PG8_STAGE(PG8_SB(0, 1), b2 + hstepB, voffB); PG8_STAGE(PG8_SA(0, 0), a2, voffA);
            PG8_WAIT_V(8); PG8_WAIT_L(0); PG8_BAR; PG8_MMA(1, 0, At, B0); PG8_MMA(1, 1, At, B1); PG8_BAR; PG8_SCHED;
            PG8_LDB(B0, 1, 0); PG8_LDB(B1, 1, 1); PG8_SCHED; PG8_LDA(At, 1, 0); PG8_STAGE(PG8_SA(0, 1), a2 + hstepA, voffA);
            PG8_WAIT_V(8); PG8_WAIT_L(0); PG8_BAR; PG8_MMA(0, 0, At, B0); PG8_MMA(0, 1, At, B1); PG8_BAR; PG8_SCHED;
            PG8_LDA(At, 1, 1); PG8_STAGE(PG8_SB(1, 0), b3, voffB); PG8_STAGE(PG8_SB(1, 1), b3 + hstepB, voffB); PG8_STAGE(PG8_SA(1, 0), a3, voffA);
            PG8_WAIT_V(8); PG8_WAIT_L(0); PG8_BAR; PG8_MMA(1, 0, At, B0); PG8_MMA(1, 1, At, B1); PG8_BAR; PG8_SCHED;
            } else {
            PG8_LDB(B0, 0, 0); PG8_SCHED; PG8_LDA(At, 0, 0); PG8_STAGE(PG8_SA(1, 1), a1 + hstepA, voffA);
            PG8_WAIT_L(8); PG8_BAR; PG8_WAIT_L(0); PG8_MMA(0, 0, At, B0); PG8_BAR; PG8_SCHED;
            PG8_LDB(B1, 0, 1); PG8_STAGE(PG8_SB(0, 0), b2, voffB);
            PG8_BAR; PG8_WAIT_L(0); PG8_MMA(0, 1, At, B1); PG8_BAR;
            PG8_LDA(At, 0, 1); PG8_STAGE(PG8_SA(0, 0), a2, voffA);
            PG8_BAR; PG8_WAIT_L(0); PG8_MMA(1, 0, At, B0); PG8_BAR; PG8_SCHED;
            PG8_STAGE(PG8_SB(0, 1), b2 + hstepB, voffB);
            PG8_WAIT_V(6); PG8_BAR; PG8_MMA(1, 1, At, B1); PG8_BAR;
            PG8_LDB(B0, 1, 0); PG8_SCHED; PG8_LDA(At, 1, 0); PG8_STAGE(PG8_SA(0, 1), a2 + hstepA, voffA);
            PG8_WAIT_L(8); PG8_BAR; PG8_WAIT_L(0); PG8_MMA(0, 0, At, B0); PG8_BAR; PG8_SCHED;
            PG8_LDB(B1, 1, 1); PG8_STAGE(PG8_SB(1, 0), b3, voffB);
            PG8_BAR; PG8_WAIT_L(0); PG8_MMA(0, 1, At, B1); PG8_BAR;
            PG8_LDA(At, 1, 1); PG8_STAGE(PG8_SA(1, 0), a3, voffA);
            PG8_BAR; PG8_WAIT_L(0); PG8_MMA(1, 0, At, B0); PG8_BAR; PG8_SCHED;
            PG8_STAGE(PG8_SB(1, 1), b3 + hstepB, voffB);
            PG8_WAIT_V(6); PG8_BAR; PG8_MMA(1, 1, At, B1); PG8_BAR;
            }
        }
        if constexpr (ALIGN_EPI) { if (wr == 0) PG8_BAR; }
        if constexpr (!Epi::AFTER_DRAIN) { E(acc, cur, wr, wc, fr, fq); S.done(cur); }
        if (!has_next) break;
#pragma unroll
        for (int a = 0; a < 2; ++a)
#pragma unroll
            for (int b = 0; b < 2; ++b)
#pragma unroll
                for (int m = 0; m < 4; ++m)
#pragma unroll
                    for (int n = 0; n < 2; ++n) acc[a][b][m][n] = (f32x4){0.f, 0.f, 0.f, 0.f};
        cur = nxt; cA = nA; cB = nB; ++ui;
        if constexpr (ALIGN_EPI) { if (wr == 1) PG8_BAR; }
    }
    PG8_WAIT_V(0);
    if constexpr (!ALIGN_EPI) { if (wr == 0) PG8_BAR; }
    PG8_BAR;
    if constexpr (Epi::AFTER_DRAIN) { E.fused(acc, cur, wr, wc, fr, fq, lds, wid, lane); S.done(cur); }
#undef PG8_SA
#undef PG8_SB
#undef PG8_STAGE
#undef PG8_LDA
#undef PG8_LDB
#undef PG8_MMA
#undef PG8_WAIT_V
#undef PG8_WAIT_L
#undef PG8_BAR
#undef PG8_SCHED
}
}

#ifndef PG8_SP2
#define PG8_SP2 true
#endif
#ifndef PG8_ALIGN
#define PG8_ALIGN true
#endif

constexpr int NWAVES = 8;
#ifndef MK_ONE_LAUNCH
#define MK_ONE_LAUNCH 1
#endif
constexpr int NPHASES = 8;

constexpr int BATCH = 8, SEQ = 8192, D = 1024, M = BATCH * SEQ, NIN = 7168;
constexpr int RH = 4, DK = 128, DV = 256, CH = 64, NCH = SEQ / CH;
constexpr float LN_EPS = 1e-5f;
constexpr float DN_ALPHA = 1.189207115002721f;

constexpr size_t MiB = 1u << 20;
constexpr size_t WS_CTL = 0, CTL_ZERO_BYTES = 1 * MiB;
constexpr size_t WS_WIN = 2 * MiB;
constexpr size_t WS_PCAT = 16 * MiB;
constexpr size_t WS_WOUT = 20 * MiB;
constexpr size_t WS_ROPE = 22 * MiB;
constexpr size_t WS_Q = 32 * MiB, WS_K = 96 * MiB, WS_V = 160 * MiB, WS_SGR = 288 * MiB, WS_XL = 416 * MiB, WS_SGL = 544 * MiB, WS_GR = 672 * MiB, WS_GL = 800 * MiB, WS_END = 928 * MiB;
constexpr size_t WS_SLOC = 928 * MiB, WS_END2 = 960 * MiB;
constexpr size_t WS_MERGED = WS_Q;
constexpr int CW_TMO = 0, CW_CODE = 1, CW_BAR = 4096;

constexpr int RING_OFF = 0, RING_BYTES = 131072;
constexpr int LDSCTL_OFF = 163328, MISC_OFF = LDSCTL_OFF + 320;
constexpr int LDS_BYTES = 163840;
static_assert(MISC_OFF + 128 <= LDS_BYTES, "LDS map");

#define GAS __attribute__((address_space(1)))
#define LAS __attribute__((address_space(3)))
typedef unsigned short bf16;
typedef unsigned v4u __attribute__((ext_vector_type(4)));
typedef unsigned v2u __attribute__((ext_vector_type(2)));
typedef float f32x4 __attribute__((ext_vector_type(4)));
typedef GAS unsigned gu32;
#define RLX_AGENT __ATOMIC_RELAXED, __HIP_MEMORY_SCOPE_AGENT
#define LDS_WAIT() asm volatile("s_waitcnt lgkmcnt(0)" ::: "memory")
#define VM_WAIT() asm volatile("s_waitcnt vmcnt(0)" ::: "memory")
__device__ __forceinline__ unsigned f2bf(float f) { unsigned u = __builtin_bit_cast(unsigned, f); return (u + 0x7fffu + ((u >> 16) & 1u)) >> 16; }
__device__ __forceinline__ unsigned pk2(float lo, float hi) { return f2bf(lo) | (f2bf(hi) << 16); }
__device__ __forceinline__ float bflo(unsigned w) { return __builtin_bit_cast(float, w << 16); }
__device__ __forceinline__ float bfhi(unsigned w) { return __builtin_bit_cast(float, w & 0xffff0000u); }
__device__ __forceinline__ float bf2f(bf16 b) { return __builtin_bit_cast(float, ((unsigned)b) << 16); }

#define XB_TMO      128
#define XB_XCNT(j)  (256  + 64 * (j))
#define XB_XSUB(j)  (1280 + 64 * (j))
#define XB_XGEN(j)  (2304 + 64 * (j))
#define XB_TOP      3328
#define XB_TOPGEN   3392
#define XCD_BAR_WORDS 3456
#define XB_SPIN_CAP (1u << 18)

__device__ __forceinline__ unsigned xb_ld(unsigned* p)              { return __hip_atomic_load(p, __ATOMIC_RELAXED, __HIP_MEMORY_SCOPE_AGENT); }
__device__ __forceinline__ unsigned xb_add(unsigned* p, unsigned v) { return __hip_atomic_fetch_add(p, v, __ATOMIC_RELAXED, __HIP_MEMORY_SCOPE_AGENT); }
__device__ __forceinline__ unsigned xb_xcc_id() { return (unsigned)__builtin_amdgcn_s_getreg((3 << 11) | 20) & 0xFu; }
#define XB_SPIN(cond, bar) do { unsigned _sp = 0; while (cond) { __builtin_amdgcn_s_sleep(1); \
    if ((++_sp & 255u) == 0u) { if (xb_ld(&(bar)[XB_TMO])) break; if (_sp > XB_SPIN_CAP) { atomicAdd(&(bar)[XB_TMO], 1u); break; } } } } while (0)

struct XcdBarrier {
    unsigned* bar; unsigned x;
    volatile LAS unsigned* st;
};

__device__ __forceinline__ XcdBarrier xcd_barrier_post(unsigned* bar, volatile LAS unsigned* st) {
    XcdBarrier b; b.bar = bar; b.x = xb_xcc_id(); b.st = st;
    if (threadIdx.x == 0) (void)xb_add(&bar[XB_XCNT(b.x)], 1u);
    return b;
}
__device__ __forceinline__ void xcd_barrier_complete(unsigned* bar, unsigned x, unsigned& nloc, unsigned& nx) {
    const unsigned G = gridDim.x * gridDim.y * gridDim.z;
    unsigned sum, cnt, mine, sp = 0u;
    for (;;) {
        sum = 0u; cnt = 0u; mine = 0u;
#pragma unroll
        for (unsigned j = 0; j < 16; ++j) { const unsigned c = xb_ld(&bar[XB_XCNT(j)]); sum += c; cnt += (c > 0u) ? 1u : 0u; mine = (j == x) ? c : mine; }
        if (sum == G) break;
        __builtin_amdgcn_s_sleep(1);
        if ((++sp & 255u) == 0u) { if (xb_ld(&bar[XB_TMO])) break; if (sp > XB_SPIN_CAP) { atomicAdd(&bar[XB_TMO], 1u); break; } }
    }
    nloc = mine > 0u ? mine : 1u; nx = cnt > 0u ? cnt : 1u;
}

__device__ __forceinline__ void xcd_barrier(const XcdBarrier& b) {
    asm volatile("s_waitcnt vmcnt(0)" ::: "memory");
    __syncthreads();
    if (threadIdx.x == 0) {
        unsigned* bar = b.bar;
        __builtin_amdgcn_s_waitcnt(0);
        unsigned nloc = b.st[0], nx = b.st[1];
        if (nloc == 0u) { xcd_barrier_complete(bar, b.x, nloc, nx); b.st[0] = nloc; b.st[1] = nx; }
        const unsigned old = xb_add(&bar[XB_XSUB(b.x)], 1u);
        const unsigned gen = old / nloc;
        if (old + 1u == (gen + 1u) * nloc) {
            __builtin_amdgcn_fence(__ATOMIC_RELEASE, "agent");
            asm volatile("s_waitcnt vmcnt(0)" ::: "memory");
            const unsigned og = xb_add(&bar[XB_TOP], 1u);
            const unsigned tg = og / nx;
            if (og + 1u == (tg + 1u) * nx) xb_add(&bar[XB_TOPGEN], 1u);
            else XB_SPIN(xb_ld(&bar[XB_TOPGEN]) == tg, bar);
            __builtin_amdgcn_fence(__ATOMIC_ACQUIRE, "agent");
            xb_add(&bar[XB_XGEN(b.x)], 1u);
            asm volatile("s_waitcnt vmcnt(0)" ::: "memory");
        } else {
            XB_SPIN(xb_ld(&bar[XB_XGEN(b.x)]) == gen, bar);
            __builtin_amdgcn_fence(__ATOMIC_ACQUIRE, "agent");
            asm volatile("s_waitcnt vmcnt(0)" ::: "memory");
        }
    }
    __syncthreads();
}


namespace rt {
#define RT_DI __device__ __forceinline__
typedef short bf16x8 __attribute__((ext_vector_type(8)));
typedef short s16x4 __attribute__((ext_vector_type(4)));
typedef short v4i16_t __attribute__((ext_vector_type(4)));
typedef float f32x16 __attribute__((ext_vector_type(16)));
typedef float f32x2_t __attribute__((ext_vector_type(2)));
typedef __bf16 bf16x2_t __attribute__((ext_vector_type(2)));
typedef LAS const char* lds_cptr;
constexpr int NSEG = 8, CPS = NCH / NSEG;
constexpr int L_QT = 0, L_KT = 16384, L_VT = 32768, L_PT = 65536, L_ST = 73728, L_GB = 77824;
RT_DI unsigned cvtpk(float lo, float hi) { f32x2_t v = {lo, hi}; bf16x2_t b = __builtin_convertvector(v, bf16x2_t); return __builtin_bit_cast(unsigned, b); }
RT_DI unsigned off_b(unsigned row, unsigned ch) { return 256u * row + 16u * (ch ^ (((row & 3u) << 2) | ((row >> 2) & 3u))); }
RT_DI unsigned off_p(unsigned row, unsigned ch) { return 128u * row + 16u * (ch ^ ((row >> 1) & 7u)); }
RT_DI s16x4 trd(lds_cptr p) { return __builtin_bit_cast(s16x4, __builtin_amdgcn_ds_read_tr16_b64_v4i16((LAS v4i16_t*)p)); }
RT_DI bf16x8 tr8(lds_cptr tile, unsigned lane, unsigned c, unsigned ks) {
    const unsigned hh = lane >> 5, blk = (lane >> 4) & 1u, q = (lane & 15u) >> 2, p = lane & 3u;
    const s16x4 lo = trd(tile + off_b(16 * ks + 8 * hh + q, 4 * c + 2 * blk + (p >> 1)) + 8 * (p & 1u));
    const s16x4 hi = trd(tile + off_b(16 * ks + 8 * hh + 4 + q, 4 * c + 2 * blk + (p >> 1)) + 8 * (p & 1u));
    return __builtin_shufflevector(lo, hi, 0, 1, 2, 3, 4, 5, 6, 7);
}
RT_DI bf16x8 scale_frag(bf16x8 v, const float (&f)[8]) {
    const v4u w = __builtin_bit_cast(v4u, v); v4u o;
    o.x = cvtpk(bflo(w.x) * f[0], bfhi(w.x) * f[1]); o.y = cvtpk(bflo(w.y) * f[2], bfhi(w.y) * f[3]);
    o.z = cvtpk(bflo(w.z) * f[4], bfhi(w.z) * f[5]); o.w = cvtpk(bflo(w.w) * f[6], bfhi(w.w) * f[7]);
    return __builtin_bit_cast(bf16x8, o);
}
RT_DI bf16x8 pack8(const f32x16& x, int s) {
    v4u o; o.x = cvtpk(x[8 * s], x[8 * s + 1]); o.y = cvtpk(x[8 * s + 2], x[8 * s + 3]); o.z = cvtpk(x[8 * s + 4], x[8 * s + 5]); o.w = cvtpk(x[8 * s + 6], x[8 * s + 7]);
    return __builtin_bit_cast(bf16x8, o);
}
#define RT_MFMA32(a, b, c) __builtin_amdgcn_mfma_f32_32x32x16_bf16((a), (b), (c), 0, 0, 0)
#define RT_MFMA16(a, b, c) __builtin_amdgcn_mfma_f32_16x16x32_bf16((a), (b), (c), 0, 0, 0)

struct Stage { v4u q[2], k[2], v[4]; };
template <bool WITH_Q>
RT_DI void stage_load(Stage& st, const bf16* Q, const bf16* K, const bf16* V, size_t m0, int h, int t) {
    const char* qb = (const char*)(Q + m0 * 512 + h * 128); const char* kb = (const char*)(K + m0 * 512 + h * 128); const char* vb = (const char*)(V + m0 * 1024 + h * 256);
#pragma unroll
    for (int k = 0; k < 2; ++k) { const int id = t + 512 * k, row = id >> 4, ch = id & 15; const unsigned off = (unsigned)(row * 512 + ch * 8) * 2u;
        if (WITH_Q) st.q[k] = *(const GAS v4u*)(qb + off);
        st.k[k] = *(const GAS v4u*)(kb + off); }
#pragma unroll
    for (int k = 0; k < 4; ++k) { const int id = t + 512 * k, row = id >> 5, c32 = id & 31; const unsigned off = (unsigned)(row * 1024 + c32 * 8) * 2u;
        st.v[k] = *(const GAS v4u*)(vb + off); }
}
template <bool WITH_Q>
RT_DI void stage_write(const Stage& st, LAS unsigned char* lds, int t) {
#pragma unroll
    for (int k = 0; k < 2; ++k) { const int id = t + 512 * k, row = id >> 4, ch = id & 15;
        if (WITH_Q) *(LAS v4u*)(lds + L_QT + off_b(row, ch)) = st.q[k];
        *(LAS v4u*)(lds + L_KT + off_b(row, ch)) = st.k[k]; }
#pragma unroll
    for (int k = 0; k < 4; ++k) { const int id = t + 512 * k, row = id >> 5, c32 = id & 31;
        *(LAS v4u*)(lds + L_VT + (c32 >> 4) * 16384 + off_b(row, c32 & 15)) = st.v[k]; }
}
RT_DI void kv_update(f32x16 (&S)[4], const bf16x8 (&vf)[4], lds_cptr KT, unsigned lane, float cdec, const float (&wj)[8], const float (&fk)[4]) {
#pragma unroll
    for (int dt = 0; dt < 4; ++dt) S[dt] = S[dt] * cdec;
#pragma unroll
    for (int ks = 0; ks < 4; ++ks) {
        float f[8];
#pragma unroll
        for (int jj = 0; jj < 8; ++jj) f[jj] = wj[jj] * fk[ks];
        const bf16x8 vs = scale_frag(vf[ks], f);
#pragma unroll
        for (int dt = 0; dt < 4; ++dt) { const bf16x8 kf = tr8(KT, lane, dt, ks); S[dt] = RT_MFMA32(kf, vs, S[dt]); }
    }
}
RT_DI int crow(int reg, int hh) { return (reg & 3) + 8 * (reg >> 2) + 4 * hh; }

RT_DI void pass1(LAS unsigned char* lds, int tid, int wave, int item, const bf16* K, const bf16* V, float* SLOC) {
    const int chain = item >> 3, seg = item & 7, b = chain >> 2, h = chain & 3;
    if (seg == NSEG - 1) return;
    const unsigned lane = tid & 63, r = lane & 31, hh = lane >> 5;
    const float lg = log1pf(-exp2f(-5.f - (float)h));
    const float cdec = expf(lg * 64.f);
    float wj[8], fk[4];
#pragma unroll
    for (int jj = 0; jj < 8; ++jj) wj[jj] = expf(lg * (float)(7 - jj));
#pragma unroll
    for (int ks = 0; ks < 4; ++ks) fk[ks] = expf(lg * (float)(56 - 16 * ks - 8 * (int)hh));
    f32x16 S[4];
#pragma unroll
    for (int dt = 0; dt < 4; ++dt)
#pragma unroll
        for (int i = 0; i < 16; ++i) S[dt][i] = 0.f;
    lds_cptr KT = (lds_cptr)(lds + L_KT), VT = (lds_cptr)(lds + L_VT + (wave >> 2) * 16384);
    Stage st;
    const size_t mseg = (size_t)b * SEQ + (size_t)seg * CPS * CH;
    stage_load<false>(st, nullptr, K, V, mseg, h, tid);
    for (int c = 0; c < CPS; ++c) {
        __syncthreads();
        stage_write<false>(st, lds, tid);
        __syncthreads();
        if (c + 1 < CPS) stage_load<false>(st, nullptr, K, V, mseg + (size_t)(c + 1) * CH, h, tid);
        bf16x8 vf[4];
#pragma unroll
        for (int ks = 0; ks < 4; ++ks) vf[ks] = tr8(VT, lane, wave & 3, ks);
        kv_update(S, vf, KT, lane, cdec, wj, fk);
    }
    float* dst = SLOC + (size_t)item * (128 * 256) + wave * 4096 + lane;
#pragma unroll
    for (int dt = 0; dt < 4; ++dt)
#pragma unroll
        for (int i = 0; i < 16; ++i) dst[(dt * 16 + i) * 64] = S[dt][i];
}

RT_DI void pass2(LAS unsigned char* lds, int tid_, int wave, int item, const bf16* Q, const bf16* K, const bf16* V, bf16* SGR, const float* SLOC, const float* gn_g, const float* gn_b) {
    const int chain = item >> 3, seg = item & 7, b = chain >> 2, h = chain & 3;
    const unsigned lane_ = tid_ & 63; const int tid = tid_;
    float cdec, lg2; const int it16 = wave >> 1, jt0 = 2 * (wave & 1);
    f32x16 S[4];
    {
    const unsigned lane = lane_;
    const float lg = log1pf(-exp2f(-5.f - (float)h));
    cdec = expf(lg * 64.f); lg2 = lg * 1.4426950408889634f;
#pragma unroll
    for (int dt = 0; dt < 4; ++dt)
#pragma unroll
        for (int i = 0; i < 16; ++i) S[dt][i] = 0.f;
    {
        const float sdec = expf(lg * (float)(CPS * CH));
        for (int g = 0; g < seg; ++g) { const float* src = SLOC + (size_t)(chain * NSEG + g) * (128 * 256) + wave * 4096 + lane;
#pragma unroll
            for (int dt = 0; dt < 4; ++dt)
#pragma unroll
                for (int i = 0; i < 16; ++i) S[dt][i] = S[dt][i] * sdec + src[(dt * 16 + i) * 64]; }
    }
    }
    __syncthreads();
    for (int i = tid; i < 512; i += 512) ((LAS float*)(lds + L_GB))[i] = (i < 256) ? gn_g[h * 256 + i] : gn_b[h * 256 + i - 256];
    lds_cptr QT = (lds_cptr)(lds + L_QT), KT = (lds_cptr)(lds + L_KT), VT = (lds_cptr)(lds + L_VT + (wave >> 2) * 16384), PT = (lds_cptr)(lds + L_PT);
    Stage st;
    const size_t mseg = (size_t)b * SEQ + (size_t)seg * CPS * CH;
    stage_load<true>(st, Q, K, V, mseg, h, tid);
    for (int c = 0; c < CPS; ++c) {
        const size_t m0 = mseg + (size_t)c * CH;
        int tid = tid_; asm volatile("" : "+v"(tid));
        const unsigned lane = tid & 63, r = lane & 31, hh = lane >> 5, fr = lane & 15, fq = lane >> 4;
        float wj[8], fk[4], pdec[2][4];
#pragma unroll
        for (int jj = 0; jj < 8; ++jj) wj[jj] = __builtin_amdgcn_exp2f(lg2 * (float)(7 - jj));
#pragma unroll
        for (int ks = 0; ks < 4; ++ks) fk[ks] = __builtin_amdgcn_exp2f(lg2 * (float)(56 - 16 * ks - 8 * (int)hh));
        const float qd0 = __builtin_amdgcn_exp2f(lg2 * (float)(r + 1)), qd1 = __builtin_amdgcn_exp2f(lg2 * (float)(r + 33));
#pragma unroll
        for (int tt = 0; tt < 2; ++tt)
#pragma unroll
            for (int e = 0; e < 4; ++e) { const int i = 16 * it16 + (int)fr, j = 16 * (jt0 + tt) + 4 * (int)fq + e; pdec[tt][e] = __builtin_amdgcn_exp2f(lg2 * (float)(i > j ? i - j : j - i)); }
        stage_write<true>(st, lds, tid);
        __syncthreads();
        {
            f32x4 p[2] = {(f32x4){0.f, 0.f, 0.f, 0.f}, (f32x4){0.f, 0.f, 0.f, 0.f}};
#pragma unroll
            for (int s = 0; s < 4; ++s) {
                const bf16x8 qf = *(const LAS bf16x8*)(QT + off_b(fr + 16 * it16, 4 * s + fq));
#pragma unroll
                for (int tt = 0; tt < 2; ++tt) { const bf16x8 kf = *(const LAS bf16x8*)(KT + off_b(fr + 16 * (jt0 + tt), 4 * s + fq)); p[tt] = RT_MFMA16(kf, qf, p[tt]); }
            }
#pragma unroll
            for (int tt = 0; tt < 2; ++tt) { v2u w; w.x = cvtpk(p[tt][0] * pdec[tt][0], p[tt][1] * pdec[tt][1]); w.y = cvtpk(p[tt][2] * pdec[tt][2], p[tt][3] * pdec[tt][3]);
                *(LAS v2u*)(lds + L_PT + off_p(16 * it16 + fr, 2 * (jt0 + tt) + (fq >> 1)) + 8 * (fq & 1)) = w; }
        }
        __syncthreads();
        f32x16 z[2];
#pragma unroll
        for (int it = 0; it < 2; ++it)
#pragma unroll
            for (int i = 0; i < 16; ++i) z[it][i] = 0.f;
#pragma unroll
        for (int dt = 0; dt < 4; ++dt)
#pragma unroll
            for (int s = 0; s < 2; ++s) {
                const bf16x8 xs = pack8(S[dt], s);
#pragma unroll
                for (int it = 0; it < 2; ++it) {
                    const s16x4 lo = *(const LAS s16x4*)(QT + off_b(32 * it + r, 4 * dt + 2 * s) + 8 * hh);
                    const s16x4 hi = *(const LAS s16x4*)(QT + off_b(32 * it + r, 4 * dt + 2 * s + 1) + 8 * hh);
                    const bf16x8 qb = __builtin_shufflevector(lo, hi, 0, 1, 2, 3, 4, 5, 6, 7);
                    z[it] = RT_MFMA32(xs, qb, z[it]);
                }
            }
        z[0] = z[0] * qd0; z[1] = z[1] * qd1;
        bf16x8 vf[4];
#pragma unroll
        for (int ks = 0; ks < 4; ++ks) vf[ks] = tr8(VT, lane, wave & 3, ks);
#pragma unroll
        for (int ks = 0; ks < 4; ++ks)
#pragma unroll
            for (int it = 0; it < 2; ++it) { const bf16x8 pf = *(const LAS bf16x8*)(PT + off_p(32 * it + r, 2 * ks + hh)); z[it] = RT_MFMA32(vf[ks], pf, z[it]); }
        kv_update(S, vf, KT, lane, cdec, wj, fk);
        if (c + 1 < CPS) stage_load<true>(st, Q, K, V, m0 + CH, h, tid);
        bf16* orow0 = SGR + (m0 + r) * 1024 + h * 256 + 32 * wave + 4 * hh;
        v2u sg[2][4];
#pragma unroll
        for (int it = 0; it < 2; ++it)
#pragma unroll
            for (int g4 = 0; g4 < 4; ++g4) sg[it][g4] = *(const GAS v2u*)(orow0 + (size_t)it * 32 * 1024 + 8 * g4);
        typedef float f2 __attribute__((ext_vector_type(2)));
#pragma unroll
        for (int it = 0; it < 2; ++it) {
            float s1 = 0.f;
#pragma unroll
            for (int i = 0; i < 16; ++i) s1 += z[it][i];
            s1 += __shfl_xor(s1, 32);
            const float mw = s1 * (1.f / 32.f); float m2 = 0.f;
#pragma unroll
            for (int i = 0; i < 16; ++i) { const float d = z[it][i] - mw; m2 += d * d; }
            m2 += __shfl_xor(m2, 32);
            if (hh == 0) *(LAS f2*)(lds + L_ST + ((32 * it + r) * 8 + wave) * 8) = (f2){mw, m2};
        }
        __syncthreads();
#pragma unroll
        for (int it = 0; it < 2; ++it) {
            const LAS f32x4* sp = (const LAS f32x4*)(lds + L_ST + (32 * it + r) * 64);
            const f32x4 a0 = sp[0], a1 = sp[1], a2 = sp[2], a3 = sp[3];
            const float mean = ((a0[0] + a0[2]) + (a1[0] + a1[2]) + (a2[0] + a2[2]) + (a3[0] + a3[2])) * 0.125f;
            float q = (a0[1] + a0[3]) + (a1[1] + a1[3]) + (a2[1] + a2[3]) + (a3[1] + a3[3]);
            { const float d0 = a0[0] - mean, d1 = a0[2] - mean, d2 = a1[0] - mean, d3 = a1[2] - mean, d4 = a2[0] - mean, d5 = a2[2] - mean, d6 = a3[0] - mean, d7 = a3[2] - mean;
              q += 32.f * ((d0 * d0 + d1 * d1) + (d2 * d2 + d3 * d3) + (d4 * d4 + d5 * d5) + (d6 * d6 + d7 * d7)); }
            const float rstd = 1.f / sqrtf(q * (1.f / 256.f) + LN_EPS);
#pragma unroll
            for (int g4 = 0; g4 < 4; ++g4) {
                const f32x4 gg = *(const LAS f32x4*)(lds + L_GB + (32 * wave + 8 * g4 + 4 * hh) * 4), bb = *(const LAS f32x4*)(lds + L_GB + 1024 + (32 * wave + 8 * g4 + 4 * hh) * 4);
                const float y0 = (z[it][4 * g4 + 0] - mean) * rstd * gg[0] + bb[0], y1 = (z[it][4 * g4 + 1] - mean) * rstd * gg[1] + bb[1];
                const float y2 = (z[it][4 * g4 + 2] - mean) * rstd * gg[2] + bb[2], y3 = (z[it][4 * g4 + 3] - mean) * rstd * gg[3] + bb[3];
                v2u w; w.x = cvtpk(bflo(sg[it][g4].x) * y0, bfhi(sg[it][g4].x) * y1); w.y = cvtpk(bflo(sg[it][g4].y) * y2, bfhi(sg[it][g4].y) * y3);
                *(GAS v2u*)(orow0 + (size_t)it * 32 * 1024 + 8 * g4) = w;
            }
        }
    }
    __syncthreads();
}
#undef RT_MFMA32
#undef RT_MFMA16
#undef RT_DI
}


namespace lr {
#define LR_DI __device__ __forceinline__
typedef short bf16x8 __attribute__((ext_vector_type(8)));
typedef float f32x16 __attribute__((ext_vector_type(16)));
constexpr int TOK = 256, NIT = SEQ / TOK, XT_ROWS = 260;
constexpr int L_XT = 0, L_WT = XT_ROWS * 256, L_AG = L_WT + 65536, L_BIAS = L_AG + 2048, L_END = L_BIAS + 256;
struct XStage { v4u v[9]; };
LR_DI void x_load(XStage& st, const bf16* XL, int b, int cb, int t0, int t) {
    const char* base = (const char*)(XL + ((size_t)b * SEQ + t0) * 1024 + cb * 128) - 3 * 2048;
#pragma unroll
    for (int k = 0; k < 9; ++k) { const int id = t + 512 * k, R = id >> 4, ch = id & 15;
        v4u v = (v4u){0u, 0u, 0u, 0u};
        if (id < 259 * 16 && (t0 + R >= 3)) v = *(const GAS v4u*)(base + (unsigned)(R * 2048 + ch * 16));
        st.v[k] = v; }
}
LR_DI void x_write(const XStage& st, LAS unsigned char* lds, int t) {
#pragma unroll
    for (int k = 0; k < 9; ++k) { const int id = t + 512 * k, R = id >> 4, ch = id & 15;
        if (id < 259 * 16) *(LAS v4u*)(lds + L_XT + R * 256 + 16 * (ch ^ (R & 15))) = st.v[k]; }
}
LR_DI void run(LAS unsigned char* lds, int tid_, int wave, int item, const bf16* XL, bf16* SGL, const float* conv_w, const float* conv_b,
               const float* w_a, const float* b_a, const float* w_x, const float* b_x, const float* lam) {
    const int b = item >> 5, cb = (item >> 2) & 7, q = item & 3;
    float bias_r, bias_i, Lc2, Lcn2, cw0, cw1, cw2, cw3, cbv;
    {
        const int tid = tid_;
        __syncthreads();
#pragma unroll 1
        for (int i = 0; i < 8; ++i) { const int id = tid + 512 * i, mi = id >> 9, n = (id >> 4) & 31, ch = id & 15, gate = mi >> 2, j = mi & 3;
            const float* W = gate ? w_x : w_a; float v[8];
#pragma unroll
            for (int e = 0; e < 8; ++e) { const int k = 8 * ch + e; v[e] = conv_w[j * 1024 + cb * 128 + k] * W[((size_t)cb * 128 + k) * 128 + q * 32 + n]; }
            v4u o; o.x = rt::cvtpk(v[0], v[1]); o.y = rt::cvtpk(v[2], v[3]); o.z = rt::cvtpk(v[4], v[5]); o.w = rt::cvtpk(v[6], v[7]);
            *(LAS v4u*)(lds + L_WT + mi * 8192 + rt::off_b(n, ch)) = o; }
        if (tid < 64) { const int gate = tid >> 5, n = tid & 31; const float* W = gate ? w_x : w_a; float s = (gate ? b_x : b_a)[cb * 128 + q * 32 + n];
            for (int k = 0; k < 128; ++k) s += conv_b[cb * 128 + k] * W[((size_t)cb * 128 + k) * 128 + q * 32 + n];
            ((LAS float*)(lds + L_BIAS))[gate * 32 + n] = s; }
        __syncthreads();
        const int r = tid & 31, chn = cb * 128 + q * 32 + r;
        bias_r = ((LAS float*)(lds + L_BIAS))[r]; bias_i = ((LAS float*)(lds + L_BIAS))[32 + r];
        const float Lc = -8.0f * log1pf(expf(-lam[chn]));
        Lc2 = Lc * 1.4426950408889634f; Lcn2 = 2.0f * Lc;
        cw0 = conv_w[chn]; cw1 = conv_w[1024 + chn]; cw2 = conv_w[2048 + chn]; cw3 = conv_w[3072 + chn]; cbv = conv_b[chn];
    }
    float carry = 0.f;
    XStage st;
    x_load(st, XL, b, cb, 0, tid_);
#pragma unroll 1
    for (int it = 0; it < NIT; ++it) {
        const int t0 = it * TOK;
        int tid = tid_; asm volatile("" : "+v"(tid));
        const unsigned lane = tid & 63, r = lane & 31, hh = lane >> 5;
        x_write(st, lds, tid);
        __syncthreads();
        f32x16 ar, ai;
#pragma unroll
        for (int i = 0; i < 16; ++i) { ar[i] = bias_r; ai[i] = bias_i; }
#pragma unroll
        for (int j = 0; j < 4; ++j) {
            const unsigned R = 32 * wave + r + j;
#pragma unroll
            for (int ks = 0; ks < 8; ++ks) {
                const bf16x8 xa = *(const LAS bf16x8*)(lds + L_XT + R * 256 + 16 * ((2 * ks + hh) ^ (R & 15)));
                const bf16x8 wa = *(const LAS bf16x8*)(lds + L_WT + j * 8192 + rt::off_b(r, 2 * ks + hh));
                const bf16x8 wx = *(const LAS bf16x8*)(lds + L_WT + (4 + j) * 8192 + rt::off_b(r, 2 * ks + hh));
                ar = __builtin_amdgcn_mfma_f32_32x32x16_bf16(xa, wa, ar, 0, 0, 0);
                ai = __builtin_amdgcn_mfma_f32_32x32x16_bf16(xa, wx, ai, 0, 0, 0);
            }
        }
        float xc[16];
        {
            const unsigned c = 32 * q + r, ch0 = c >> 3, sub = 2 * (c & 7);
#pragma unroll
            for (int g = 0; g < 4; ++g) {
                float xv[7];
#pragma unroll
                for (int d = 0; d < 7; ++d) { const unsigned R = 32 * wave + 8 * g + 4 * hh + d;
                    xv[d] = bf2f(*(const LAS bf16*)(lds + L_XT + R * 256 + 16 * (ch0 ^ (R & 15)) + sub)); }
#pragma unroll
                for (int e = 0; e < 4; ++e) xc[4 * g + e] = cbv + cw0 * xv[e] + cw1 * xv[e + 1] + cw2 * xv[e + 2] + cw3 * xv[e + 3];
            }
        }
        bf16* orow = SGL + ((size_t)b * SEQ + t0 + 32 * wave + 4 * hh) * 1024 + cb * 128 + q * 32 + r;
        bf16 sg[16];
#pragma unroll
        for (int i = 0; i < 16; ++i) sg[i] = *(const GAS bf16*)(orow + (size_t)((i & 3) + 8 * (i >> 2)) * 1024);
        if (it + 1 < NIT) x_load(st, XL, b, cb, t0 + TOK, tid);
        float a[16], u[16];
#pragma unroll
        for (int i = 0; i < 16; ++i) {
            const float rg = __builtin_amdgcn_rcpf(1.0f + __builtin_amdgcn_exp2f(-1.4426950408889634f * ar[i]));
            const float ig = __builtin_amdgcn_rcpf(1.0f + __builtin_amdgcn_exp2f(-1.4426950408889634f * ai[i]));
            const float av = __builtin_amdgcn_exp2f(rg * Lc2);
            const float y = rg * Lcn2;
            const float s_small = -y * (1.0f + y * (0.5f + y * (0.16666667f + y * 0.041666668f)));
            const float s_big = 1.0f - av * av;
            const float s = (y > -0.25f) ? s_small : s_big;
            a[i] = av; u[i] = __builtin_amdgcn_sqrtf(s) * (ig * xc[i]);
        }
        float Ag[4], Hg[4], Ap[4], Hp[4];
#pragma unroll
        for (int g = 0; g < 4; ++g) { Ag[g] = (a[4 * g] * a[4 * g + 1]) * (a[4 * g + 2] * a[4 * g + 3]);
            Hg[g] = ((u[4 * g] * a[4 * g + 1] + u[4 * g + 1]) * a[4 * g + 2] + u[4 * g + 2]) * a[4 * g + 3] + u[4 * g + 3];
            Ap[g] = __shfl_xor(Ag[g], 32); Hp[g] = __shfl_xor(Hg[g], 32); }
        float Ac = 1.0f, Hc = 0.0f, Ab[4], Hb[4];
#pragma unroll
        for (int g = 0; g < 4; ++g) {
            const float A1 = hh ? Ap[g] : Ag[g], H1 = hh ? Hp[g] : Hg[g], A2 = hh ? Ag[g] : Ap[g], H2 = hh ? Hg[g] : Hp[g];
            const float Hc1 = A1 * Hc + H1, Ac1 = Ac * A1;
            Ab[g] = hh ? Ac1 : Ac; Hb[g] = hh ? Hc1 : Hc;
            Hc = A2 * Hc1 + H2; Ac = Ac1 * A2;
        }
        typedef float f2 __attribute__((ext_vector_type(2)));
        if (hh == 0) *(LAS f2*)(lds + L_AG + (wave * 32 + r) * 8) = (f2){Ac, Hc};
        __syncthreads();
        float c = carry, cin = carry;
#pragma unroll
        for (int w = 0; w < 8; ++w) { const f2 ah = *(const LAS f2*)(lds + L_AG + (w * 32 + r) * 8); if (w == wave) cin = c; c = ah.x * c + ah.y; }
        carry = c;
#pragma unroll
        for (int g = 0; g < 4; ++g) { float h = Hb[g] + Ab[g] * cin;
#pragma unroll
            for (int e = 0; e < 4; ++e) { const int i = 4 * g + e; h = a[i] * h + u[i];
                *(GAS bf16*)(orow + (size_t)((i & 3) + 8 * (i >> 2)) * 1024) = (bf16)f2bf(bf2f(sg[i]) * h); } }
    }
    __syncthreads();
}
#undef LR_DI
}

struct Frame {
    LAS unsigned char* lds;
    volatile LAS unsigned* MISC;
    gu32* ctl;
    int tid, lane, wave;
    int vcu, G;
    const float* x; float* out;
    const float *ln_in_g, *ln_in_b, *w_in, *b_merge, *gn_g, *gn_b, *w_ret, *conv_w, *conv_b, *w_rg_a, *b_rg_a, *w_rg_x, *b_rg_x, *lam, *w_lru, *w_out, *ln_out_g, *ln_out_b;
    bf16 *WinT, *PcatT, *WoutT; float* rope;
    bf16 *Q, *K, *V, *SGR, *XL, *SGL, *GR, *GL, *MERGED, *XN;
};

__device__ __forceinline__ float wave_sum(float v) {
#pragma unroll
    for (int o = 1; o < 64; o <<= 1) v += __shfl_xor(v, o);
    return v;
}
__device__ __forceinline__ int win_dest_row(int c) {
    if (c >= 1024) return c;
    const int blk = c >> 9, cc = c & 511, head = cc >> 7, idx = cc & 127, bj = idx >> 6, i = idx & 63;
    return blk * 512 + (head >> 1) * 256 + 128 * bj + (head & 1) * 64 + i;
}
template <bool WIN>
__device__ __forceinline__ void p0_transpose_item(const float* W, int ldw, bf16* WT, int ldt, int koff, LAS float* scr, int k0, int n0, int lane) {
#pragma unroll 8
    for (int i = 0; i < 32; ++i) { const int kk = 2 * i + (lane >> 5); scr[kk * 33 + (lane & 31)] = W[(size_t)(k0 + kk) * ldw + n0 + (lane & 31)]; }
    LDS_WAIT(); asm volatile("" ::: "memory");
    const int c = lane & 7;
#pragma unroll
    for (int j = 0; j < 4; ++j) { const int n = (lane >> 3) + 8 * j; const LAS float* s = scr + (8 * c) * 33 + n;
        const int col = n0 + n; const int drow = WIN ? win_dest_row(col) : col;
        const float sc = (WIN && col >= 512 && col < 1024) ? 0.08838834764831845f : 1.0f;
        v4u o; o.x = pk2(s[0 * 33] * sc, s[1 * 33] * sc); o.y = pk2(s[2 * 33] * sc, s[3 * 33] * sc); o.z = pk2(s[4 * 33] * sc, s[5 * 33] * sc); o.w = pk2(s[6 * 33] * sc, s[7 * 33] * sc);
        *(GAS v4u*)(WT + (size_t)drow * ldt + koff + k0 + 8 * c) = o; }
    LDS_WAIT(); asm volatile("" ::: "memory");
}
__device__ __forceinline__ void p0_prologue(Frame& F) {
    LAS float* scr = (LAS float*)(F.lds + RING_OFF + F.wave * 16384);
    const int gw = F.vcu * NWAVES + F.wave, NGW = F.G * NWAVES;
    constexpr int I_IN = (D / 64) * (NIN / 32), I_SQ = (D / 64) * (D / 32);
    constexpr int NITEMS = I_IN + 3 * I_SQ;
    for (int it = gw; it < NITEMS; it += NGW) {
        int r = it;
        if (r < I_IN) { const int nblk = NIN / 32; p0_transpose_item<true>(F.w_in, NIN, F.WinT, D, 0, scr, 64 * (r / nblk), 32 * (r % nblk), F.lane); continue; } r -= I_IN;
        const int nblk = D / 32, k0 = 64 * ((r % I_SQ) / nblk), n0 = 32 * ((r % I_SQ) % nblk);
        if (r < I_SQ) { p0_transpose_item<false>(F.w_ret, D, F.PcatT, 2 * D, 0, scr, k0, n0, F.lane); continue; }
        if (r < 2 * I_SQ) { p0_transpose_item<false>(F.w_lru, D, F.PcatT, 2 * D, D, scr, k0, n0, F.lane); continue; }
        p0_transpose_item<false>(F.w_out, D, F.WoutT, D, 0, scr, k0, n0, F.lane);
    }
    for (int e = (F.vcu * NWAVES * 64) + F.tid; e < SEQ * 64; e += F.G * NWAVES * 64) {
        const int pos = e >> 6, i = e & 63;
        const double inv = exp(-(double)i * (9.210340371976184 / 64.0));
        const double ang = (double)pos * inv;
        const double n = rint(ang * 0.15915494309189535);
        double r = fma(-n, 6.283185307179586, ang); r = fma(-n, 2.4492935982947064e-16, r);
        const float rf = (float)r;
        typedef float f32x2 __attribute__((ext_vector_type(2)));
        f32x2 cs; cs.x = cosf(rf); cs.y = sinf(rf);
        *(GAS f32x2*)((GAS float*)F.rope + (size_t)e * 2) = cs;
    }
    f32x4 gv[4], bv[4];
#pragma unroll
    for (int j = 0; j < 4; ++j) { gv[j] = *((const GAS f32x4*)F.ln_in_g + F.lane + 64 * j); bv[j] = *((const GAS f32x4*)F.ln_in_b + F.lane + 64 * j); }
    for (int m = gw; m < M; m += NGW) {
        const GAS f32x4* xr = (const GAS f32x4*)(F.x + (size_t)m * D) + F.lane;
        f32x4 v[4]; float s = 0.f;
#pragma unroll
        for (int j = 0; j < 4; ++j) { v[j] = xr[64 * j]; s += (v[j].x + v[j].y) + (v[j].z + v[j].w); }
        const float mean = wave_sum(s) * (1.f / D); float s2 = 0.f;
#pragma unroll
        for (int j = 0; j < 4; ++j) { v[j] = v[j] - mean; s2 += (v[j].x * v[j].x + v[j].y * v[j].y) + (v[j].z * v[j].z + v[j].w * v[j].w); }
        const float rstd = 1.f / sqrtf(wave_sum(s2) * (1.f / D) + LN_EPS);
        GAS v2u* o8 = (GAS v2u*)(F.XN + (size_t)m * D) + F.lane;
#pragma unroll
        for (int j = 0; j < 4; ++j) { const f32x4 y = v[j] * rstd * gv[j] + bv[j]; v2u w; w.x = pk2(y.x, y.y); w.y = pk2(y.z, y.w); o8[64 * j] = w; }
    }
}

__device__ __forceinline__ void ret_simple(Frame& F, int item, float* RAW) {
    const int b = item >> 5, h = (item >> 3) & 3, es = item & 7, t = F.tid;
    LAS float* Qs = (LAS float*)(F.lds);
    LAS float* Ks = Qs + 64 * 129;
    LAS float* Vs = Ks + 64 * 129;
    LAS float* Ps = Vs + 64 * 32;
    LAS float* Ss = Ps + 64 * 65;
    const float lg = log1pf(-exp2f(-5.f - (float)h));
    for (int i = t; i < 128 * 32; i += 512) Ss[i] = 0.f;
    const float cdec = expf(lg * 64.f);
    for (int c = 0; c < NCH; ++c) {
        const size_t m0 = (size_t)b * SEQ + (size_t)c * CH;
        __syncthreads();
#pragma unroll
        for (int k = 0; k < 2; ++k) { const int id = t + 512 * k, row = id >> 4, c8 = id & 15;
            const v4u q = *(const GAS v4u*)(F.Q + (m0 + row) * 512 + h * 128 + c8 * 8), kk = *(const GAS v4u*)(F.K + (m0 + row) * 512 + h * 128 + c8 * 8);
            LAS float* qd = Qs + row * 129 + c8 * 8; LAS float* kd = Ks + row * 129 + c8 * 8;
            qd[0] = bflo(q.x); qd[1] = bfhi(q.x); qd[2] = bflo(q.y); qd[3] = bfhi(q.y); qd[4] = bflo(q.z); qd[5] = bfhi(q.z); qd[6] = bflo(q.w); qd[7] = bfhi(q.w);
            kd[0] = bflo(kk.x); kd[1] = bfhi(kk.x); kd[2] = bflo(kk.y); kd[3] = bfhi(kk.y); kd[4] = bflo(kk.z); kd[5] = bfhi(kk.z); kd[6] = bflo(kk.w); kd[7] = bfhi(kk.w); }
        if (t < 256) { const int row = t >> 2, c8 = t & 3;
            const v4u v = *(const GAS v4u*)(F.V + (m0 + row) * 1024 + h * 256 + es * 32 + c8 * 8);
            LAS float* vd = Vs + row * 32 + c8 * 8;
            vd[0] = bflo(v.x); vd[1] = bfhi(v.x); vd[2] = bflo(v.y); vd[3] = bfhi(v.y); vd[4] = bflo(v.z); vd[5] = bfhi(v.z); vd[6] = bflo(v.w); vd[7] = bfhi(v.w); }
        __syncthreads();
        {
            const int i = t >> 3, jg = t & 7; float a[8];
#pragma unroll
            for (int jj = 0; jj < 8; ++jj) a[jj] = 0.f;
            for (int d = 0; d < 128; ++d) { const float q = Qs[i * 129 + d];
#pragma unroll
                for (int jj = 0; jj < 8; ++jj) a[jj] += q * Ks[(jg * 8 + jj) * 129 + d]; }
#pragma unroll
            for (int jj = 0; jj < 8; ++jj) { const int j = jg * 8 + jj; const int dd = i > j ? i - j : j - i; Ps[i * 65 + j] = a[jj] * expf(lg * (float)dd); }
        }
        __syncthreads();
        {
            const int e = t & 31, ig = t >> 5;
#pragma unroll
            for (int ii = 0; ii < 4; ++ii) { const int i = ig * 4 + ii; float o1 = 0.f, o2 = 0.f;
                for (int j = 0; j < 64; ++j) o1 += Ps[i * 65 + j] * Vs[j * 32 + e];
                for (int d = 0; d < 128; ++d) o2 += Qs[i * 129 + d] * Ss[d * 32 + e];
                RAW[(m0 + i) * 1024 + h * 256 + es * 32 + e] = o1 + expf(lg * (float)(i + 1)) * o2; }
        }
        __syncthreads();
        {
            const int e = t & 31, dg = t >> 5; float a[8];
#pragma unroll
            for (int dd = 0; dd < 8; ++dd) a[dd] = 0.f;
            for (int j = 0; j < 64; ++j) { const float vd = Vs[j * 32 + e] * expf(lg * (float)(63 - j));
#pragma unroll
                for (int dd = 0; dd < 8; ++dd) a[dd] += Ks[j * 129 + dg * 8 + dd] * vd; }
#pragma unroll
            for (int dd = 0; dd < 8; ++dd) { const int d = dg * 8 + dd; Ss[d * 32 + e] = Ss[d * 32 + e] * cdec + a[dd]; }
        }
    }
    __syncthreads();
}

__device__ __forceinline__ void lru_simple(Frame& F, int item) {
    const int b = item >> 5, cb = (item >> 2) & 7, q = item & 3, t = F.tid;
    LAS float* Xs = (LAS float*)(F.lds);
    LAS float* XC = Xs + 67 * 128;
    LAS float* Wa = XC + 64 * 129;
    LAS float* Wx = Wa + 128 * 32;
    LAS float* AA = Wx + 128 * 32;
    LAS float* UU = AA + 64 * 32;
    LAS float* Hc = UU + 64 * 32;
    __syncthreads();
    for (int i = t; i < 128 * 32; i += 512) { const int r = i >> 5, c = i & 31;
        Wa[i] = F.w_rg_a[((size_t)cb * 128 + r) * 128 + q * 32 + c]; Wx[i] = F.w_rg_x[((size_t)cb * 128 + r) * 128 + q * 32 + c]; }
    if (t < 32) Hc[t] = 0.f;
    const int c = t & 31, tg = t >> 5, ch = cb * 128 + q * 32 + c;
    const float ba = F.b_rg_a[ch], bx = F.b_rg_x[ch];
    const float lamv = F.lam[ch];
    const float Lc = -8.0f * log1pf(expf(-lamv));
    for (int tile = 0; tile < SEQ / 64; ++tile) {
        const int t0 = tile * 64; const size_t m0 = (size_t)b * SEQ + t0;
        __syncthreads();
        for (int id = t; id < 67 * 16; id += 512) { const int r = id >> 4, c8 = id & 15; const int s = t0 - 3 + r;
            v4u v = (v4u){0u, 0u, 0u, 0u};
            if (s >= 0) v = *(const GAS v4u*)(F.XL + ((size_t)b * SEQ + s) * 1024 + cb * 128 + c8 * 8);
            LAS float* xd = Xs + r * 128 + c8 * 8;
            xd[0] = bflo(v.x); xd[1] = bfhi(v.x); xd[2] = bflo(v.y); xd[3] = bfhi(v.y); xd[4] = bflo(v.z); xd[5] = bfhi(v.z); xd[6] = bflo(v.w); xd[7] = bfhi(v.w); }
        __syncthreads();
#pragma unroll 4
        for (int k = 0; k < 16; ++k) { const int id = t + 512 * k, tt = id >> 7, i = id & 127, cc = cb * 128 + i;
            float a = F.conv_b[cc];
#pragma unroll
            for (int j = 0; j < 4; ++j) a += F.conv_w[j * 1024 + cc] * Xs[(tt + j) * 128 + i];
            XC[tt * 129 + i] = a; }
        __syncthreads();
#pragma unroll
        for (int k = 0; k < 4; ++k) { const int tt = tg * 4 + k; float rp = ba, ip = bx;
            for (int i = 0; i < 128; ++i) { const float xv = XC[tt * 129 + i]; rp += xv * Wa[i * 32 + c]; ip += xv * Wx[i * 32 + c]; }
            const float r = 1.0f / (1.0f + expf(-rp)), ig = 1.0f / (1.0f + expf(-ip));
            const float la = r * Lc;
            AA[tt * 32 + c] = expf(la);
            UU[tt * 32 + c] = sqrtf(-expm1f(2.0f * la)) * (ig * XC[tt * 129 + q * 32 + c]); }
        __syncthreads();
        if (t < 32) { float hh = Hc[t];
            for (int k = 0; k < 64; ++k) { hh = AA[k * 32 + t] * hh + UU[k * 32 + t]; UU[k * 32 + t] = hh; }
            Hc[t] = hh; }
        __syncthreads();
#pragma unroll
        for (int k = 0; k < 4; ++k) { const int id = t + 512 * k, tt = id >> 5, cc = id & 31; const size_t off = (m0 + tt) * 1024 + cb * 128 + q * 32 + cc;
            F.SGL[off] = (bf16)f2bf(bf2f(F.SGL[off]) * UU[tt * 32 + cc]); }
    }
    __syncthreads();
}

__device__ __forceinline__ void gn_gate(Frame& F, const float* RAW) {
    const int gw = F.vcu * NWAVES + F.wave, NGW = F.G * NWAVES;
    for (int m = gw; m < M; m += NGW) {
        const GAS f32x4* xr = (const GAS f32x4*)(RAW + (size_t)m * D) + F.lane;
        GAS v2u* sg = (GAS v2u*)(F.SGR + (size_t)m * D) + F.lane;
#pragma unroll
        for (int j = 0; j < 4; ++j) {
            f32x4 v = xr[64 * j];
            const float mean = wave_sum((v.x + v.y) + (v.z + v.w)) * (1.f / 256.f);
            v = v - mean;
            const float rstd = 1.f / sqrtf(wave_sum((v.x * v.x + v.y * v.y) + (v.z * v.z + v.w * v.w)) * (1.f / 256.f) + LN_EPS);
            const f32x4 g = *((const GAS f32x4*)F.gn_g + F.lane + 64 * j), bb = *((const GAS f32x4*)F.gn_b + F.lane + 64 * j);
            const f32x4 y = v * rstd * g + bb;
            const v2u s = sg[64 * j]; v2u w;
            w.x = pk2(bflo(s.x) * y.x, bfhi(s.x) * y.y); w.y = pk2(bflo(s.y) * y.z, bfhi(s.y) * y.w);
            sg[64 * j] = w;
        }
    }
}

__device__ __forceinline__ void final_ln(Frame& F) {
    const int gw = F.vcu * NWAVES + F.wave, NGW = F.G * NWAVES;
    for (int m = gw; m < M; m += NGW) {
        const GAS f32x4* xr = (const GAS f32x4*)(F.x + (size_t)m * D) + F.lane;
        GAS f32x4* yr = (GAS f32x4*)(F.out + (size_t)m * D) + F.lane;
        f32x4 v[4]; float s = 0.f;
#pragma unroll
        for (int j = 0; j < 4; ++j) { v[j] = xr[64 * j]; s += (v[j].x + v[j].y) + (v[j].z + v[j].w); }
        float mean = wave_sum(s) * (1.f / D); float s2 = 0.f;
#pragma unroll
        for (int j = 0; j < 4; ++j) { v[j] = v[j] - mean; s2 += (v[j].x * v[j].x + v[j].y * v[j].y) + (v[j].z * v[j].z + v[j].w * v[j].w); }
        float rstd = 1.f / sqrtf(wave_sum(s2) * (1.f / D) + LN_EPS);
        s = 0.f;
#pragma unroll
        for (int j = 0; j < 4; ++j) { const f32x4 g = *((const GAS f32x4*)F.ln_in_g + F.lane + 64 * j), bb = *((const GAS f32x4*)F.ln_in_b + F.lane + 64 * j);
            v[j] = (v[j] * rstd * g + bb) * DN_ALPHA + yr[64 * j]; s += (v[j].x + v[j].y) + (v[j].z + v[j].w); }
        mean = wave_sum(s) * (1.f / D); s2 = 0.f;
#pragma unroll
        for (int j = 0; j < 4; ++j) { v[j] = v[j] - mean; s2 += (v[j].x * v[j].x + v[j].y * v[j].y) + (v[j].z * v[j].z + v[j].w * v[j].w); }
        rstd = 1.f / sqrtf(wave_sum(s2) * (1.f / D) + LN_EPS);
#pragma unroll
        for (int j = 0; j < 4; ++j) { const f32x4 g = *((const GAS f32x4*)F.ln_out_g + F.lane + 64 * j), bb = *((const GAS f32x4*)F.ln_out_b + F.lane + 64 * j);
            yr[64 * j] = v[j] * rstd * g + bb; }
    }
}

struct Args { const float* in[19]; float* out; unsigned char* ws; int ph_lo, ph_hi, li, pad; };
__global__ void __launch_bounds__(NWAVES * 64, 2) fwd_kernel(Args args) {
    extern __shared__ __attribute__((aligned(16))) unsigned char lds[];
    Frame F;
    F.lds = (LAS unsigned char*)lds;
    F.MISC = (volatile LAS unsigned*)(F.lds + MISC_OFF);
    F.tid = threadIdx.x; F.lane = F.tid & 63; F.wave = __builtin_amdgcn_readfirstlane(F.tid >> 6);
    F.G = gridDim.x; { const int bx = blockIdx.x; F.vcu = (F.G % 8 == 0) ? (bx % 8) * (F.G / 8) + bx / 8 : bx; }
    unsigned char* ws = args.ws;
    F.ctl = (gu32*)(ws + WS_CTL);
    F.x = args.in[0]; F.ln_in_g = args.in[1]; F.ln_in_b = args.in[2]; F.w_in = args.in[3]; F.b_merge = args.in[4]; F.gn_g = args.in[5]; F.gn_b = args.in[6]; F.w_ret = args.in[7];
    F.conv_w = args.in[8]; F.conv_b = args.in[9]; F.w_rg_a = args.in[10]; F.b_rg_a = args.in[11]; F.w_rg_x = args.in[12]; F.b_rg_x = args.in[13]; F.lam = args.in[14]; F.w_lru = args.in[15];
    F.w_out = args.in[16]; F.ln_out_g = args.in[17]; F.ln_out_b = args.in[18]; F.out = args.out;
    F.WinT = (bf16*)(ws + WS_WIN); F.PcatT = (bf16*)(ws + WS_PCAT); F.WoutT = (bf16*)(ws + WS_WOUT); F.rope = (float*)(ws + WS_ROPE);
    F.Q = (bf16*)(ws + WS_Q); F.K = (bf16*)(ws + WS_K); F.V = (bf16*)(ws + WS_V); F.SGR = (bf16*)(ws + WS_SGR); F.XL = (bf16*)(ws + WS_XL); F.SGL = (bf16*)(ws + WS_SGL);
    F.GR = (bf16*)(ws + WS_GR); F.GL = (bf16*)(ws + WS_GL); F.MERGED = (bf16*)(ws + WS_MERGED); F.XN = (bf16*)args.out;
    for (int u = F.tid; u < (LDS_BYTES - LDSCTL_OFF) / 4; u += NWAVES * 64) ((LAS unsigned*)(F.lds + LDSCTL_OFF))[u] = 0u;
    __syncthreads();
    XcdBarrier bar; bar.bar = (unsigned*)(F.ctl + CW_BAR); bar.x = 0; bar.st = nullptr;
    if (MK_ONE_LAUNCH) bar = xcd_barrier_post((unsigned*)(F.ctl + CW_BAR), F.MISC + 8);
#define GRID_BAR(seam) do { if (!MK_ONE_LAUNCH) { if (F.tid == 0) __hip_atomic_store(F.ctl + CW_TMO, 0xBADBA0u | (unsigned)(seam), RLX_AGENT); } else { xcd_barrier(bar); } } while (0)
    const int lo = args.ph_lo, hi = args.ph_hi;
#define IN(k) (lo <= (k) && (k) < hi)
#define BOTH(k) (IN(k) && IN((k) + 1))

    if (IN(0)) { p0_prologue(F); if (BOTH(0)) GRID_BAR(0); }

    if (IN(1)) {
        pg8::Gemm g{F.XN, F.WinT, M, NIN, D}; pg8::StaticOrder S; S.init(M, NIN, F.G, (int)blockIdx.x);
        pg8::EpiIn E{F.Q, F.K, F.V, F.SGR, F.XL, F.SGL, F.GR, F.GL, F.rope, F.b_merge};
        pg8::gemm_phase<pg8::EpiIn, pg8::StaticOrder, PG8_ALIGN, PG8_SP2>(F.lds + RING_OFF, g, S, E);
        if (BOTH(1)) GRID_BAR(1);
    }

    if (IN(2)) {
        for (int it = F.vcu; it < 256; it += F.G) rt::pass1(F.lds, F.tid, F.wave, it, F.K, F.V, (float*)(ws + WS_SLOC));
        for (int it = F.vcu; it < 256; it += F.G) lr::run(F.lds, F.tid, F.wave, it, F.XL, F.SGL, F.conv_w, F.conv_b, F.w_rg_a, F.b_rg_a, F.w_rg_x, F.b_rg_x, F.lam);
        if (BOTH(2)) GRID_BAR(2);
    }

    if (IN(3)) {
        for (int it = F.vcu; it < 256; it += F.G) rt::pass2(F.lds, F.tid, F.wave, it, F.Q, F.K, F.V, F.SGR, (const float*)(ws + WS_SLOC), F.gn_g, F.gn_b);
        if (BOTH(3)) GRID_BAR(3);
    }

    if (IN(4)) {
        pg8::Gemm g{F.SGR, F.PcatT, M, D, D}; g.ldb = 2 * D; pg8::StaticOrder S; S.init(M, D, F.G, (int)blockIdx.x);
        pg8::EpiGateF32 E{F.out, F.GR, D};
        pg8::gemm_phase<pg8::EpiGateF32, pg8::StaticOrder, PG8_ALIGN, PG8_SP2>(F.lds + RING_OFF, g, S, E);
        if (BOTH(4)) GRID_BAR(4);
    }

    if (IN(5)) {
        pg8::Gemm g{F.SGL, F.PcatT + D, M, D, D}; g.ldb = 2 * D; pg8::StaticOrder S; S.init(M, D, F.G, (int)blockIdx.x);
        pg8::EpiMerge E{F.MERGED, F.out, F.GL, D};
        pg8::gemm_phase<pg8::EpiMerge, pg8::StaticOrder, PG8_ALIGN, PG8_SP2>(F.lds + RING_OFF, g, S, E);
        if (BOTH(5)) GRID_BAR(5);
    }

    if (IN(6)) {
        pg8::Gemm g{F.MERGED, F.WoutT, M, D, D}; pg8::StaticOrder S; S.init(M, D, F.G, (int)blockIdx.x);
        pg8::EpiF32 E{F.out, D};
        pg8::gemm_phase<pg8::EpiF32, pg8::StaticOrder, PG8_ALIGN, PG8_SP2>(F.lds + RING_OFF, g, S, E);
        if (BOTH(6)) GRID_BAR(6);
    }

    if (IN(7)) { final_ln(F); }
#undef IN
#undef BOTH
}

extern "C" void kernel_launch(void* const* d_in, const int* in_sizes, int n_in, void* d_out, int out_size, void* d_ws, size_t ws_size, hipStream_t stream) {
    static int grid = 0;
    if (grid == 0) {
        if (n_in != 19 || in_sizes[0] != M * D || out_size != M * D || ws_size < WS_END2) { fprintf(stderr, "kernel_launch: unexpected shapes (n_in %d, in0 %d, out %d, ws %zu); nothing launched\n", n_in, n_in > 0 ? in_sizes[0] : -1, out_size, ws_size); grid = -1; return; }
        int dev = 0, cus = 0, per_cu = 0;
        if (hipGetDevice(&dev) != hipSuccess || hipDeviceGetAttribute(&cus, hipDeviceAttributeMultiprocessorCount, dev) != hipSuccess) { grid = -1; return; }
        if (hipFuncSetAttribute((const void*)fwd_kernel, hipFuncAttributeMaxDynamicSharedMemorySize, LDS_BYTES) != hipSuccess) { fprintf(stderr, "kernel_launch: hipFuncSetAttribute failed\n"); grid = -1; return; }
        if (hipOccupancyMaxActiveBlocksPerMultiprocessor(&per_cu, (const void*)fwd_kernel, NWAVES * 64, LDS_BYTES) != hipSuccess || per_cu < 1) { fprintf(stderr, "kernel_launch: occupancy query reports %d\n", per_cu); per_cu = 1; }
        (void)hipGetLastError();
        grid = cus;
    }
    if (grid < 0) return;
    if (hipMemsetAsync((char*)d_ws + WS_CTL, 0, CTL_ZERO_BYTES, stream) != hipSuccess) return;
    Args a{};
    for (int i = 0; i < 19; ++i) a.in[i] = (const float*)d_in[i];
    a.out = (float*)d_out; a.ws = (unsigned char*)d_ws;
    const int nl = MK_ONE_LAUNCH ? 1 : NPHASES;
    for (int li = 0; li < nl; ++li) {
        a.ph_lo = MK_ONE_LAUNCH ? 0 : li; a.ph_hi = MK_ONE_LAUNCH ? NPHASES : li + 1; a.li = li;
        hipLaunchKernelGGL(fwd_kernel, dim3(grid), dim3(NWAVES * 64), LDS_BYTES, stream, a);
        if (hipPeekAtLastError() != hipSuccess) break;
    }
}
```

```cpp
#include <hip/hip_runtime.h>
#include <cstdio>
#include <cstdint>
namespace pg8 {
#define PG8_LAS __attribute__((address_space(3)))
typedef unsigned short bf16_t;
typedef short bf16x8 __attribute__((ext_vector_type(8)));
typedef float f32x4 __attribute__((ext_vector_type(4)));
typedef unsigned u32x4 __attribute__((ext_vector_type(4)));
constexpr int BM = 256, BK = 64, HALF = 128, HTB = HALF * BK * 2  , STAGE_BYTES = 8 * HTB, NXCD = 8, WGM = 8;

__host__ __device__ __forceinline__ int lds_byte(int r, int c) { const int st = (r >> 4) * 2 + (c >> 5), rr = r & 15, cc = c & 31, ob = rr * 64 + cc * 2; return st * 1024 + (ob ^ (((ob >> 9) & 1) << 5)); }
__host__ __device__ __forceinline__ void stage_rc(int b, int& R, int& C) { const int st = b / 1024, sb = b % 1024, swz = sb ^ (((sb >> 9) & 1) << 5); R = (st >> 1) * 16 + swz / 64; C = (st & 1) * 32 + (swz % 64) / 2; }
__host__ __device__ __forceinline__ int perm32(int rho) { const int n = rho >> 4, i = rho & 15; return 8 * (i >> 2) + 4 * n + (i & 3); }

struct Unit { int pm, pn; };
struct Gemm { const bf16_t* A; const bf16_t* Bt; int M, N, K; int lda = 0, ldb = 0; };

struct StaticOrder {
    int nM, nN, nwg, G, c;
    __host__ __device__ void init(int M, int N, int G_, int c_) { nM = M / BM; nN = N / BM; nwg = nM * nN; G = G_; c = c_; }
    __host__ __device__ bool next(int i, Unit& u) const {
        const long L = (long)i * G + c; if (L >= nwg) return false;
        int wgid = (int)L; { const int q = nwg / NXCD, r = nwg % NXCD, xcd = wgid % NXCD, off = wgid / NXCD; wgid = (xcd < r ? xcd * (q + 1) : r * (q + 1) + (xcd - r) * q) + off; }
        const int nig = WGM * nN, gid = wgid / nig, fm = gid * WGM, gsz = (nM - fm) < WGM ? (nM - fm) : WGM;
        u.pm = fm + ((wgid % nig) % gsz); u.pn = (wgid % nig) / gsz; return true;
    }
    __device__ __forceinline__ void a_ready(const Unit&) const {}
    __device__ __forceinline__ void done(const Unit&) const {}
};

__device__ __forceinline__ unsigned cvt_pk_bf16(float lo, float hi) { unsigned r; asm volatile("v_cvt_pk_bf16_f32 %0, %1, %2" : "=v"(r) : "v"(lo), "v"(hi)); return r; }
typedef unsigned u32x2 __attribute__((ext_vector_type(2)));
__device__ __forceinline__ float bf_lo(unsigned w) { return __builtin_bit_cast(float, w << 16); }
__device__ __forceinline__ float bf_hi(unsigned w) { return __builtin_bit_cast(float, w & 0xffff0000u); }
__device__ __forceinline__ float fast_sigmoid(float x) { return __builtin_amdgcn_rcpf(1.0f + __builtin_amdgcn_exp2f(-1.4426950408889634f * x)); }

struct EpiF32 {
    static constexpr bool PERM = false, AFTER_DRAIN = false, MID = false;
    float* C; int ldc;
    __device__ __forceinline__ void operator()(const f32x4 (&acc)[2][2][4][2], const Unit& u, int wr, int wc, int fr, int fq) const {
        const int row0 = u.pm * BM + wr * 64 + fr, col0 = u.pn * BM + wc * 32 + 4 * fq;
#pragma unroll
        for (int ai = 0; ai < 2; ++ai)
#pragma unroll
            for (int m = 0; m < 4; ++m) { float* rowp = C + (size_t)(row0 + ai * HALF + m * 16) * ldc + col0;
#pragma unroll
                for (int bj = 0; bj < 2; ++bj)
#pragma unroll
                    for (int n = 0; n < 2; ++n) *(f32x4*)(rowp + bj * HALF + n * 16) = acc[ai][bj][m][n]; }
    }
};
struct EpiGateF32 {
    static constexpr bool PERM = false, AFTER_DRAIN = false, MID = false;
    float* C; const bf16_t* G; int ldc;
    __device__ __forceinline__ void operator()(const f32x4 (&acc)[2][2][4][2], const Unit& u, int wr, int wc, int fr, int fq) const {
        const int row0 = u.pm * BM + wr * 64 + fr, col0 = u.pn * BM + wc * 32 + 4 * fq;
#pragma unroll
        for (int ai = 0; ai < 2; ++ai)
#pragma unroll
            for (int m = 0; m < 4; ++m) { const size_t off = (size_t)(row0 + ai * HALF + m * 16) * ldc + col0;
#pragma unroll
                for (int bj = 0; bj < 2; ++bj)
#pragma unroll
                    for (int n = 0; n < 2; ++n) { const u32x2 g = *(const u32x2*)(G + off + bj * HALF + n * 16); const f32x4 a = acc[ai][bj][m][n];
                        f32x4 o; o[0] = bf_lo(g.x) * a[0]; o[1] = bf_hi(g.x) * a[1]; o[2] = bf_lo(g.y) * a[2]; o[3] = bf_hi(g.y) * a[3];
                        *(f32x4*)(C + off + bj * HALF + n * 16) = o; } }
    }
};
struct EpiMerge {
    static constexpr bool PERM = true, AFTER_DRAIN = false, MID = false;
    bf16_t* O; const float* T1; const bf16_t* G; int ldc;
    __device__ __forceinline__ void operator()(const f32x4 (&acc)[2][2][4][2], const Unit& u, int wr, int wc, int fr, int fq) const {
        const int row0 = u.pm * BM + wr * 64 + fr, col0 = u.pn * BM + wc * 32 + 8 * fq;
#pragma unroll
        for (int ai = 0; ai < 2; ++ai)
#pragma unroll
            for (int m = 0; m < 4; ++m) { const size_t off = (size_t)(row0 + ai * HALF + m * 16) * ldc + col0;
#pragma unroll
                for (int bj = 0; bj < 2; ++bj) { const u32x4 g = *(const u32x4*)(G + off + bj * HALF);
                    const f32x4 t0 = *(const f32x4*)(T1 + off + bj * HALF), t1 = *(const f32x4*)(T1 + off + bj * HALF + 4);
                    const f32x4 a0 = acc[ai][bj][m][0], a1 = acc[ai][bj][m][1];
                    u32x4 w;
                    w.x = cvt_pk_bf16(t0[0] + bf_lo(g.x) * a0[0], t0[1] + bf_hi(g.x) * a0[1]);
                    w.y = cvt_pk_bf16(t0[2] + bf_lo(g.y) * a0[2], t0[3] + bf_hi(g.y) * a0[3]);
                    w.z = cvt_pk_bf16(t1[0] + bf_lo(g.z) * a1[0], t1[1] + bf_hi(g.z) * a1[1]);
                    w.w = cvt_pk_bf16(t1[2] + bf_lo(g.w) * a1[2], t1[3] + bf_hi(g.w) * a1[3]);
                    *(u32x4*)(O + off + bj * HALF) = w; } }
    }
};
struct EpiMerge2 {
    static constexpr bool PERM = true, AFTER_DRAIN = false, MID = true;
    bf16_t* O; const bf16_t* GR; const bf16_t* GL; int ldc;
    __device__ __forceinline__ void mid(f32x4 (&acc)[2][2][4][2], const Unit& u, int wr, int wc, int fr_, int fq) const {
        int fr = fr_; asm volatile("" : "+v"(fr));
        const unsigned off0 = (unsigned)((u.pm * BM + wr * 64 + fr) * ldc + u.pn * BM + wc * 32 + 8 * fq) * 2u;
        const char* grb = (const char*)GR; const char* glb = (const char*)GL;
#pragma unroll
        for (int ai = 0; ai < 2; ++ai)
#pragma unroll
            for (int m = 0; m < 4; ++m) {
#pragma unroll
                for (int bj = 0; bj < 2; ++bj) { const unsigned off = off0 + (unsigned)((ai * HALF + m * 16) * ldc + bj * HALF) * 2u;
                    const u32x4 gr = *(const u32x4*)(grb + off), gl = *(const u32x4*)(glb + off);
                    f32x4 r0, r1;
                    r0[0] = bf_lo(gr.x) * __builtin_amdgcn_rcpf(bf_lo(gl.x)); r0[1] = bf_hi(gr.x) * __builtin_amdgcn_rcpf(bf_hi(gl.x));
                    r0[2] = bf_lo(gr.y) * __builtin_amdgcn_rcpf(bf_lo(gl.y)); r0[3] = bf_hi(gr.y) * __builtin_amdgcn_rcpf(bf_hi(gl.y));
                    r1[0] = bf_lo(gr.z) * __builtin_amdgcn_rcpf(bf_lo(gl.z)); r1[1] = bf_hi(gr.z) * __builtin_amdgcn_rcpf(bf_hi(gl.z));
                    r1[2] = bf_lo(gr.w) * __builtin_amdgcn_rcpf(bf_lo(gl.w)); r1[3] = bf_hi(gr.w) * __builtin_amdgcn_rcpf(bf_hi(gl.w));
                    acc[ai][bj][m][0] = acc[ai][bj][m][0] * r0; acc[ai][bj][m][1] = acc[ai][bj][m][1] * r1;
                    asm volatile("" ::: "memory"); } }
    }
    __device__ __forceinline__ void operator()(const f32x4 (&acc)[2][2][4][2], const Unit& u, int wr, int wc, int fr, int fq) const {
        const int row0 = u.pm * BM + wr * 64 + fr, col0 = u.pn * BM + wc * 32 + 8 * fq;
#pragma unroll
        for (int ai = 0; ai < 2; ++ai)
#pragma unroll
            for (int m = 0; m < 4; ++m) { const size_t off = (size_t)(row0 + ai * HALF + m * 16) * ldc + col0;
#pragma unroll
                for (int bj = 0; bj < 2; ++bj) { const u32x4 g = *(const u32x4*)(GL + off + bj * HALF);
                    const f32x4 a0 = acc[ai][bj][m][0], a1 = acc[ai][bj][m][1];
                    u32x4 w;
                    w.x = cvt_pk_bf16(bf_lo(g.x) * a0[0], bf_hi(g.x) * a0[1]); w.y = cvt_pk_bf16(bf_lo(g.y) * a0[2], bf_hi(g.y) * a0[3]);
                    w.z = cvt_pk_bf16(bf_lo(g.z) * a1[0], bf_hi(g.z) * a1[1]); w.w = cvt_pk_bf16(bf_lo(g.w) * a1[2], bf_hi(g.w) * a1[3]);
                    *(u32x4*)(O + off + bj * HALF) = w; } }
    }
};
struct EpiIn {
    static constexpr bool PERM = true, AFTER_DRAIN = false, MID = false;
    bf16_t *Q, *Kb, *V, *SGR, *XL, *SGL, *GR, *GL; const float* rope; const float* bmerge;
    __device__ __forceinline__ void operator()(const f32x4 (&acc)[2][2][4][2], const Unit& u, int wr, int wc, int fr, int fq) const {
        const int row0 = u.pm * BM + wr * 64 + fr; const int pn = u.pn;
        if (pn < 4) {
            bf16_t* base = (pn < 2) ? Q : Kb; const int head = 2 * (pn & 1) + (wc >> 1), i0 = 32 * (wc & 1) + 8 * fq;
#pragma unroll
            for (int ai = 0; ai < 2; ++ai)
#pragma unroll
                for (int m = 0; m < 4; ++m) { const int row = row0 + ai * HALF + m * 16, pos = row & 8191;
                    const f32x4* cs = (const f32x4*)(rope + ((size_t)pos * 64 + i0) * 2);
                    const f32x4 c0 = cs[0], c1 = cs[1], c2 = cs[2], c3 = cs[3];
                    const f32x4 xa = acc[ai][0][m][0], xb = acc[ai][0][m][1], ya = acc[ai][1][m][0], yb = acc[ai][1][m][1];
                    u32x4 o1, o2;
                    o1.x = cvt_pk_bf16(xa[0] * c0[0] - ya[0] * c0[1], xa[1] * c0[2] - ya[1] * c0[3]);
                    o1.y = cvt_pk_bf16(xa[2] * c1[0] - ya[2] * c1[1], xa[3] * c1[2] - ya[3] * c1[3]);
                    o1.z = cvt_pk_bf16(xb[0] * c2[0] - yb[0] * c2[1], xb[1] * c2[2] - yb[1] * c2[3]);
                    o1.w = cvt_pk_bf16(xb[2] * c3[0] - yb[2] * c3[1], xb[3] * c3[2] - yb[3] * c3[3]);
                    o2.x = cvt_pk_bf16(ya[0] * c0[0] + xa[0] * c0[1], ya[1] * c0[2] + xa[1] * c0[3]);
                    o2.y = cvt_pk_bf16(ya[2] * c1[0] + xa[2] * c1[1], ya[3] * c1[2] + xa[3] * c1[3]);
                    o2.z = cvt_pk_bf16(yb[0] * c2[0] + xb[0] * c2[1], yb[1] * c2[2] + xb[1] * c2[3]);
                    o2.w = cvt_pk_bf16(yb[2] * c3[0] + xb[2] * c3[1], yb[3] * c3[2] + xb[3] * c3[3]);
                    bf16_t* rp = base + (size_t)row * 512 + head * 128 + i0;
                    *(u32x4*)rp = o1; *(u32x4*)(rp + 64) = o2; }
        } else {
            const int ty = (pn - 4) >> 2, colt = ((pn - 4) & 3) * BM, col0 = colt + wc * 32 + 8 * fq;
            bf16_t* base = ty == 0 ? V : ty == 1 ? SGR : ty == 2 ? XL : ty == 3 ? SGL : ty == 4 ? GR : GL;
            const int ldo = (ty == 1 || ty == 3) ? 2048 : 1024;
            f32x4 bv[2][2];
#pragma unroll
            for (int bj = 0; bj < 2; ++bj)
#pragma unroll
                for (int n = 0; n < 2; ++n) bv[bj][n] = (ty >= 4) ? *(const f32x4*)(bmerge + (ty - 4) * 1024 + col0 + bj * HALF + 4 * n) : (f32x4){0.f, 0.f, 0.f, 0.f};
#pragma unroll
            for (int ai = 0; ai < 2; ++ai)
#pragma unroll
                for (int m = 0; m < 4; ++m) { bf16_t* rowp = base + (size_t)(row0 + ai * HALF + m * 16) * ldo + col0;
#pragma unroll
                    for (int bj = 0; bj < 2; ++bj) { f32x4 v0 = acc[ai][bj][m][0] + bv[bj][0], v1 = acc[ai][bj][m][1] + bv[bj][1];
                        if (ty == 1 || ty == 3) {
#pragma unroll
                            for (int j = 0; j < 4; ++j) { v0[j] = v0[j] * fast_sigmoid(v0[j]); v1[j] = v1[j] * fast_sigmoid(v1[j]); } }
                        if (ty >= 4) {
#pragma unroll
                            for (int j = 0; j < 4; ++j) { v0[j] = fast_sigmoid(v0[j]); v1[j] = fast_sigmoid(v1[j]); } }
                        u32x4 w; w.x = cvt_pk_bf16(v0[0], v0[1]); w.y = cvt_pk_bf16(v0[2], v0[3]); w.z = cvt_pk_bf16(v1[0], v1[1]); w.w = cvt_pk_bf16(v1[2], v1[3]);
                        *(u32x4*)(rowp + bj * HALF) = w; } }
        }
    }
};

template <class Epi, class Sched, bool ALIGN_EPI = false, bool SP2 = false>
__device__ __forceinline__ void gemm_phase(PG8_LAS unsigned char* lds, const Gemm g, const Sched& S, const Epi& E) {
    const int tid = threadIdx.x, wid = __builtin_amdgcn_readfirstlane(tid >> 6), lane = tid & 63, wr = wid >> 2, wc = wid & 3, fr = lane & 15, fq = lane >> 4;
    const int K = g.K, nt = K / BK, lda = g.lda ? g.lda : K, ldb = g.ldb ? g.ldb : K;
    unsigned voffA[2], voffB[2];
#pragma unroll
    for (int i = 0; i < 2; ++i) { int R, C; stage_rc(tid * 16 + i * 8192, R, C); const int Rb = Epi::PERM ? ((R & ~31) + perm32(R & 31)) : R;
        voffA[i] = (unsigned)(R * lda + C) * 2u; voffB[i] = (unsigned)(Rb * ldb + C) * 2u; }
    const size_t kstep = (size_t)(BK * 2);
    const size_t hstepA = (size_t)HALF * lda * 2, hstepB = (size_t)HALF * ldb * 2;
    const size_t tstepA = 2 * hstepA, tstepB = 2 * hstepB;
    const unsigned ldsw = (unsigned)wid * 1024u;
    const int aoff = lds_byte(wr * 64 + fr, fq * 8), boff = lds_byte(wc * 32 + fr, fq * 8);
#define PG8_SA(b, h) (((b) * 2 + (h)) * HTB)
#define PG8_SB(b, h) ((4 + (b) * 2 + (h)) * HTB)
#define PG8_STAGE(bufoff, gbase, voff) do { _Pragma("unroll") for (int _i = 0; _i < 2; ++_i) \
        __builtin_amdgcn_global_load_lds((const unsigned*)((const char*)(gbase) + (voff)[_i]), (PG8_LAS unsigned*)(lds + (bufoff) + ldsw + _i * 8192), 16, 0, 0); } while (0)
#define PG8_LDA(dst, b, h) do { _Pragma("unroll") for (int m = 0; m < 4; ++m) _Pragma("unroll") for (int k = 0; k < 2; ++k) dst[m][k] = *(const PG8_LAS bf16x8*)(lds + PG8_SA(b, h) + aoff + m * 2048 + k * 1024); } while (0)
#define PG8_LDB(dst, b, h) do { _Pragma("unroll") for (int n = 0; n < 2; ++n) _Pragma("unroll") for (int k = 0; k < 2; ++k) dst[n][k] = *(const PG8_LAS bf16x8*)(lds + PG8_SB(b, h) + boff + n * 2048 + k * 1024); } while (0)
#define PG8_MMA(ai, bj, At, Bt) do { __builtin_amdgcn_s_setprio(1); _Pragma("unroll") for (int m = 0; m < 4; ++m) _Pragma("unroll") for (int n = 0; n < 2; ++n) _Pragma("unroll") for (int k = 0; k < 2; ++k) \
        acc[ai][bj][m][n] = __builtin_amdgcn_mfma_f32_16x16x32_bf16(Bt[n][k], At[m][k], acc[ai][bj][m][n], 0, 0, 0); __builtin_amdgcn_s_setprio(0); } while (0)
#define PG8_WAIT_V(n) asm volatile("s_waitcnt vmcnt(" #n ")" ::: "memory")
#define PG8_WAIT_L(n) asm volatile("s_waitcnt lgkmcnt(" #n ")" ::: "memory")
#define PG8_BAR __builtin_amdgcn_s_barrier()
#define PG8_SCHED __builtin_amdgcn_sched_barrier(0)
    Unit cur, nxt; int ui = 0;
    if (!S.next(0, cur)) return;
    f32x4 acc[2][2][4][2];
#pragma unroll
    for (int a = 0; a < 2; ++a)
#pragma unroll
        for (int b = 0; b < 2; ++b)
#pragma unroll
            for (int m = 0; m < 4; ++m)
#pragma unroll
                for (int n = 0; n < 2; ++n) acc[a][b][m][n] = (f32x4){0.f, 0.f, 0.f, 0.f};
    bf16x8 At[4][2], B0[2][2], B1[2][2];
    const char* cA = (const char*)g.A + (size_t)cur.pm * tstepA; const char* cB = (const char*)g.Bt + (size_t)cur.pn * tstepB;
    S.a_ready(cur);
    if constexpr (SP2) {
        PG8_STAGE(PG8_SB(0, 0), cB, voffB); PG8_STAGE(PG8_SB(0, 1), cB + hstepB, voffB); PG8_STAGE(PG8_SA(0, 0), cA, voffA); PG8_STAGE(PG8_SA(0, 1), cA + hstepA, voffA);
        if (wr == 1) PG8_BAR;
        PG8_WAIT_V(2); PG8_BAR;
        PG8_STAGE(PG8_SB(1, 0), cB + kstep, voffB); PG8_STAGE(PG8_SA(1, 0), cA + kstep, voffA); PG8_STAGE(PG8_SB(1, 1), cB + hstepB + kstep, voffB);
        PG8_WAIT_V(6); PG8_BAR;
    } else {
        PG8_STAGE(PG8_SB(0, 0), cB, voffB); PG8_STAGE(PG8_SA(0, 0), cA, voffA); PG8_STAGE(PG8_SB(0, 1), cB + hstepB, voffB); PG8_STAGE(PG8_SA(0, 1), cA + hstepA, voffA);
        if (wr == 1) PG8_BAR;
        PG8_WAIT_V(4); PG8_BAR;
        PG8_STAGE(PG8_SB(1, 0), cB + kstep, voffB); PG8_STAGE(PG8_SA(1, 0), cA + kstep, voffA); PG8_STAGE(PG8_SB(1, 1), cB + hstepB + kstep, voffB);
        PG8_WAIT_V(6); PG8_BAR;
    }
    for (;;) {
        const bool has_next = S.next(ui + 1, nxt);
        const char* nA = has_next ? (const char*)g.A + (size_t)nxt.pm * tstepA : cA; const char* nB = has_next ? (const char*)g.Bt + (size_t)nxt.pn * tstepB : cB;
        for (int t = 0; t < nt; t += 2) {
            const bool last = (t == nt - 2);
            const char* a1 = cA + (size_t)(t + 1) * kstep;
            const char* a2 = last ? nA : cA + (size_t)(t + 2) * kstep; const char* b2 = last ? nB : cB + (size_t)(t + 2) * kstep;
            const char* a3 = a2 + kstep; const char* b3 = b2 + kstep;
            if (last && has_next) S.a_ready(nxt);
            if constexpr (Epi::MID) { if (t == nt / 2) E.mid(acc, cur, wr, wc, fr, fq); }
            if constexpr (SP2) {
            PG8_LDB(B0, 0, 0); PG8_LDB(B1, 0, 1); PG8_SCHED; PG8_LDA(At, 0, 0); PG8_STAGE(PG8_SA(1, 1), a1 + hstepA, voffA);
            PG8_WAIT_V(8); PG8_WAIT_L(0); PG8_BAR; PG8_MMA(0, 0, At, B0); PG8_MMA(0, 1, At, B1); PG8_BAR; PG8_SCHED;
            PG8_LDA(At, 0, 1); PG8_STAGE(PG8_SB(0, 0), b2, voffB); PG8_STAGE(PG8_SB(0, 1), b2 + hstepB, voffB); PG8_STAGE(PG8_SA(0, 0), a2, voffA);
            PG8_WAIT_V(8); PG8_WAIT_L(0); PG8_BAR; PG8_MMA(1, 0, At, B0); PG8_MMA(1, 1, At, B1); PG8_BAR; PG8_SCHED;
            PG8_LDB(B0, 1, 0); PG8_LDB(B1, 1, 1); PG8_SCHED; PG8_LDA(At, 1, 0); PG8_STAGE(PG8_SA(0, 1), a2 + hstepA, voffA);
            PG8_WAIT_V(8); PG8_WAIT_L(0); PG8_BAR; PG8_MMA(0, 0, At, B0); PG8_MMA(0, 1, At, B1); PG8_BAR; PG8_SCHED;
            PG8_LDA(At, 1, 1); PG8_STAGE(PG8_SB(1, 0), b3, voffB); PG8_STAGE(PG8_SB(1, 1), b3 + hstepB, voffB); PG8_STAGE(PG8_SA(1, 0), a3, voffA);
            PG8_WAIT_V(8); PG8_WAIT_L(0); PG8_BAR; PG8_MMA(1, 0, At, B0); PG8_MMA(1, 1, At, B1); PG8_BAR; PG8_SCHED;
            } else {
            PG8_LDB(B0, 0, 0); PG8_SCHED; PG8_LDA(At, 0, 0); PG8_STAGE(PG8_SA(1, 1), a1 + hstepA, voffA);
            PG8_WAIT_L(8); PG8_BAR; PG8_WAIT_L(0); PG8_MMA(0, 0, At, B0); PG8_BAR; PG8_SCHED;
            PG8_LDB(B1, 0, 1); PG8_STAGE(PG8_SB(0, 0), b2, voffB);
            PG8_BAR; PG8_WAIT_L(0); PG8_MMA(0, 1, At, B1); PG8_BAR;
            PG8_LDA(At, 0, 1); PG8_STAGE(PG8_SA(0, 0), a2, voffA);
            PG8_BAR; PG8_WAIT_L(0); PG8_MMA(1, 0, At, B0); PG8_BAR; PG8_SCHED;
            PG8_STAGE(PG8_SB(0, 1), b2 + hstepB, voffB);
            PG8_WAIT_V(6); PG8_BAR; PG8_MMA(1, 1, At, B1); PG8_BAR;
            PG8_LDB(B0, 1, 0); PG8_SCHED; PG8_LDA(At, 1, 0); PG8_STAGE(PG8_SA(0, 1), a2 + hstepA, voffA);
            PG8_WAIT_L(8); PG8_BAR; PG8_WAIT_L(0); PG8_MMA(0, 0, At, B0); PG8_BAR; PG8_SCHED;
            PG8_LDB(B1, 1, 1); PG8_STAGE(PG8_SB(1, 0), b3, voffB);
            PG8_BAR; PG8_WAIT_L(0); PG8_MMA(0, 1, At, B1); PG8_BAR;
            PG8_LDA(At, 1, 1); PG8_STAGE(PG8_SA(1, 0), a3, voffA);
            PG8_BAR; PG8_WAIT_L(0); PG8_MMA(1, 0, At, B0); PG8_BAR; PG8_SCHED;
            PG8_STAGE(PG8_SB(1, 1), b3 + hstepB, voffB);
            PG8_WAIT_V(6); PG8_BAR; PG8_MMA(1, 1, At, B1); PG8_BAR;
            }
        }
        if constexpr (ALIGN_EPI) { if (wr == 0) PG8_BAR; }
        if constexpr (!Epi::AFTER_DRAIN) { E(acc, cur, wr, wc, fr, fq); S.done(cur); }
        if (!has_next) break;
#pragma unroll
        for (int a = 0; a < 2; ++a)
#pragma unroll
            for (int b = 0; b < 2; ++b)
#pragma unroll
                for (int m = 0; m < 4; ++m)
#pragma unroll
                    for (int n = 0; n < 2; ++n) acc[a][b][m][n] = (f32x4){0.f, 0.f, 0.f, 0.f};
        cur = nxt; cA = nA; cB = nB; ++ui;
        if constexpr (ALIGN_EPI) { if (wr == 1) PG8_BAR; }
    }
    PG8_WAIT_V(0);
    if constexpr (!ALIGN_EPI) { if (wr == 0) PG8_BAR; }
    PG8_BAR;
    if constexpr (Epi::AFTER_DRAIN) { E.fused(acc, cur, wr, wc, fr, fq, lds, wid, lane); S.done(cur); }
#undef PG8_SA
#undef PG8_SB
#undef PG8_STAGE
#undef PG8_LDA
#undef PG8_LDB
#undef PG8_MMA
#undef PG8_WAIT_V
#undef PG8_WAIT_L
#undef PG8_BAR
#undef PG8_SCHED
}
}

#ifndef PG8_SP2
#define PG8_SP2 true
#endif
#ifndef PG8_ALIGN
#define PG8_ALIGN true
#endif

constexpr int NWAVES = 8;
#ifndef MK_ONE_LAUNCH
#define MK_ONE_LAUNCH 1
#endif
constexpr int NPHASES = 7;
#ifndef PROBE_DUP
#define PROBE_DUP 0
#endif
#ifndef PROBE_SEC
#define PROBE_SEC 0
#endif
#define PSEC_B(k) unsigned long long psec_t0_##k = 0; if (PROBE_SEC == (k)) { __builtin_amdgcn_sched_barrier(0); psec_t0_##k = __builtin_amdgcn_s_memrealtime(); __builtin_amdgcn_sched_barrier(0); }
#define PSEC_E(k) if (PROBE_SEC == (k)) { __builtin_amdgcn_sched_barrier(0); pacc += __builtin_amdgcn_s_memrealtime() - psec_t0_##k; __builtin_amdgcn_sched_barrier(0); }

constexpr int BATCH = 8, SEQ = 8192, D = 1024, M = BATCH * SEQ, NIN = 7168;
constexpr int RH = 4, DK = 128, DV = 256, CH = 64, NCH = SEQ / CH;
constexpr float LN_EPS = 1e-5f;
constexpr float DN_ALPHA = 1.189207115002721f;

constexpr size_t MiB = 1u << 20;
constexpr size_t WS_CTL = 0, CTL_ZERO_BYTES = 1 * MiB;
constexpr size_t WS_WIN = 2 * MiB;
constexpr size_t WS_PCAT = 16 * MiB;
constexpr size_t WS_WOUT = 20 * MiB;
constexpr size_t WS_ROPE = 22 * MiB;
constexpr size_t WS_Q = 32 * MiB, WS_K = 96 * MiB, WS_V = 160 * MiB, WS_ACAT = 288 * MiB, WS_XL = 544 * MiB, WS_GR = 672 * MiB, WS_GL = 800 * MiB, WS_END = 928 * MiB;
constexpr size_t WS_SLOC = 928 * MiB, WS_END2 = 960 * MiB;
constexpr size_t WS_MERGED = WS_Q;
constexpr int CW_TMO = 0, CW_CODE = 1, CW_BAR = 4096;

constexpr int RING_OFF = 0, RING_BYTES = 131072;
constexpr int LDSCTL_OFF = 163328, MISC_OFF = LDSCTL_OFF + 320;
constexpr int LDS_BYTES = 163840;
static_assert(MISC_OFF + 128 <= LDS_BYTES, "LDS map");

#define GAS __attribute__((address_space(1)))
#define LAS __attribute__((address_space(3)))
typedef unsigned short bf16;
typedef unsigned v4u __attribute__((ext_vector_type(4)));
typedef unsigned v2u __attribute__((ext_vector_type(2)));
typedef float f32x4 __attribute__((ext_vector_type(4)));
typedef GAS unsigned gu32;
#define RLX_AGENT __ATOMIC_RELAXED, __HIP_MEMORY_SCOPE_AGENT
#define LDS_WAIT() asm volatile("s_waitcnt lgkmcnt(0)" ::: "memory")
#define VM_WAIT() asm volatile("s_waitcnt vmcnt(0)" ::: "memory")
__device__ __forceinline__ unsigned f2bf(float f) { unsigned u = __builtin_bit_cast(unsigned, f); return (u + 0x7fffu + ((u >> 16) & 1u)) >> 16; }
__device__ __forceinline__ unsigned pk2(float lo, float hi) { return f2bf(lo) | (f2bf(hi) << 16); }
__device__ __forceinline__ float bflo(unsigned w) { return __builtin_bit_cast(float, w << 16); }
__device__ __forceinline__ float bfhi(unsigned w) { return __builtin_bit_cast(float, w & 0xffff0000u); }
__device__ __forceinline__ float bf2f(bf16 b) { return __builtin_bit_cast(float, ((unsigned)b) << 16); }

#define XB_TMO      128
#define XB_XCNT(j)  (256  + 64 * (j))
#define XB_XSUB(j)  (1280 + 64 * (j))
#define XB_XGEN(j)  (2304 + 64 * (j))
#define XB_TOP      3328
#define XB_TOPGEN   3392
#define XCD_BAR_WORDS 3456
#define XB_SPIN_CAP (1u << 18)

__device__ __forceinline__ unsigned xb_ld(unsigned* p)              { return __hip_atomic_load(p, __ATOMIC_RELAXED, __HIP_MEMORY_SCOPE_AGENT); }
__device__ __forceinline__ unsigned xb_add(unsigned* p, unsigned v) { return __hip_atomic_fetch_add(p, v, __ATOMIC_RELAXED, __HIP_MEMORY_SCOPE_AGENT); }
__device__ __forceinline__ unsigned xb_xcc_id() { return (unsigned)__builtin_amdgcn_s_getreg((3 << 11) | 20) & 0xFu; }
#define XB_SPIN(cond, bar) do { unsigned _sp = 0; while (cond) { __builtin_amdgcn_s_sleep(1); \
    if ((++_sp & 255u) == 0u) { if (xb_ld(&(bar)[XB_TMO])) break; if (_sp > XB_SPIN_CAP) { atomicAdd(&(bar)[XB_TMO], 1u); break; } } } } while (0)

struct XcdBarrier {
    unsigned* bar; unsigned x;
    volatile LAS unsigned* st;
};

__device__ __forceinline__ XcdBarrier xcd_barrier_post(unsigned* bar, volatile LAS unsigned* st) {
    XcdBarrier b; b.bar = bar; b.x = xb_xcc_id(); b.st = st;
    if (threadIdx.x == 0) (void)xb_add(&bar[XB_XCNT(b.x)], 1u);
    return b;
}
__device__ __forceinline__ void xcd_barrier_complete(unsigned* bar, unsigned x, unsigned& nloc, unsigned& nx) {
    const unsigned G = gridDim.x * gridDim.y * gridDim.z;
    unsigned sum, cnt, mine, sp = 0u;
    for (;;) {
        sum = 0u; cnt = 0u; mine = 0u;
#pragma unroll
        for (unsigned j = 0; j < 16; ++j) { const unsigned c = xb_ld(&bar[XB_XCNT(j)]); sum += c; cnt += (c > 0u) ? 1u : 0u; mine = (j == x) ? c : mine; }
        if (sum == G) break;
        __builtin_amdgcn_s_sleep(1);
        if ((++sp & 255u) == 0u) { if (xb_ld(&bar[XB_TMO])) break; if (sp > XB_SPIN_CAP) { atomicAdd(&bar[XB_TMO], 1u); break; } }
    }
    nloc = mine > 0u ? mine : 1u; nx = cnt > 0u ? cnt : 1u;
}

__device__ __forceinline__ void xcd_barrier(const XcdBarrier& b) {
    asm volatile("s_waitcnt vmcnt(0)" ::: "memory");
    __syncthreads();
    if (threadIdx.x == 0) {
        unsigned* bar = b.bar;
        __builtin_amdgcn_s_waitcnt(0);
        unsigned nloc = b.st[0], nx = b.st[1];
        if (nloc == 0u) { xcd_barrier_complete(bar, b.x, nloc, nx); b.st[0] = nloc; b.st[1] = nx; }
        const unsigned old = xb_add(&bar[XB_XSUB(b.x)], 1u);
        const unsigned gen = old / nloc;
        if (old + 1u == (gen + 1u) * nloc) {
            __builtin_amdgcn_fence(__ATOMIC_RELEASE, "agent");
            asm volatile("s_waitcnt vmcnt(0)" ::: "memory");
            const unsigned og = xb_add(&bar[XB_TOP], 1u);
            const unsigned tg = og / nx;
            if (og + 1u == (tg + 1u) * nx) xb_add(&bar[XB_TOPGEN], 1u);
            else XB_SPIN(xb_ld(&bar[XB_TOPGEN]) == tg, bar);
            __builtin_amdgcn_fence(__ATOMIC_ACQUIRE, "agent");
            xb_add(&bar[XB_XGEN(b.x)], 1u);
            asm volatile("s_waitcnt vmcnt(0)" ::: "memory");
        } else {
            XB_SPIN(xb_ld(&bar[XB_XGEN(b.x)]) == gen, bar);
            __builtin_amdgcn_fence(__ATOMIC_ACQUIRE, "agent");
            asm volatile("s_waitcnt vmcnt(0)" ::: "memory");
        }
    }
    __syncthreads();
}


namespace rt {
#define RT_DI __device__ __forceinline__
typedef short bf16x8 __attribute__((ext_vector_type(8)));
typedef short s16x4 __attribute__((ext_vector_type(4)));
typedef short v4i16_t __attribute__((ext_vector_type(4)));
typedef float f32x16 __attribute__((ext_vector_type(16)));
typedef float f32x2_t __attribute__((ext_vector_type(2)));
typedef __bf16 bf16x2_t __attribute__((ext_vector_type(2)));
typedef LAS const char* lds_cptr;
constexpr int NSEG = 8, CPS = NCH / NSEG;
constexpr int L_QT = 0, L_KT = 16384, L_VT = 32768, L_PT = 65536, L_ST = 73728, L_GB = 77824;
RT_DI unsigned cvtpk(float lo, float hi) { f32x2_t v = {lo, hi}; bf16x2_t b = __builtin_convertvector(v, bf16x2_t); return __builtin_bit_cast(unsigned, b); }
RT_DI unsigned off_b(unsigned row, unsigned ch) { return 256u * row + 16u * (ch ^ (((row & 3u) << 2) | ((row >> 2) & 3u))); }
RT_DI unsigned off_p(unsigned row, unsigned ch) { return 128u * row + 16u * (ch ^ ((row >> 1) & 7u)); }
RT_DI s16x4 trd(lds_cptr p) { return __builtin_bit_cast(s16x4, __builtin_amdgcn_ds_read_tr16_b64_v4i16((LAS v4i16_t*)p)); }
RT_DI bf16x8 tr8(lds_cptr tile, unsigned lane, unsigned c, unsigned ks) {
    const unsigned hh = lane >> 5, blk = (lane >> 4) & 1u, q = (lane & 15u) >> 2, p = lane & 3u;
    const s16x4 lo = trd(tile + off_b(16 * ks + 8 * hh + q, 4 * c + 2 * blk + (p >> 1)) + 8 * (p & 1u));
    const s16x4 hi = trd(tile + off_b(16 * ks + 8 * hh + 4 + q, 4 * c + 2 * blk + (p >> 1)) + 8 * (p & 1u));
    return __builtin_shufflevector(lo, hi, 0, 1, 2, 3, 4, 5, 6, 7);
}
RT_DI bf16x8 scale_frag(bf16x8 v, const float (&f)[8]) {
    const v4u w = __builtin_bit_cast(v4u, v); v4u o;
    o.x = cvtpk(bflo(w.x) * f[0], bfhi(w.x) * f[1]); o.y = cvtpk(bflo(w.y) * f[2], bfhi(w.y) * f[3]);
    o.z = cvtpk(bflo(w.z) * f[4], bfhi(w.z) * f[5]); o.w = cvtpk(bflo(w.w) * f[6], bfhi(w.w) * f[7]);
    return __builtin_bit_cast(bf16x8, o);
}
RT_DI bf16x8 pack8(const f32x16& x, int s) {
    v4u o; o.x = cvtpk(x[8 * s], x[8 * s + 1]); o.y = cvtpk(x[8 * s + 2], x[8 * s + 3]); o.z = cvtpk(x[8 * s + 4], x[8 * s + 5]); o.w = cvtpk(x[8 * s + 6], x[8 * s + 7]);
    return __builtin_bit_cast(bf16x8, o);
}
#define RT_MFMA32(a, b, c) __builtin_amdgcn_mfma_f32_32x32x16_bf16((a), (b), (c), 0, 0, 0)
#define RT_MFMA16(a, b, c) __builtin_amdgcn_mfma_f32_16x16x32_bf16((a), (b), (c), 0, 0, 0)

struct Stage { v4u q[2], k[2], v[4]; };
template <bool WITH_Q>
RT_DI void stage_load(Stage& st, const bf16* Q, const bf16* K, const bf16* V, size_t m0, int h, int t) {
    const char* qb = (const char*)(Q + m0 * 512 + h * 128); const char* kb = (const char*)(K + m0 * 512 + h * 128); const char* vb = (const char*)(V + m0 * 1024 + h * 256);
#pragma unroll
    for (int k = 0; k < 2; ++k) { const int id = t + 512 * k, row = id >> 4, ch = id & 15; const unsigned off = (unsigned)(row * 512 + ch * 8) * 2u;
        if (WITH_Q) st.q[k] = *(const GAS v4u*)(qb + off);
        st.k[k] = *(const GAS v4u*)(kb + off); }
#pragma unroll
    for (int k = 0; k < 4; ++k) { const int id = t + 512 * k, row = id >> 5, c32 = id & 31; const unsigned off = (unsigned)(row * 1024 + c32 * 8) * 2u;
        st.v[k] = *(const GAS v4u*)(vb + off); }
}
template <bool WITH_Q>
RT_DI void stage_write(const Stage& st, LAS unsigned char* lds, int t) {
#pragma unroll
    for (int k = 0; k < 2; ++k) { const int id = t + 512 * k, row = id >> 4, ch = id & 15;
        if (WITH_Q) *(LAS v4u*)(lds + L_QT + off_b(row, ch)) = st.q[k];
        *(LAS v4u*)(lds + L_KT + off_b(row, ch)) = st.k[k]; }
#pragma unroll
    for (int k = 0; k < 4; ++k) { const int id = t + 512 * k, row = id >> 5, c32 = id & 31;
        *(LAS v4u*)(lds + L_VT + (c32 >> 4) * 16384 + off_b(row, c32 & 15)) = st.v[k]; }
}
RT_DI void kv_update(f32x16 (&S)[4], const bf16x8 (&vf)[4], lds_cptr KT, unsigned lane, float cdec, const float (&wj)[8], const float (&fk)[4]) {
#pragma unroll
    for (int dt = 0; dt < 4; ++dt) S[dt] = S[dt] * cdec;
#pragma unroll
    for (int ks = 0; ks < 4; ++ks) {
        float f[8];
#pragma unroll
        for (int jj = 0; jj < 8; ++jj) f[jj] = wj[jj] * fk[ks];
        const bf16x8 vs = scale_frag(vf[ks], f);
#pragma unroll
        for (int dt = 0; dt < 4; ++dt) { const bf16x8 kf = tr8(KT, lane, dt, ks); S[dt] = RT_MFMA32(kf, vs, S[dt]); }
    }
}
RT_DI int crow(int reg, int hh) { return (reg & 3) + 8 * (reg >> 2) + 4 * hh; }

RT_DI void pass1(LAS unsigned char* lds, int tid, int wave, int item, const bf16* K, const bf16* V, float* SLOC) {
    const int chain = item >> 3, seg = item & 7, b = chain >> 2, h = chain & 3;
    if (seg == NSEG - 1) return;
    const unsigned lane = tid & 63, r = lane & 31, hh = lane >> 5;
    const float lg = log1pf(-exp2f(-5.f - (float)h));
    const float cdec = expf(lg * 64.f);
    float wj[8], fk[4];
#pragma unroll
    for (int jj = 0; jj < 8; ++jj) wj[jj] = expf(lg * (float)(7 - jj));
#pragma unroll
    for (int ks = 0; ks < 4; ++ks) fk[ks] = expf(lg * (float)(56 - 16 * ks - 8 * (int)hh));
    f32x16 S[4];
#pragma unroll
    for (int dt = 0; dt < 4; ++dt)
#pragma unroll
        for (int i = 0; i < 16; ++i) S[dt][i] = 0.f;
    lds_cptr KT = (lds_cptr)(lds + L_KT), VT = (lds_cptr)(lds + L_VT + (wave >> 2) * 16384);
    Stage st;
    const size_t mseg = (size_t)b * SEQ + (size_t)seg * CPS * CH;
    stage_load<false>(st, nullptr, K, V, mseg, h, tid);
    for (int c = 0; c < CPS; ++c) {
        __syncthreads();
        stage_write<false>(st, lds, tid);
        __syncthreads();
        if (c + 1 < CPS) stage_load<false>(st, nullptr, K, V, mseg + (size_t)(c + 1) * CH, h, tid);
        bf16x8 vf[4];
#pragma unroll
        for (int ks = 0; ks < 4; ++ks) vf[ks] = tr8(VT, lane, wave & 3, ks);
        kv_update(S, vf, KT, lane, cdec, wj, fk);
    }
    float* dst = SLOC + (size_t)item * (128 * 256) + wave * 4096 + lane;
#pragma unroll
    for (int dt = 0; dt < 4; ++dt)
#pragma unroll
        for (int i = 0; i < 16; ++i) dst[(dt * 16 + i) * 64] = S[dt][i];
}

RT_DI void pass2(LAS unsigned char* lds, int tid_, int wave, int item, const bf16* Q, const bf16* K, const bf16* V, const bf16* SGR, bf16* DST, const float* SLOC, const float* gn_g, const float* gn_b, unsigned long long& pacc) {
    const int chain = item >> 3, seg = item & 7, b = chain >> 2, h = chain & 3;
    const unsigned lane_ = tid_ & 63; const int tid = tid_;
    float cdec, lg2; const int it16 = wave >> 1, jt0 = 2 * (wave & 1);
    f32x16 S[4];
    {
    const unsigned lane = lane_;
    const float lg = log1pf(-exp2f(-5.f - (float)h));
    cdec = expf(lg * 64.f); lg2 = lg * 1.4426950408889634f;
#pragma unroll
    for (int dt = 0; dt < 4; ++dt)
#pragma unroll
        for (int i = 0; i < 16; ++i) S[dt][i] = 0.f;
    {
        const float sdec = expf(lg * (float)(CPS * CH));
        for (int g = 0; g < seg; ++g) { const float* src = SLOC + (size_t)(chain * NSEG + g) * (128 * 256) + wave * 4096 + lane;
#pragma unroll
            for (int dt = 0; dt < 4; ++dt)
#pragma unroll
                for (int i = 0; i < 16; ++i) S[dt][i] = S[dt][i] * sdec + src[(dt * 16 + i) * 64]; }
    }
    }
    __syncthreads();
    for (int i = tid; i < 512; i += 512) ((LAS float*)(lds + L_GB))[i] = (i < 256) ? gn_g[h * 256 + i] : gn_b[h * 256 + i - 256];
    lds_cptr QT = (lds_cptr)(lds + L_QT), KT = (lds_cptr)(lds + L_KT), VT = (lds_cptr)(lds + L_VT + (wave >> 2) * 16384), PT = (lds_cptr)(lds + L_PT);
    Stage st;
    const size_t mseg = (size_t)b * SEQ + (size_t)seg * CPS * CH;
    stage_load<true>(st, Q, K, V, mseg, h, tid);
    for (int c = 0; c < CPS; ++c) {
        const size_t m0 = mseg + (size_t)c * CH;
        int tid = tid_; asm volatile("" : "+v"(tid));
        const unsigned lane = tid & 63, r = lane & 31, hh = lane >> 5, fr = lane & 15, fq = lane >> 4;
        float wj[8], fk[4], pdec[2][4];
#pragma unroll
        for (int jj = 0; jj < 8; ++jj) wj[jj] = __builtin_amdgcn_exp2f(lg2 * (float)(7 - jj));
#pragma unroll
        for (int ks = 0; ks < 4; ++ks) fk[ks] = __builtin_amdgcn_exp2f(lg2 * (float)(56 - 16 * ks - 8 * (int)hh));
        const float qd0 = __builtin_amdgcn_exp2f(lg2 * (float)(r + 1)), qd1 = __builtin_amdgcn_exp2f(lg2 * (float)(r + 33));
#pragma unroll
        for (int tt = 0; tt < 2; ++tt)
#pragma unroll
            for (int e = 0; e < 4; ++e) { const int i = 16 * it16 + (int)fr, j = 16 * (jt0 + tt) + 4 * (int)fq + e; pdec[tt][e] = __builtin_amdgcn_exp2f(lg2 * (float)(i > j ? i - j : j - i)); }
        PSEC_B(11) stage_write<true>(st, lds, tid);
        __syncthreads();
        PSEC_E(11) PSEC_B(12)
        {
            f32x4 p[2] = {(f32x4){0.f, 0.f, 0.f, 0.f}, (f32x4){0.f, 0.f, 0.f, 0.f}};
#pragma unroll
            for (int s = 0; s < 4; ++s) {
                const bf16x8 qf = *(const LAS bf16x8*)(QT + off_b(fr + 16 * it16, 4 * s + fq));
#pragma unroll
                for (int tt = 0; tt < 2; ++tt) { const bf16x8 kf = *(const LAS bf16x8*)(KT + off_b(fr + 16 * (jt0 + tt), 4 * s + fq)); p[tt] = RT_MFMA16(kf, qf, p[tt]); }
            }
#pragma unroll
            for (int tt = 0; tt < 2; ++tt) { v2u w; w.x = cvtpk(p[tt][0] * pdec[tt][0], p[tt][1] * pdec[tt][1]); w.y = cvtpk(p[tt][2] * pdec[tt][2], p[tt][3] * pdec[tt][3]);
                *(LAS v2u*)(lds + L_PT + off_p(16 * it16 + fr, 2 * (jt0 + tt) + (fq >> 1)) + 8 * (fq & 1)) = w; }
        }
        __syncthreads();
        PSEC_E(12) PSEC_B(13)
        f32x16 z[2];
#pragma unroll
        for (int it = 0; it < 2; ++it)
#pragma unroll
            for (int i = 0; i < 16; ++i) z[it][i] = 0.f;
#pragma unroll
        for (int dt = 0; dt < 4; ++dt)
#pragma unroll
            for (int s = 0; s < 2; ++s) {
                const bf16x8 xs = pack8(S[dt], s);
#pragma unroll
                for (int it = 0; it < 2; ++it) {
                    const s16x4 lo = *(const LAS s16x4*)(QT + off_b(32 * it + r, 4 * dt + 2 * s) + 8 * hh);
                    const s16x4 hi = *(const LAS s16x4*)(QT + off_b(32 * it + r, 4 * dt + 2 * s + 1) + 8 * hh);
                    const bf16x8 qb = __builtin_shufflevector(lo, hi, 0, 1, 2, 3, 4, 5, 6, 7);
                    z[it] = RT_MFMA32(xs, qb, z[it]);
                }
            }
        z[0] = z[0] * qd0; z[1] = z[1] * qd1;
        PSEC_E(13) PSEC_B(14)
        bf16x8 vf[4];
#pragma unroll
        for (int ks = 0; ks < 4; ++ks) vf[ks] = tr8(VT, lane, wave & 3, ks);
#pragma unroll
        for (int ks = 0; ks < 4; ++ks)
#pragma unroll
            for (int it = 0; it < 2; ++it) { const bf16x8 pf = *(const LAS bf16x8*)(PT + off_p(32 * it + r, 2 * ks + hh)); z[it] = RT_MFMA32(vf[ks], pf, z[it]); }
        PSEC_E(14) PSEC_B(15)
        kv_update(S, vf, KT, lane, cdec, wj, fk);
        PSEC_E(15) PSEC_B(16)
        if (c + 1 < CPS) stage_load<true>(st, Q, K, V, m0 + CH, h, tid);
        const size_t ooff = (m0 + r) * 2048 + h * 256 + 32 * wave + 4 * hh; const bf16* srow0 = SGR + ooff; bf16* orow0 = DST + ooff;
        v2u sg[2][4];
#pragma unroll
        for (int it = 0; it < 2; ++it)
#pragma unroll
            for (int g4 = 0; g4 < 4; ++g4) sg[it][g4] = *(const GAS v2u*)(srow0 + (size_t)it * 32 * 2048 + 8 * g4);
        typedef float f2 __attribute__((ext_vector_type(2)));
#pragma unroll
        for (int it = 0; it < 2; ++it) {
            float s1 = 0.f;
#pragma unroll
            for (int i = 0; i < 16; ++i) s1 += z[it][i];
            s1 += __shfl_xor(s1, 32);
            const float mw = s1 * (1.f / 32.f); float m2 = 0.f;
#pragma unroll
            for (int i = 0; i < 16; ++i) { const float d = z[it][i] - mw; m2 += d * d; }
            m2 += __shfl_xor(m2, 32);
            if (hh == 0) *(LAS f2*)(lds + L_ST + ((32 * it + r) * 8 + wave) * 8) = (f2){mw, m2};
        }
        __syncthreads();
        PSEC_E(16) PSEC_B(17)
#pragma unroll
        for (int it = 0; it < 2; ++it) {
            const LAS f32x4* sp = (const LAS f32x4*)(lds + L_ST + (32 * it + r) * 64);
            const f32x4 a0 = sp[0], a1 = sp[1], a2 = sp[2], a3 = sp[3];
            const float mean = ((a0[0] + a0[2]) + (a1[0] + a1[2]) + (a2[0] + a2[2]) + (a3[0] + a3[2])) * 0.125f;
            float q = (a0[1] + a0[3]) + (a1[1] + a1[3]) + (a2[1] + a2[3]) + (a3[1] + a3[3]);
            { const float d0 = a0[0] - mean, d1 = a0[2] - mean, d2 = a1[0] - mean, d3 = a1[2] - mean, d4 = a2[0] - mean, d5 = a2[2] - mean, d6 = a3[0] - mean, d7 = a3[2] - mean;
              q += 32.f * ((d0 * d0 + d1 * d1) + (d2 * d2 + d3 * d3) + (d4 * d4 + d5 * d5) + (d6 * d6 + d7 * d7)); }
            const float rstd = 1.f / sqrtf(q * (1.f / 256.f) + LN_EPS);
#pragma unroll
            for (int g4 = 0; g4 < 4; ++g4) {
                const f32x4 gg = *(const LAS f32x4*)(lds + L_GB + (32 * wave + 8 * g4 + 4 * hh) * 4), bb = *(const LAS f32x4*)(lds + L_GB + 1024 + (32 * wave + 8 * g4 + 4 * hh) * 4);
                const float y0 = (z[it][4 * g4 + 0] - mean) * rstd * gg[0] + bb[0], y1 = (z[it][4 * g4 + 1] - mean) * rstd * gg[1] + bb[1];
                const float y2 = (z[it][4 * g4 + 2] - mean) * rstd * gg[2] + bb[2], y3 = (z[it][4 * g4 + 3] - mean) * rstd * gg[3] + bb[3];
                v2u w; w.x = cvtpk(bflo(sg[it][g4].x) * y0, bfhi(sg[it][g4].x) * y1); w.y = cvtpk(bflo(sg[it][g4].y) * y2, bfhi(sg[it][g4].y) * y3);
                *(GAS v2u*)(orow0 + (size_t)it * 32 * 2048 + 8 * g4) = w;
            }
        }
        PSEC_E(17)
    }
    __syncthreads();
}
#undef RT_MFMA32
#undef RT_MFMA16
#undef RT_DI
}


namespace lr {
#define LR_DI __device__ __forceinline__
typedef short bf16x8 __attribute__((ext_vector_type(8)));
typedef float f32x16 __attribute__((ext_vector_type(16)));
constexpr int TOK = 256, NIT = SEQ / TOK, XT_ROWS = 260;
constexpr int L_XT = 0, L_WT = XT_ROWS * 256, L_AG = L_WT + 16384, L_BIAS = L_AG + 2048, L_CWT = L_BIAS + 256, L_XCF = L_CWT + 2560, L_SGT = L_XCF + 32768, L_END = L_SGT + 16384;
static_assert(L_END <= LDSCTL_OFF, "LRU LDS map");
struct XStage { v4u v[9]; };
LR_DI void x_load(XStage& st, const bf16* XL, int b, int cb, int t0, int t) {
    const char* base = (const char*)(XL + ((size_t)b * SEQ + t0) * 1024 + cb * 128) - 3 * 2048;
    const int rmin = (t0 == 0) ? 3 : 0;
#pragma unroll
    for (int k = 0; k < 9; ++k) { int id = t + 512 * k; id = id < 259 * 16 ? id : 259 * 16 - 1; const int R = id >> 4, ch = id & 15, Rl = R < rmin ? rmin : R;
        const v4u v = *(const GAS v4u*)(base + (unsigned)(Rl * 2048 + ch * 16));
        st.v[k] = (R < rmin) ? (v4u){0u, 0u, 0u, 0u} : v; }
}
LR_DI void x_write(const XStage& st, LAS unsigned char* lds, int t) {
#pragma unroll
    for (int k = 0; k < 9; ++k) { const int id = t + 512 * k, R = id >> 4, ch = id & 15;
        if (id < 259 * 16) *(LAS v4u*)(lds + L_XT + R * 256 + 16 * (ch ^ (R & 15))) = st.v[k]; }
}
LR_DI void run(LAS unsigned char* lds, int tid_, int wave, int item, const bf16* XL, const bf16* SGL, bf16* DST, const float* conv_w, const float* conv_b,
               const float* w_a, const float* b_a, const float* w_x, const float* b_x, const float* lam, unsigned long long& pacc) {
    const int b = item >> 5, cb = (item >> 2) & 7, q = item & 3;
    float bias_r, bias_i, Lc2, Lcn2;
    _Pragma("nounroll") for (int rep = 0; rep < ((((PROBE_DUP) >> 9) & 1) + 1); ++rep)
    {
        const int tid = tid_;
        __syncthreads();
#pragma unroll
        for (int i = 0; i < 2; ++i) { const int id = tid + 512 * i, gate = id >> 9, ch = (id >> 5) & 15, n = id & 31;
            const float* W = (gate ? w_x : w_a) + ((size_t)cb * 128 + 8 * ch) * 128 + q * 32 + n; float v[8];
#pragma unroll
            for (int e = 0; e < 8; ++e) v[e] = W[e * 128];
            v4u o; o.x = rt::cvtpk(v[0], v[1]); o.y = rt::cvtpk(v[2], v[3]); o.z = rt::cvtpk(v[4], v[5]); o.w = rt::cvtpk(v[6], v[7]);
            *(LAS v4u*)(lds + L_WT + gate * 8192 + rt::off_b(n, ch)) = o; }
        if (tid < 64) ((LAS float*)(lds + L_BIAS))[tid] = ((tid >> 5) ? b_x : b_a)[cb * 128 + q * 32 + (tid & 31)];
        for (int i = tid; i < 16 * 5 * 8; i += 512) { const int ch = i / 40, j = (i % 40) >> 3, e = i & 7; const int c = cb * 128 + 8 * ch + e;
            ((LAS float*)(lds + L_CWT))[i] = (j < 4) ? conv_w[j * 1024 + c] : conv_b[c]; }
        __syncthreads();
        const int r = tid & 31, chn = cb * 128 + q * 32 + r;
        bias_r = ((LAS float*)(lds + L_BIAS))[r]; bias_i = ((LAS float*)(lds + L_BIAS))[32 + r];
        const float Lc = -8.0f * log1pf(expf(-lam[chn]));
        Lc2 = Lc * 1.4426950408889634f; Lcn2 = 2.0f * Lc;
    }
    float carry = 0.f;
    XStage st;
    x_load(st, XL, b, cb, 0, tid_);
#pragma unroll 1
    for (int it = 0; it < NIT; ++it) {
        const int t0 = it * TOK;
        int tid = tid_; asm volatile("" : "+v"(tid));
        const unsigned lane = tid & 63, r = lane & 31, hh = lane >> 5;
        PSEC_B(1) x_write(st, lds, tid);
        __syncthreads();
        PSEC_E(1) PSEC_B(2)
        const size_t orow0 = ((size_t)b * SEQ + t0 + 32 * wave) * 2048 + cb * 128 + q * 32;
        v4u sgv[2];
#pragma unroll
        for (int k = 0; k < 2; ++k) { const int id = lane + 64 * k; sgv[k] = *(const GAS v4u*)(SGL + orow0 + (size_t)(id >> 2) * 2048 + (id & 3) * 8); }
        if (it + 1 < NIT) x_load(st, XL, b, cb, t0 + TOK, tid);
        v4u co[2][4];
        {
            const unsigned ch = tid & 15;
            f32x4 wv[5][2];
#pragma unroll
            for (int j = 0; j < 5; ++j) { wv[j][0] = *(const LAS f32x4*)(lds + L_CWT + (ch * 40 + j * 8) * 4); wv[j][1] = *(const LAS f32x4*)(lds + L_CWT + (ch * 40 + j * 8 + 4) * 4); }
#pragma unroll
            for (int k = 0; k < 2; ++k) {
                const unsigned T = 4 * ((tid >> 4) + 32 * k);
                float xv[7][8];
#pragma unroll
                for (int d = 0; d < 7; ++d) { const unsigned R = T + d; const v4u w = *(const LAS v4u*)(lds + L_XT + R * 256 + 16 * (ch ^ (R & 15)));
                    xv[d][0] = bflo(w.x); xv[d][1] = bfhi(w.x); xv[d][2] = bflo(w.y); xv[d][3] = bfhi(w.y); xv[d][4] = bflo(w.z); xv[d][5] = bfhi(w.z); xv[d][6] = bflo(w.w); xv[d][7] = bfhi(w.w); }
#pragma unroll
                for (int e4 = 0; e4 < 4; ++e4) { float o[8];
#pragma unroll
                    for (int e = 0; e < 8; ++e) { const int hv = e >> 2, c4 = e & 3;
                        o[e] = wv[4][hv][c4] + wv[0][hv][c4] * xv[e4][e] + wv[1][hv][c4] * xv[e4 + 1][e] + wv[2][hv][c4] * xv[e4 + 2][e] + wv[3][hv][c4] * xv[e4 + 3][e]; }
                    co[k][e4].x = rt::cvtpk(o[0], o[1]); co[k][e4].y = rt::cvtpk(o[2], o[3]); co[k][e4].z = rt::cvtpk(o[4], o[5]); co[k][e4].w = rt::cvtpk(o[6], o[7]);
                    if ((ch >> 2) == (unsigned)q) {
                        LAS float* xf = (LAS float*)(lds + L_XCF) + (T + e4) * 32 + (ch & 3) * 8;
                        *(LAS f32x4*)xf = (f32x4){o[0], o[1], o[2], o[3]}; *(LAS f32x4*)(xf + 4) = (f32x4){o[4], o[5], o[6], o[7]}; }
                }
            }
        }
        __syncthreads();
#pragma unroll
        for (int k = 0; k < 2; ++k) { const unsigned ch = tid & 15, T = 4 * ((tid >> 4) + 32 * k);
#pragma unroll
            for (int e4 = 0; e4 < 4; ++e4) { const unsigned R = T + e4; *(LAS v4u*)(lds + L_XT + R * 256 + 16 * (ch ^ (R & 15))) = co[k][e4]; } }
#pragma unroll
        for (int k = 0; k < 2; ++k) { const int id = lane + 64 * k; *(LAS v4u*)(lds + L_SGT + wave * 2048 + id * 16) = sgv[k]; }
        __syncthreads();
        PSEC_E(2) PSEC_B(3)
        f32x16 ar, ai;
#pragma unroll
        for (int i = 0; i < 16; ++i) { ar[i] = bias_r; ai[i] = bias_i; }
        {
            const unsigned R = 32 * wave + r;
#pragma unroll
            for (int ks = 0; ks < 8; ++ks) {
                const bf16x8 xa = *(const LAS bf16x8*)(lds + L_XT + R * 256 + 16 * ((2 * ks + hh) ^ (R & 15)));
                const bf16x8 wa = *(const LAS bf16x8*)(lds + L_WT + rt::off_b(r, 2 * ks + hh));
                const bf16x8 wx = *(const LAS bf16x8*)(lds + L_WT + 8192 + rt::off_b(r, 2 * ks + hh));
                ar = __builtin_amdgcn_mfma_f32_32x32x16_bf16(xa, wa, ar, 0, 0, 0);
                ai = __builtin_amdgcn_mfma_f32_32x32x16_bf16(xa, wx, ai, 0, 0, 0);
            }
        }
        PSEC_E(3) PSEC_B(4)
        float a[16], u[16];
#pragma unroll
        for (int i = 0; i < 16; ++i) {
            const float xc = ((const LAS float*)(lds + L_XCF))[(32 * wave + (i & 3) + 8 * (i >> 2) + 4 * hh) * 32 + r];
            const float rg = __builtin_amdgcn_rcpf(1.0f + __builtin_amdgcn_exp2f(-1.4426950408889634f * ar[i]));
            const float ig = __builtin_amdgcn_rcpf(1.0f + __builtin_amdgcn_exp2f(-1.4426950408889634f * ai[i]));
            const float av = __builtin_amdgcn_exp2f(rg * Lc2);
            const float y = rg * Lcn2;
            const float s_small = -y * (1.0f + y * (0.5f + y * (0.16666667f + y * 0.041666668f)));
            const float s_big = 1.0f - av * av;
            const float s = (y > -0.25f) ? s_small : s_big;
            a[i] = av; u[i] = __builtin_amdgcn_sqrtf(s) * (ig * xc);
        }
        PSEC_E(4) PSEC_B(5)
        float Ag[4], Hg[4], Ap[4], Hp[4];
#pragma unroll
        for (int g = 0; g < 4; ++g) { Ag[g] = (a[4 * g] * a[4 * g + 1]) * (a[4 * g + 2] * a[4 * g + 3]);
            Hg[g] = ((u[4 * g] * a[4 * g + 1] + u[4 * g + 1]) * a[4 * g + 2] + u[4 * g + 2]) * a[4 * g + 3] + u[4 * g + 3];
            Ap[g] = __shfl_xor(Ag[g], 32); Hp[g] = __shfl_xor(Hg[g], 32); }
        float Ac = 1.0f, Hc = 0.0f, Ab[4], Hb[4];
#pragma unroll
        for (int g = 0; g < 4; ++g) {
            const float A1 = hh ? Ap[g] : Ag[g], H1 = hh ? Hp[g] : Hg[g], A2 = hh ? Ag[g] : Ap[g], H2 = hh ? Hg[g] : Hp[g];
            const float Hc1 = A1 * Hc + H1, Ac1 = Ac * A1;
            Ab[g] = hh ? Ac1 : Ac; Hb[g] = hh ? Hc1 : Hc;
            Hc = A2 * Hc1 + H2; Ac = Ac1 * A2;
        }
        typedef float f2 __attribute__((ext_vector_type(2)));
        if (hh == 0) *(LAS f2*)(lds + L_AG + (wave * 32 + r) * 8) = (f2){Ac, Hc};
        __syncthreads();
        PSEC_E(5) PSEC_B(6)
        float c = carry, cin = carry;
#pragma unroll
        for (int w = 0; w < 8; ++w) { const f2 ah = *(const LAS f2*)(lds + L_AG + (w * 32 + r) * 8); if (w == wave) cin = c; c = ah.x * c + ah.y; }
        carry = c;
        LAS bf16* slab = (LAS bf16*)(lds + L_SGT + wave * 2048);
#pragma unroll
        for (int g = 0; g < 4; ++g) { float h = Hb[g] + Ab[g] * cin;
#pragma unroll
            for (int e = 0; e < 4; ++e) { const int i = 4 * g + e; h = a[i] * h + u[i];
                LAS bf16* p = slab + ((i & 3) + 8 * (i >> 2) + 4 * hh) * 32 + r;
                *p = (bf16)(rt::cvtpk(bf2f(*p) * h, 0.f) & 0xffffu); } }
#pragma unroll
        for (int k = 0; k < 2; ++k) { const int id = lane + 64 * k; const v4u v = *(const LAS v4u*)(lds + L_SGT + wave * 2048 + id * 16);
            *(GAS v4u*)(DST + orow0 + (size_t)(id >> 2) * 2048 + (id & 3) * 8) = v; }
        PSEC_E(6)
    }
    __syncthreads();
}
#undef LR_DI
}

struct Frame {
    LAS unsigned char* lds;
    volatile LAS unsigned* MISC;
    gu32* ctl;
    int tid, lane, wave;
    int vcu, G;
    const float* x; float* out;
    const float *ln_in_g, *ln_in_b, *w_in, *b_merge, *gn_g, *gn_b, *w_ret, *conv_w, *conv_b, *w_rg_a, *b_rg_a, *w_rg_x, *b_rg_x, *lam, *w_lru, *w_out, *ln_out_g, *ln_out_b;
    bf16 *WinT, *PcatT, *WoutT; float* rope;
    bf16 *Q, *K, *V, *SGR, *XL, *SGL, *GR, *GL, *MERGED, *XN;
};

__device__ __forceinline__ float wave_sum(float v) {
#pragma unroll
    for (int o = 1; o < 64; o <<= 1) v += __shfl_xor(v, o);
    return v;
}
__device__ __forceinline__ int win_dest_row(int c) {
    if (c >= 1024) return c;
    const int blk = c >> 9, cc = c & 511, head = cc >> 7, idx = cc & 127, bj = idx >> 6, i = idx & 63;
    return blk * 512 + (head >> 1) * 256 + 128 * bj + (head & 1) * 64 + i;
}
template <bool WIN>
__device__ __forceinline__ void p0_transpose_item(const float* W, int ldw, bf16* WT, int ldt, int koff, LAS float* scr, int k0, int n0, int lane) {
#pragma unroll 8
    for (int i = 0; i < 32; ++i) { const int kk = 2 * i + (lane >> 5); scr[kk * 33 + (lane & 31)] = W[(size_t)(k0 + kk) * ldw + n0 + (lane & 31)]; }
    LDS_WAIT(); asm volatile("" ::: "memory");
    const int c = lane & 7;
#pragma unroll
    for (int j = 0; j < 4; ++j) { const int n = (lane >> 3) + 8 * j; const LAS float* s = scr + (8 * c) * 33 + n;
        const int col = n0 + n; const int drow = WIN ? win_dest_row(col) : col;
        const float sc = (WIN && col >= 512 && col < 1024) ? 0.08838834764831845f : 1.0f;
        v4u o; o.x = pk2(s[0 * 33] * sc, s[1 * 33] * sc); o.y = pk2(s[2 * 33] * sc, s[3 * 33] * sc); o.z = pk2(s[4 * 33] * sc, s[5 * 33] * sc); o.w = pk2(s[6 * 33] * sc, s[7 * 33] * sc);
        *(GAS v4u*)(WT + (size_t)drow * ldt + koff + k0 + 8 * c) = o; }
    LDS_WAIT(); asm volatile("" ::: "memory");
}
__device__ __forceinline__ void p0_prologue(Frame& F) {
    LAS float* scr = (LAS float*)(F.lds + RING_OFF + F.wave * 16384);
    const int gw = F.vcu * NWAVES + F.wave, NGW = F.G * NWAVES;
    constexpr int I_IN = (D / 64) * (NIN / 32), I_SQ = (D / 64) * (D / 32);
    constexpr int NITEMS = I_IN + 3 * I_SQ;
    for (int it = gw; it < NITEMS; it += NGW) {
        int r = it;
        if (r < I_IN) { const int nblk = NIN / 32; p0_transpose_item<true>(F.w_in, NIN, F.WinT, D, 0, scr, 64 * (r / nblk), 32 * (r % nblk), F.lane); continue; } r -= I_IN;
        const int nblk = D / 32, k0 = 64 * ((r % I_SQ) / nblk), n0 = 32 * ((r % I_SQ) % nblk);
        if (r < I_SQ) { p0_transpose_item<false>(F.w_ret, D, F.PcatT, 2 * D, 0, scr, k0, n0, F.lane); continue; }
        if (r < 2 * I_SQ) { p0_transpose_item<false>(F.w_lru, D, F.PcatT, 2 * D, D, scr, k0, n0, F.lane); continue; }
        p0_transpose_item<false>(F.w_out, D, F.WoutT, D, 0, scr, k0, n0, F.lane);
    }
    for (int e = (F.vcu * NWAVES * 64) + F.tid; e < SEQ * 64; e += F.G * NWAVES * 64) {
        const int pos = e >> 6, i = e & 63;
        const double inv = exp(-(double)i * (9.210340371976184 / 64.0));
        const double ang = (double)pos * inv;
        const double n = rint(ang * 0.15915494309189535);
        double r = fma(-n, 6.283185307179586, ang); r = fma(-n, 2.4492935982947064e-16, r);
        const float rf = (float)r;
        typedef float f32x2 __attribute__((ext_vector_type(2)));
        f32x2 cs; cs.x = cosf(rf); cs.y = sinf(rf);
        *(GAS f32x2*)((GAS float*)F.rope + (size_t)e * 2) = cs;
    }
    f32x4 gv[4], bv[4];
#pragma unroll
    for (int j = 0; j < 4; ++j) { gv[j] = *((const GAS f32x4*)F.ln_in_g + F.lane + 64 * j); bv[j] = *((const GAS f32x4*)F.ln_in_b + F.lane + 64 * j); }
    f32x4 vn[4];
    if (gw < M) {
#pragma unroll
        for (int j = 0; j < 4; ++j) vn[j] = ((const GAS f32x4*)(F.x + (size_t)gw * D) + F.lane)[64 * j]; }
    for (int m = gw; m < M; m += NGW) {
        f32x4 v[4]; float s = 0.f;
#pragma unroll
        for (int j = 0; j < 4; ++j) { v[j] = vn[j]; s += (v[j].x + v[j].y) + (v[j].z + v[j].w); }
        if (m + NGW < M) {
#pragma unroll
            for (int j = 0; j < 4; ++j) vn[j] = ((const GAS f32x4*)(F.x + (size_t)(m + NGW) * D) + F.lane)[64 * j]; }
        const float mean = wave_sum(s) * (1.f / D); float s2 = 0.f;
#pragma unroll
        for (int j = 0; j < 4; ++j) { v[j] = v[j] - mean; s2 += (v[j].x * v[j].x + v[j].y * v[j].y) + (v[j].z * v[j].z + v[j].w * v[j].w); }
        const float rstd = 1.f / sqrtf(wave_sum(s2) * (1.f / D) + LN_EPS);
        GAS v2u* o8 = (GAS v2u*)(F.XN + (size_t)m * D) + F.lane;
#pragma unroll
        for (int j = 0; j < 4; ++j) { const f32x4 y = v[j] * rstd * gv[j] + bv[j]; v2u w; w.x = pk2(y.x, y.y); w.y = pk2(y.z, y.w); o8[64 * j] = w; }
    }
}

__device__ __forceinline__ void ret_simple(Frame& F, int item, float* RAW) {
    const int b = item >> 5, h = (item >> 3) & 3, es = item & 7, t = F.tid;
    LAS float* Qs = (LAS float*)(F.lds);
    LAS float* Ks = Qs + 64 * 129;
    LAS float* Vs = Ks + 64 * 129;
    LAS float* Ps = Vs + 64 * 32;
    LAS float* Ss = Ps + 64 * 65;
    const float lg = log1pf(-exp2f(-5.f - (float)h));
    for (int i = t; i < 128 * 32; i += 512) Ss[i] = 0.f;
    const float cdec = expf(lg * 64.f);
    for (int c = 0; c < NCH; ++c) {
        const size_t m0 = (size_t)b * SEQ + (size_t)c * CH;
        __syncthreads();
#pragma unroll
        for (int k = 0; k < 2; ++k) { const int id = t + 512 * k, row = id >> 4, c8 = id & 15;
            const v4u q = *(const GAS v4u*)(F.Q + (m0 + row) * 512 + h * 128 + c8 * 8), kk = *(const GAS v4u*)(F.K + (m0 + row) * 512 + h * 128 + c8 * 8);
            LAS float* qd = Qs + row * 129 + c8 * 8; LAS float* kd = Ks + row * 129 + c8 * 8;
            qd[0] = bflo(q.x); qd[1] = bfhi(q.x); qd[2] = bflo(q.y); qd[3] = bfhi(q.y); qd[4] = bflo(q.z); qd[5] = bfhi(q.z); qd[6] = bflo(q.w); qd[7] = bfhi(q.w);
            kd[0] = bflo(kk.x); kd[1] = bfhi(kk.x); kd[2] = bflo(kk.y); kd[3] = bfhi(kk.y); kd[4] = bflo(kk.z); kd[5] = bfhi(kk.z); kd[6] = bflo(kk.w); kd[7] = bfhi(kk.w); }
        if (t < 256) { const int row = t >> 2, c8 = t & 3;
            const v4u v = *(const GAS v4u*)(F.V + (m0 + row) * 1024 + h * 256 + es * 32 + c8 * 8);
            LAS float* vd = Vs + row * 32 + c8 * 8;
            vd[0] = bflo(v.x); vd[1] = bfhi(v.x); vd[2] = bflo(v.y); vd[3] = bfhi(v.y); vd[4] = bflo(v.z); vd[5] = bfhi(v.z); vd[6] = bflo(v.w); vd[7] = bfhi(v.w); }
        __syncthreads();
        {
            const int i = t >> 3, jg = t & 7; float a[8];
#pragma unroll
            for (int jj = 0; jj < 8; ++jj) a[jj] = 0.f;
            for (int d = 0; d < 128; ++d) { const float q = Qs[i * 129 + d];
#pragma unroll
                for (int jj = 0; jj < 8; ++jj) a[jj] += q * Ks[(jg * 8 + jj) * 129 + d]; }
#pragma unroll
            for (int jj = 0; jj < 8; ++jj) { const int j = jg * 8 + jj; const int dd = i > j ? i - j : j - i; Ps[i * 65 + j] = a[jj] * expf(lg * (float)dd); }
        }
        __syncthreads();
        {
            const int e = t & 31, ig = t >> 5;
#pragma unroll
            for (int ii = 0; ii < 4; ++ii) { const int i = ig * 4 + ii; float o1 = 0.f, o2 = 0.f;
                for (int j = 0; j < 64; ++j) o1 += Ps[i * 65 + j] * Vs[j * 32 + e];
                for (int d = 0; d < 128; ++d) o2 += Qs[i * 129 + d] * Ss[d * 32 + e];
                RAW[(m0 + i) * 1024 + h * 256 + es * 32 + e] = o1 + expf(lg * (float)(i + 1)) * o2; }
        }
        __syncthreads();
        {
            const int e = t & 31, dg = t >> 5; float a[8];
#pragma unroll
            for (int dd = 0; dd < 8; ++dd) a[dd] = 0.f;
            for (int j = 0; j < 64; ++j) { const float vd = Vs[j * 32 + e] * expf(lg * (float)(63 - j));
#pragma unroll
                for (int dd = 0; dd < 8; ++dd) a[dd] += Ks[j * 129 + dg * 8 + dd] * vd; }
#pragma unroll
            for (int dd = 0; dd < 8; ++dd) { const int d = dg * 8 + dd; Ss[d * 32 + e] = Ss[d * 32 + e] * cdec + a[dd]; }
        }
    }
    __syncthreads();
}

__device__ __forceinline__ void lru_simple(Frame& F, int item) {
    const int b = item >> 5, cb = (item >> 2) & 7, q = item & 3, t = F.tid;
    LAS float* Xs = (LAS float*)(F.lds);
    LAS float* XC = Xs + 67 * 128;
    LAS float* Wa = XC + 64 * 129;
    LAS float* Wx = Wa + 128 * 32;
    LAS float* AA = Wx + 128 * 32;
    LAS float* UU = AA + 64 * 32;
    LAS float* Hc = UU + 64 * 32;
    __syncthreads();
    for (int i = t; i < 128 * 32; i += 512) { const int r = i >> 5, c = i & 31;
        Wa[i] = F.w_rg_a[((size_t)cb * 128 + r) * 128 + q * 32 + c]; Wx[i] = F.w_rg_x[((size_t)cb * 128 + r) * 128 + q * 32 + c]; }
    if (t < 32) Hc[t] = 0.f;
    const int c = t & 31, tg = t >> 5, ch = cb * 128 + q * 32 + c;
    const float ba = F.b_rg_a[ch], bx = F.b_rg_x[ch];
    const float lamv = F.lam[ch];
    const float Lc = -8.0f * log1pf(expf(-lamv));
    for (int tile = 0; tile < SEQ / 64; ++tile) {
        const int t0 = tile * 64; const size_t m0 = (size_t)b * SEQ + t0;
        __syncthreads();
        for (int id = t; id < 67 * 16; id += 512) { const int r = id >> 4, c8 = id & 15; const int s = t0 - 3 + r;
            v4u v = (v4u){0u, 0u, 0u, 0u};
            if (s >= 0) v = *(const GAS v4u*)(F.XL + ((size_t)b * SEQ + s) * 1024 + cb * 128 + c8 * 8);
            LAS float* xd = Xs + r * 128 + c8 * 8;
            xd[0] = bflo(v.x); xd[1] = bfhi(v.x); xd[2] = bflo(v.y); xd[3] = bfhi(v.y); xd[4] = bflo(v.z); xd[5] = bfhi(v.z); xd[6] = bflo(v.w); xd[7] = bfhi(v.w); }
        __syncthreads();
#pragma unroll 4
        for (int k = 0; k < 16; ++k) { const int id = t + 512 * k, tt = id >> 7, i = id & 127, cc = cb * 128 + i;
            float a = F.conv_b[cc];
#pragma unroll
            for (int j = 0; j < 4; ++j) a += F.conv_w[j * 1024 + cc] * Xs[(tt + j) * 128 + i];
            XC[tt * 129 + i] = a; }
        __syncthreads();
#pragma unroll
        for (int k = 0; k < 4; ++k) { const int tt = tg * 4 + k; float rp = ba, ip = bx;
            for (int i = 0; i < 128; ++i) { const float xv = XC[tt * 129 + i]; rp += xv * Wa[i * 32 + c]; ip += xv * Wx[i * 32 + c]; }
            const float r = 1.0f / (1.0f + expf(-rp)), ig = 1.0f / (1.0f + expf(-ip));
            const float la = r * Lc;
            AA[tt * 32 + c] = expf(la);
            UU[tt * 32 + c] = sqrtf(-expm1f(2.0f * la)) * (ig * XC[tt * 129 + q * 32 + c]); }
        __syncthreads();
        if (t < 32) { float hh = Hc[t];
            for (int k = 0; k < 64; ++k) { hh = AA[k * 32 + t] * hh + UU[k * 32 + t]; UU[k * 32 + t] = hh; }
            Hc[t] = hh; }
        __syncthreads();
#pragma unroll
        for (int k = 0; k < 4; ++k) { const int id = t + 512 * k, tt = id >> 5, cc = id & 31; const size_t off = (m0 + tt) * 1024 + cb * 128 + q * 32 + cc;
            F.SGL[off] = (bf16)f2bf(bf2f(F.SGL[off]) * UU[tt * 32 + cc]); }
    }
    __syncthreads();
}

__device__ __forceinline__ void gn_gate(Frame& F, const float* RAW) {
    const int gw = F.vcu * NWAVES + F.wave, NGW = F.G * NWAVES;
    for (int m = gw; m < M; m += NGW) {
        const GAS f32x4* xr = (const GAS f32x4*)(RAW + (size_t)m * D) + F.lane;
        GAS v2u* sg = (GAS v2u*)(F.SGR + (size_t)m * D) + F.lane;
#pragma unroll
        for (int j = 0; j < 4; ++j) {
            f32x4 v = xr[64 * j];
            const float mean = wave_sum((v.x + v.y) + (v.z + v.w)) * (1.f / 256.f);
            v = v - mean;
            const float rstd = 1.f / sqrtf(wave_sum((v.x * v.x + v.y * v.y) + (v.z * v.z + v.w * v.w)) * (1.f / 256.f) + LN_EPS);
            const f32x4 g = *((const GAS f32x4*)F.gn_g + F.lane + 64 * j), bb = *((const GAS f32x4*)F.gn_b + F.lane + 64 * j);
            const f32x4 y = v * rstd * g + bb;
            const v2u s = sg[64 * j]; v2u w;
            w.x = pk2(bflo(s.x) * y.x, bfhi(s.x) * y.y); w.y = pk2(bflo(s.y) * y.z, bfhi(s.y) * y.w);
            sg[64 * j] = w;
        }
    }
}

__device__ __forceinline__ void final_ln(Frame& F) {
    const int gw = F.vcu * NWAVES + F.wave, NGW = F.G * NWAVES;
    f32x4 xn[4], yn[4];
    if (gw < M) {
#pragma unroll
        for (int j = 0; j < 4; ++j) { xn[j] = ((const GAS f32x4*)(F.x + (size_t)gw * D) + F.lane)[64 * j]; yn[j] = ((const GAS f32x4*)(F.out + (size_t)gw * D) + F.lane)[64 * j]; } }
    for (int m = gw; m < M; m += NGW) {
        GAS f32x4* yr = (GAS f32x4*)(F.out + (size_t)m * D) + F.lane;
        f32x4 v[4], y[4]; float s = 0.f;
#pragma unroll
        for (int j = 0; j < 4; ++j) { v[j] = xn[j]; y[j] = yn[j]; s += (v[j].x + v[j].y) + (v[j].z + v[j].w); }
        if (m + NGW < M) {
#pragma unroll
            for (int j = 0; j < 4; ++j) { xn[j] = ((const GAS f32x4*)(F.x + (size_t)(m + NGW) * D) + F.lane)[64 * j]; yn[j] = ((const GAS f32x4*)(F.out + (size_t)(m + NGW) * D) + F.lane)[64 * j]; } }
        float mean = wave_sum(s) * (1.f / D); float s2 = 0.f;
#pragma unroll
        for (int j = 0; j < 4; ++j) { v[j] = v[j] - mean; s2 += (v[j].x * v[j].x + v[j].y * v[j].y) + (v[j].z * v[j].z + v[j].w * v[j].w); }
        float rstd = 1.f / sqrtf(wave_sum(s2) * (1.f / D) + LN_EPS);
        s = 0.f;
#pragma unroll
        for (int j = 0; j < 4; ++j) { const f32x4 g = *((const GAS f32x4*)F.ln_in_g + F.lane + 64 * j), bb = *((const GAS f32x4*)F.ln_in_b + F.lane + 64 * j);
            v[j] = (v[j] * rstd * g + bb) * DN_ALPHA + y[j]; s += (v[j].x + v[j].y) + (v[j].z + v[j].w); }
        mean = wave_sum(s) * (1.f / D); s2 = 0.f;
#pragma unroll
        for (int j = 0; j < 4; ++j) { v[j] = v[j] - mean; s2 += (v[j].x * v[j].x + v[j].y * v[j].y) + (v[j].z * v[j].z + v[j].w * v[j].w); }
        rstd = 1.f / sqrtf(wave_sum(s2) * (1.f / D) + LN_EPS);
#pragma unroll
        for (int j = 0; j < 4; ++j) { const f32x4 g = *((const GAS f32x4*)F.ln_out_g + F.lane + 64 * j), bb = *((const GAS f32x4*)F.ln_out_b + F.lane + 64 * j);
            yr[64 * j] = v[j] * rstd * g + bb; }
    }
}

struct Args { const float* in[19]; float* out; unsigned char* ws; int ph_lo, ph_hi, li, pad; };
__global__ void __launch_bounds__(NWAVES * 64, 2) fwd_kernel(Args args) {
    extern __shared__ __attribute__((aligned(16))) unsigned char lds[];
    Frame F;
    F.lds = (LAS unsigned char*)lds;
    F.MISC = (volatile LAS unsigned*)(F.lds + MISC_OFF);
    F.tid = threadIdx.x; F.lane = F.tid & 63; F.wave = __builtin_amdgcn_readfirstlane(F.tid >> 6);
    F.G = gridDim.x; { const int bx = blockIdx.x; F.vcu = (F.G % 8 == 0) ? (bx % 8) * (F.G / 8) + bx / 8 : bx; }
    unsigned char* ws = args.ws;
    F.ctl = (gu32*)(ws + WS_CTL);
    F.x = args.in[0]; F.ln_in_g = args.in[1]; F.ln_in_b = args.in[2]; F.w_in = args.in[3]; F.b_merge = args.in[4]; F.gn_g = args.in[5]; F.gn_b = args.in[6]; F.w_ret = args.in[7];
    F.conv_w = args.in[8]; F.conv_b = args.in[9]; F.w_rg_a = args.in[10]; F.b_rg_a = args.in[11]; F.w_rg_x = args.in[12]; F.b_rg_x = args.in[13]; F.lam = args.in[14]; F.w_lru = args.in[15];
    F.w_out = args.in[16]; F.ln_out_g = args.in[17]; F.ln_out_b = args.in[18]; F.out = args.out;
    F.WinT = (bf16*)(ws + WS_WIN); F.PcatT = (bf16*)(ws + WS_PCAT); F.WoutT = (bf16*)(ws + WS_WOUT); F.rope = (float*)(ws + WS_ROPE);
    F.Q = (bf16*)(ws + WS_Q); F.K = (bf16*)(ws + WS_K); F.V = (bf16*)(ws + WS_V); F.SGR = (bf16*)(ws + WS_ACAT); F.XL = (bf16*)(ws + WS_XL); F.SGL = (bf16*)(ws + WS_ACAT) + 1024;
    F.GR = (bf16*)(ws + WS_GR); F.GL = (bf16*)(ws + WS_GL); F.MERGED = (bf16*)(ws + WS_MERGED); F.XN = (bf16*)args.out;
    for (int u = F.tid; u < (LDS_BYTES - LDSCTL_OFF) / 4; u += NWAVES * 64) ((LAS unsigned*)(F.lds + LDSCTL_OFF))[u] = 0u;
    __syncthreads();
    XcdBarrier bar; bar.bar = (unsigned*)(F.ctl + CW_BAR); bar.x = 0; bar.st = nullptr;
    if (MK_ONE_LAUNCH) bar = xcd_barrier_post((unsigned*)(F.ctl + CW_BAR), F.MISC + 8);
#define GRID_BAR(seam) do { if (!MK_ONE_LAUNCH) { if (F.tid == 0) __hip_atomic_store(F.ctl + CW_TMO, 0xBADBA0u | (unsigned)(seam), RLX_AGENT); } else { xcd_barrier(bar); } } while (0)
    const int lo = args.ph_lo, hi = args.ph_hi;
    unsigned long long pacc = 0;
#define IN(k) (lo <= (k) && (k) < hi)
#define BOTH(k) (IN(k) && IN((k) + 1))
#define NREP(k) ((((PROBE_DUP) >> (k)) & 1) + 1)

    if (IN(0)) { PSEC_B(30) _Pragma("nounroll") for (int rep = 0; rep < NREP(0); ++rep) p0_prologue(F); PSEC_E(30) PSEC_B(40) if (BOTH(0)) GRID_BAR(0); PSEC_E(40) }

    if (IN(1)) {
        PSEC_B(31)
        _Pragma("nounroll") for (int rep = 0; rep < NREP(1); ++rep) {
        pg8::Gemm g{F.XN, F.WinT, M, NIN, D}; pg8::StaticOrder S; S.init(M, NIN, F.G, (int)blockIdx.x);
        pg8::EpiIn E{F.Q, F.K, F.V, F.SGR, F.XL, F.SGL, F.GR, F.GL, F.rope, F.b_merge};
        pg8::gemm_phase<pg8::EpiIn, pg8::StaticOrder, PG8_ALIGN, PG8_SP2>(F.lds + RING_OFF, g, S, E);
        }
        PSEC_E(31) PSEC_B(41)
        if (BOTH(1)) GRID_BAR(1);
        PSEC_E(41)
    }

    if (IN(2)) {
        PSEC_B(32)
        _Pragma("nounroll") for (int rep = 0; rep < NREP(8); ++rep)
        for (int it = F.vcu; it < 256; it += F.G) rt::pass1(F.lds, F.tid, F.wave, it, F.K, F.V, (float*)(ws + WS_SLOC));
        PSEC_E(32) PSEC_B(33)
        _Pragma("nounroll") for (int rep = 0; rep < NREP(2); ++rep)
        for (int it = F.vcu; it < 256; it += F.G) lr::run(F.lds, F.tid, F.wave, it, F.XL, F.SGL, (rep + 1 < NREP(2)) ? (bf16*)F.out : F.SGL, F.conv_w, F.conv_b, F.w_rg_a, F.b_rg_a, F.w_rg_x, F.b_rg_x, F.lam, pacc);
        PSEC_E(33) PSEC_B(42)
        if (BOTH(2)) GRID_BAR(2);
        PSEC_E(42)
    }

    if (IN(3)) {
        PSEC_B(34)
        _Pragma("nounroll") for (int rep = 0; rep < NREP(3); ++rep)
        for (int it = F.vcu; it < 256; it += F.G) rt::pass2(F.lds, F.tid, F.wave, it, F.Q, F.K, F.V, F.SGR, (rep + 1 < NREP(3)) ? (bf16*)F.out : F.SGR, (const float*)(ws + WS_SLOC), F.gn_g, F.gn_b, pacc);
        PSEC_E(34) PSEC_B(43)
        if (BOTH(3)) GRID_BAR(3);
        PSEC_E(43)
    }

    if (IN(4)) {
        PSEC_B(35)
        _Pragma("nounroll") for (int rep = 0; rep < NREP(4); ++rep) {
        pg8::Gemm g{F.SGR, F.PcatT, M, D, 2 * D}; pg8::StaticOrder S; S.init(M, D, F.G, (int)blockIdx.x);
        pg8::EpiMerge2 E{F.MERGED, F.GR, F.GL, D};
        pg8::gemm_phase<pg8::EpiMerge2, pg8::StaticOrder, PG8_ALIGN, PG8_SP2>(F.lds + RING_OFF, g, S, E);
        }
        PSEC_E(35) PSEC_B(44)
        if (BOTH(4)) GRID_BAR(4);
        PSEC_E(44)
    }

    if (IN(5)) {
        PSEC_B(37)
        _Pragma("nounroll") for (int rep = 0; rep < NREP(5); ++rep) {
        pg8::Gemm g{F.MERGED, F.WoutT, M, D, D}; pg8::StaticOrder S; S.init(M, D, F.G, (int)blockIdx.x);
        pg8::EpiF32 E{F.out, D};
        pg8::gemm_phase<pg8::EpiF32, pg8::StaticOrder, PG8_ALIGN, PG8_SP2>(F.lds + RING_OFF, g, S, E);
        }
        PSEC_E(37) PSEC_B(46)
        if (BOTH(5)) GRID_BAR(5);
        PSEC_E(46)
    }

    if (IN(6)) { PSEC_B(38) final_ln(F); PSEC_E(38) }
    if (PROBE_SEC != 0 && blockIdx.x == 0 && F.wave == 0) { const unsigned long long t0 = __builtin_amdgcn_s_memrealtime(); while (__builtin_amdgcn_s_memrealtime() - t0 < pacc) __builtin_amdgcn_s_sleep(8); }
#undef IN
#undef BOTH
}

extern "C" void kernel_launch(void* const* d_in, const int* in_sizes, int n_in, void* d_out, int out_size, void* d_ws, size_t ws_size, hipStream_t stream) {
    static int grid = 0;
    if (grid == 0) {
        if (n_in != 19 || in_sizes[0] != M * D || out_size != M * D || ws_size < WS_END2) { fprintf(stderr, "kernel_launch: unexpected shapes (n_in %d, in0 %d, out %d, ws %zu); nothing launched\n", n_in, n_in > 0 ? in_sizes[0] : -1, out_size, ws_size); grid = -1; return; }
        int dev = 0, cus = 0, per_cu = 0;
        if (hipGetDevice(&dev) != hipSuccess || hipDeviceGetAttribute(&cus, hipDeviceAttributeMultiprocessorCount, dev) != hipSuccess) { grid = -1; return; }
        if (hipFuncSetAttribute((const void*)fwd_kernel, hipFuncAttributeMaxDynamicSharedMemorySize, LDS_BYTES) != hipSuccess) { fprintf(stderr, "kernel_launch: hipFuncSetAttribute failed\n"); grid = -1; return; }
        if (hipOccupancyMaxActiveBlocksPerMultiprocessor(&per_cu, (const void*)fwd_kernel, NWAVES * 64, LDS_BYTES) != hipSuccess || per_cu < 1) { fprintf(stderr, "kernel_launch: occupancy query reports %d\n", per_cu); per_cu = 1; }
        (void)hipGetLastError();
        grid = cus;
    }
    if (grid < 0) return;
    if (hipMemsetAsync((char*)d_ws + WS_CTL, 0, CTL_ZERO_BYTES, stream) != hipSuccess) return;
    Args a{};
    for (int i = 0; i < 19; ++i) a.in[i] = (const float*)d_in[i];
    a.out = (float*)d_out; a.ws = (unsigned char*)d_ws;
    const int nl = MK_ONE_LAUNCH ? 1 : NPHASES;
    for (int li = 0; li < nl; ++li) {
        a.ph_lo = MK_ONE_LAUNCH ? 0 : li; a.ph_hi = MK_ONE_LAUNCH ? NPHASES : li + 1; a.li = li;
        hipLaunchKernelGGL(fwd_kernel, dim3(grid), dim3(NWAVES * 64), LDS_BYTES, stream, a);
        if (hipPeekAtLastError() != hipSuccess) break;
    }
}
```

```cpp
#include <hip/hip_runtime.h>
#include <cstdio>
#include <cstdint>
#ifndef PROBE_SEC
#define PROBE_SEC 0
#endif
#define PSEC_B(k) unsigned long long psec_t0_##k = 0; if (PROBE_SEC == (k)) { __builtin_amdgcn_sched_barrier(0); psec_t0_##k = __builtin_amdgcn_s_memrealtime(); __builtin_amdgcn_sched_barrier(0); }
#define PSEC_E(k) if (PROBE_SEC == (k)) { __builtin_amdgcn_sched_barrier(0); pacc += __builtin_amdgcn_s_memrealtime() - psec_t0_##k; __builtin_amdgcn_sched_barrier(0); }
namespace pg8 {
#define PG8_LAS __attribute__((address_space(3)))
typedef unsigned short bf16_t;
typedef short bf16x8 __attribute__((ext_vector_type(8)));
typedef float f32x4 __attribute__((ext_vector_type(4)));
typedef unsigned u32x4 __attribute__((ext_vector_type(4)));
constexpr int BM = 256, BK = 64, HALF = 128, HTB = HALF * BK * 2  , STAGE_BYTES = 8 * HTB, NXCD = 8, WGM = 8;

__host__ __device__ __forceinline__ int lds_byte(int r, int c) { const int st = (r >> 4) * 2 + (c >> 5), rr = r & 15, cc = c & 31, ob = rr * 64 + cc * 2; return st * 1024 + (ob ^ (((ob >> 9) & 1) << 5)); }
__host__ __device__ __forceinline__ void stage_rc(int b, int& R, int& C) { const int st = b / 1024, sb = b % 1024, swz = sb ^ (((sb >> 9) & 1) << 5); R = (st >> 1) * 16 + swz / 64; C = (st & 1) * 32 + (swz % 64) / 2; }
__host__ __device__ __forceinline__ int perm32(int rho) { const int n = rho >> 4, i = rho & 15; return 8 * (i >> 2) + 4 * n + (i & 3); }

struct Unit { int pm, pn; };
struct Gemm { const bf16_t* A; const bf16_t* Bt; int M, N, K; int lda = 0, ldb = 0; };

struct StaticOrder {
    int nM, nN, nwg, G, c;
    __host__ __device__ void init(int M, int N, int G_, int c_) { nM = M / BM; nN = N / BM; nwg = nM * nN; G = G_; c = c_; }
    __host__ __device__ bool next(int i, Unit& u) const {
        const long L = (long)i * G + c; if (L >= nwg) return false;
        int wgid = (int)L; { const int q = nwg / NXCD, r = nwg % NXCD, xcd = wgid % NXCD, off = wgid / NXCD; wgid = (xcd < r ? xcd * (q + 1) : r * (q + 1) + (xcd - r) * q) + off; }
        const int nig = WGM * nN, gid = wgid / nig, fm = gid * WGM, gsz = (nM - fm) < WGM ? (nM - fm) : WGM;
        u.pm = fm + ((wgid % nig) % gsz); u.pn = (wgid % nig) / gsz; return true;
    }
    __device__ __forceinline__ void a_ready(const Unit&) const {}
    __device__ __forceinline__ void done(const Unit&) const {}
};

__device__ __forceinline__ unsigned cvt_pk_bf16(float lo, float hi) { unsigned r; asm volatile("v_cvt_pk_bf16_f32 %0, %1, %2" : "=v"(r) : "v"(lo), "v"(hi)); return r; }
typedef unsigned u32x2 __attribute__((ext_vector_type(2)));
__device__ __forceinline__ float bf_lo(unsigned w) { return __builtin_bit_cast(float, w << 16); }
__device__ __forceinline__ float bf_hi(unsigned w) { return __builtin_bit_cast(float, w & 0xffff0000u); }
__device__ __forceinline__ float fast_sigmoid(float x) { return __builtin_amdgcn_rcpf(1.0f + __builtin_amdgcn_exp2f(-1.4426950408889634f * x)); }

struct EpiF32 {
    static constexpr bool PERM = false, AFTER_DRAIN = false, MID = false;
    float* C; int ldc;
    __device__ __forceinline__ void operator()(const f32x4 (&acc)[2][2][4][2], const Unit& u, int wr, int wc, int fr, int fq) const {
        const int row0 = u.pm * BM + wr * 64 + fr, col0 = u.pn * BM + wc * 32 + 4 * fq;
#pragma unroll
        for (int ai = 0; ai < 2; ++ai)
#pragma unroll
            for (int m = 0; m < 4; ++m) { float* rowp = C + (size_t)(row0 + ai * HALF + m * 16) * ldc + col0;
#pragma unroll
                for (int bj = 0; bj < 2; ++bj)
#pragma unroll
                    for (int n = 0; n < 2; ++n) *(f32x4*)(rowp + bj * HALF + n * 16) = acc[ai][bj][m][n]; }
    }
};
struct EpiGateF32 {
    static constexpr bool PERM = false, AFTER_DRAIN = false, MID = false;
    float* C; const bf16_t* G; int ldc;
    __device__ __forceinline__ void operator()(const f32x4 (&acc)[2][2][4][2], const Unit& u, int wr, int wc, int fr, int fq) const {
        const int row0 = u.pm * BM + wr * 64 + fr, col0 = u.pn * BM + wc * 32 + 4 * fq;
#pragma unroll
        for (int ai = 0; ai < 2; ++ai)
#pragma unroll
            for (int m = 0; m < 4; ++m) { const size_t off = (size_t)(row0 + ai * HALF + m * 16) * ldc + col0;
#pragma unroll
                for (int bj = 0; bj < 2; ++bj)
#pragma unroll
                    for (int n = 0; n < 2; ++n) { const u32x2 g = *(const u32x2*)(G + off + bj * HALF + n * 16); const f32x4 a = acc[ai][bj][m][n];
                        f32x4 o; o[0] = bf_lo(g.x) * a[0]; o[1] = bf_hi(g.x) * a[1]; o[2] = bf_lo(g.y) * a[2]; o[3] = bf_hi(g.y) * a[3];
                        *(f32x4*)(C + off + bj * HALF + n * 16) = o; } }
    }
};
struct EpiMerge {
    static constexpr bool PERM = true, AFTER_DRAIN = false, MID = false;
    bf16_t* O; const float* T1; const bf16_t* G; int ldc;
    __device__ __forceinline__ void operator()(const f32x4 (&acc)[2][2][4][2], const Unit& u, int wr, int wc, int fr, int fq) const {
        const int row0 = u.pm * BM + wr * 64 + fr, col0 = u.pn * BM + wc * 32 + 8 * fq;
#pragma unroll
        for (int ai = 0; ai < 2; ++ai)
#pragma unroll
            for (int m = 0; m < 4; ++m) { const size_t off = (size_t)(row0 + ai * HALF + m * 16) * ldc + col0;
#pragma unroll
                for (int bj = 0; bj < 2; ++bj) { const u32x4 g = *(const u32x4*)(G + off + bj * HALF);
                    const f32x4 t0 = *(const f32x4*)(T1 + off + bj * HALF), t1 = *(const f32x4*)(T1 + off + bj * HALF + 4);
                    const f32x4 a0 = acc[ai][bj][m][0], a1 = acc[ai][bj][m][1];
                    u32x4 w;
                    w.x = cvt_pk_bf16(t0[0] + bf_lo(g.x) * a0[0], t0[1] + bf_hi(g.x) * a0[1]);
                    w.y = cvt_pk_bf16(t0[2] + bf_lo(g.y) * a0[2], t0[3] + bf_hi(g.y) * a0[3]);
                    w.z = cvt_pk_bf16(t1[0] + bf_lo(g.z) * a1[0], t1[1] + bf_hi(g.z) * a1[1]);
                    w.w = cvt_pk_bf16(t1[2] + bf_lo(g.w) * a1[2], t1[3] + bf_hi(g.w) * a1[3]);
                    *(u32x4*)(O + off + bj * HALF) = w; } }
    }
};
struct EpiBf16Plain {
    static constexpr bool PERM = true, AFTER_DRAIN = false, MID = false;
    bf16_t* O; int ldc;
    __device__ __forceinline__ void operator()(const f32x4 (&acc)[2][2][4][2], const Unit& u, int wr, int wc, int fr, int fq) const {
        const int row0 = u.pm * BM + wr * 64 + fr, col0 = u.pn * BM + wc * 32 + 8 * fq;
#pragma unroll
        for (int ai = 0; ai < 2; ++ai)
#pragma unroll
            for (int m = 0; m < 4; ++m) { bf16_t* rowp = O + (size_t)(row0 + ai * HALF + m * 16) * ldc + col0;
#pragma unroll
                for (int bj = 0; bj < 2; ++bj) { const f32x4 a0 = acc[ai][bj][m][0] + 0.0f, a1 = acc[ai][bj][m][1] + 0.0f;
                    u32x4 w; w.x = cvt_pk_bf16(a0[0], a0[1]); w.y = cvt_pk_bf16(a0[2], a0[3]); w.z = cvt_pk_bf16(a1[0], a1[1]); w.w = cvt_pk_bf16(a1[2], a1[3]);
                    *(u32x4*)(rowp + bj * HALF) = w; } }
    }
};
struct EpiMerge2 {
    static constexpr bool PERM = true, AFTER_DRAIN = false, MID = true;
    bf16_t* O; const bf16_t* GR; const bf16_t* GL; int ldc;
    __device__ __forceinline__ void mid(f32x4 (&acc)[2][2][4][2], const Unit& u, int wr, int wc, int fr_, int fq) const {
        int fr = fr_; asm volatile("" : "+v"(fr));
        const unsigned off0 = (unsigned)((u.pm * BM + wr * 64 + fr) * ldc + u.pn * BM + wc * 32 + 8 * fq) * 2u;
        const char* grb = (const char*)GR; const char* glb = (const char*)GL;
#pragma unroll
        for (int ai = 0; ai < 2; ++ai)
#pragma unroll
            for (int m = 0; m < 4; ++m) {
#pragma unroll
                for (int bj = 0; bj < 2; ++bj) { const unsigned off = off0 + (unsigned)((ai * HALF + m * 16) * ldc + bj * HALF) * 2u;
                    const u32x4 gr = *(const u32x4*)(grb + off), gl = *(const u32x4*)(glb + off);
                    f32x4 r0, r1;
                    r0[0] = bf_lo(gr.x) * __builtin_amdgcn_rcpf(bf_lo(gl.x)); r0[1] = bf_hi(gr.x) * __builtin_amdgcn_rcpf(bf_hi(gl.x));
                    r0[2] = bf_lo(gr.y) * __builtin_amdgcn_rcpf(bf_lo(gl.y)); r0[3] = bf_hi(gr.y) * __builtin_amdgcn_rcpf(bf_hi(gl.y));
                    r1[0] = bf_lo(gr.z) * __builtin_amdgcn_rcpf(bf_lo(gl.z)); r1[1] = bf_hi(gr.z) * __builtin_amdgcn_rcpf(bf_hi(gl.z));
                    r1[2] = bf_lo(gr.w) * __builtin_amdgcn_rcpf(bf_lo(gl.w)); r1[3] = bf_hi(gr.w) * __builtin_amdgcn_rcpf(bf_hi(gl.w));
                    acc[ai][bj][m][0] = acc[ai][bj][m][0] * r0; acc[ai][bj][m][1] = acc[ai][bj][m][1] * r1;
                    asm volatile("" ::: "memory"); } }
    }
    __device__ __forceinline__ void operator()(const f32x4 (&acc)[2][2][4][2], const Unit& u, int wr, int wc, int fr, int fq) const {
        const int row0 = u.pm * BM + wr * 64 + fr, col0 = u.pn * BM + wc * 32 + 8 * fq;
#pragma unroll
        for (int ai = 0; ai < 2; ++ai)
#pragma unroll
            for (int m = 0; m < 4; ++m) { const size_t off = (size_t)(row0 + ai * HALF + m * 16) * ldc + col0;
#pragma unroll
                for (int bj = 0; bj < 2; ++bj) { const u32x4 g = *(const u32x4*)(GL + off + bj * HALF);
                    const f32x4 a0 = acc[ai][bj][m][0], a1 = acc[ai][bj][m][1];
                    u32x4 w;
                    w.x = cvt_pk_bf16(bf_lo(g.x) * a0[0], bf_hi(g.x) * a0[1]); w.y = cvt_pk_bf16(bf_lo(g.y) * a0[2], bf_hi(g.y) * a0[3]);
                    w.z = cvt_pk_bf16(bf_lo(g.z) * a1[0], bf_hi(g.z) * a1[1]); w.w = cvt_pk_bf16(bf_lo(g.w) * a1[2], bf_hi(g.w) * a1[3]);
                    *(u32x4*)(O + off + bj * HALF) = w; } }
    }
};
struct EpiIn {
    static constexpr bool PERM = true, AFTER_DRAIN = false, MID = false;
    bf16_t *Q, *Kb, *V, *SGR, *XL, *SGL, *GR, *GL; const float* rope; const float* bmerge;
    __device__ __forceinline__ void operator()(const f32x4 (&acc)[2][2][4][2], const Unit& u, int wr, int wc, int fr, int fq) const {
        const int row0 = u.pm * BM + wr * 64 + fr; const int pn = u.pn;
        if (pn < 4) {
            bf16_t* base = (pn < 2) ? Q : Kb; const int head = 2 * (pn & 1) + (wc >> 1), i0 = 32 * (wc & 1) + 8 * fq;
#pragma unroll
            for (int ai = 0; ai < 2; ++ai)
#pragma unroll
                for (int m = 0; m < 4; ++m) { const int row = row0 + ai * HALF + m * 16, pos = row & 8191;
                    const f32x4* cs = (const f32x4*)(rope + ((size_t)pos * 64 + i0) * 2);
                    const f32x4 c0 = cs[0], c1 = cs[1], c2 = cs[2], c3 = cs[3];
                    const f32x4 xa = acc[ai][0][m][0], xb = acc[ai][0][m][1], ya = acc[ai][1][m][0], yb = acc[ai][1][m][1];
                    u32x4 o1, o2;
                    o1.x = cvt_pk_bf16(xa[0] * c0[0] - ya[0] * c0[1], xa[1] * c0[2] - ya[1] * c0[3]);
                    o1.y = cvt_pk_bf16(xa[2] * c1[0] - ya[2] * c1[1], xa[3] * c1[2] - ya[3] * c1[3]);
                    o1.z = cvt_pk_bf16(xb[0] * c2[0] - yb[0] * c2[1], xb[1] * c2[2] - yb[1] * c2[3]);
                    o1.w = cvt_pk_bf16(xb[2] * c3[0] - yb[2] * c3[1], xb[3] * c3[2] - yb[3] * c3[3]);
                    o2.x = cvt_pk_bf16(ya[0] * c0[0] + xa[0] * c0[1], ya[1] * c0[2] + xa[1] * c0[3]);
                    o2.y = cvt_pk_bf16(ya[2] * c1[0] + xa[2] * c1[1], ya[3] * c1[2] + xa[3] * c1[3]);
                    o2.z = cvt_pk_bf16(yb[0] * c2[0] + xb[0] * c2[1], yb[1] * c2[2] + xb[1] * c2[3]);
                    o2.w = cvt_pk_bf16(yb[2] * c3[0] + xb[2] * c3[1], yb[3] * c3[2] + xb[3] * c3[3]);
                    bf16_t* rp = base + (size_t)row * 512 + head * 128 + i0;
                    *(u32x4*)rp = o1; *(u32x4*)(rp + 64) = o2; }
        } else {
            const int ty = (pn - 4) >> 2, colt = ((pn - 4) & 3) * BM, col0 = colt + wc * 32 + 8 * fq;
            bf16_t* base = ty == 0 ? V : ty == 1 ? SGR : ty == 2 ? XL : ty == 3 ? SGL : ty == 4 ? GR : GL;
            const int ldo = (ty == 1 || ty == 3) ? 2048 : 1024;
            f32x4 bv[2][2];
#pragma unroll
            for (int bj = 0; bj < 2; ++bj)
#pragma unroll
                for (int n = 0; n < 2; ++n) bv[bj][n] = (ty >= 4) ? *(const f32x4*)(bmerge + (ty - 4) * 1024 + col0 + bj * HALF + 4 * n) : (f32x4){0.f, 0.f, 0.f, 0.f};
#pragma unroll
            for (int ai = 0; ai < 2; ++ai)
#pragma unroll
                for (int m = 0; m < 4; ++m) { bf16_t* rowp = base + (size_t)(row0 + ai * HALF + m * 16) * ldo + col0;
#pragma unroll
                    for (int bj = 0; bj < 2; ++bj) { f32x4 v0 = acc[ai][bj][m][0] + bv[bj][0], v1 = acc[ai][bj][m][1] + bv[bj][1];
                        if (ty == 1 || ty == 3) {
#pragma unroll
                            for (int j = 0; j < 4; ++j) { v0[j] = v0[j] * fast_sigmoid(v0[j]); v1[j] = v1[j] * fast_sigmoid(v1[j]); } }
                        if (ty >= 4) {
#pragma unroll
                            for (int j = 0; j < 4; ++j) { v0[j] = fast_sigmoid(v0[j]); v1[j] = fast_sigmoid(v1[j]); } }
                        u32x4 w; w.x = cvt_pk_bf16(v0[0], v0[1]); w.y = cvt_pk_bf16(v0[2], v0[3]); w.z = cvt_pk_bf16(v1[0], v1[1]); w.w = cvt_pk_bf16(v1[2], v1[3]);
                        *(u32x4*)(rowp + bj * HALF) = w; } }
        }
    }
};

template <class Epi, class Sched, bool ALIGN_EPI = false, bool SP2 = false>
__device__ __forceinline__ void gemm_phase(PG8_LAS unsigned char* lds, const Gemm g, const Sched& S, const Epi& E, unsigned long long& pacc, const int pid) {
    const int tid = threadIdx.x, wid = __builtin_amdgcn_readfirstlane(tid >> 6), lane = tid & 63, wr = wid >> 2, wc = wid & 3, fr = lane & 15, fq = lane >> 4;
    const int K = g.K, nt = K / BK, lda = g.lda ? g.lda : K, ldb = g.ldb ? g.ldb : K;
    unsigned voffA[2], voffB[2];
#pragma unroll
    for (int i = 0; i < 2; ++i) { int R, C; stage_rc(tid * 16 + i * 8192, R, C); const int Rb = Epi::PERM ? ((R & ~31) + perm32(R & 31)) : R;
        voffA[i] = (unsigned)(R * lda + C) * 2u; voffB[i] = (unsigned)(Rb * ldb + C) * 2u; }
    const size_t kstep = (size_t)(BK * 2);
    const size_t hstepA = (size_t)HALF * lda * 2, hstepB = (size_t)HALF * ldb * 2;
    const size_t tstepA = 2 * hstepA, tstepB = 2 * hstepB;
    const unsigned ldsw = (unsigned)wid * 1024u;
    const int aoff = lds_byte(wr * 64 + fr, fq * 8), boff = lds_byte(wc * 32 + fr, fq * 8);
#define PG8_SA(b, h) (((b) * 2 + (h)) * HTB)
#define PG8_SB(b, h) ((4 + (b) * 2 + (h)) * HTB)
#define PG8_STAGE(bufoff, gbase, voff) do { _Pragma("unroll") for (int _i = 0; _i < 2; ++_i) \
        __builtin_amdgcn_global_load_lds((const unsigned*)((const char*)(gbase) + (voff)[_i]), (PG8_LAS unsigned*)(lds + (bufoff) + ldsw + _i * 8192), 16, 0, 0); } while (0)
#define PG8_LDA(dst, b, h) do { _Pragma("unroll") for (int m = 0; m < 4; ++m) _Pragma("unroll") for (int k = 0; k < 2; ++k) dst[m][k] = *(const PG8_LAS bf16x8*)(lds + PG8_SA(b, h) + aoff + m * 2048 + k * 1024); } while (0)
#define PG8_LDB(dst, b, h) do { _Pragma("unroll") for (int n = 0; n < 2; ++n) _Pragma("unroll") for (int k = 0; k < 2; ++k) dst[n][k] = *(const PG8_LAS bf16x8*)(lds + PG8_SB(b, h) + boff + n * 2048 + k * 1024); } while (0)
#define PG8_MMA(ai, bj, At, Bt) do { __builtin_amdgcn_s_setprio(1); _Pragma("unroll") for (int m = 0; m < 4; ++m) _Pragma("unroll") for (int n = 0; n < 2; ++n) _Pragma("unroll") for (int k = 0; k < 2; ++k) \
        acc[ai][bj][m][n] = __builtin_amdgcn_mfma_f32_16x16x32_bf16(Bt[n][k], At[m][k], acc[ai][bj][m][n], 0, 0, 0); __builtin_amdgcn_s_setprio(0); } while (0)
#define PG8_WAIT_V(n) asm volatile("s_waitcnt vmcnt(" #n ")" ::: "memory")
#define PG8_WAIT_L(n) asm volatile("s_waitcnt lgkmcnt(" #n ")" ::: "memory")
#define PG8_BAR __builtin_amdgcn_s_barrier()
#define PG8_SCHED __builtin_amdgcn_sched_barrier(0)
    Unit cur, nxt; int ui = 0;
    if (!S.next(0, cur)) return;
    f32x4 acc[2][2][4][2];
#pragma unroll
    for (int a = 0; a < 2; ++a)
#pragma unroll
        for (int b = 0; b < 2; ++b)
#pragma unroll
            for (int m = 0; m < 4; ++m)
#pragma unroll
                for (int n = 0; n < 2; ++n) acc[a][b][m][n] = (f32x4){0.f, 0.f, 0.f, 0.f};
    bf16x8 At[4][2], B0[2][2], B1[2][2];
    const char* cA = (const char*)g.A + (size_t)cur.pm * tstepA; const char* cB = (const char*)g.Bt + (size_t)cur.pn * tstepB;
    S.a_ready(cur);
    if constexpr (SP2) {
        PG8_STAGE(PG8_SB(0, 0), cB, voffB); PG8_STAGE(PG8_SB(0, 1), cB + hstepB, voffB); PG8_STAGE(PG8_SA(0, 0), cA, voffA); PG8_STAGE(PG8_SA(0, 1), cA + hstepA, voffA);
        if (wr == 1) PG8_BAR;
        PG8_WAIT_V(2); PG8_BAR;
        PG8_STAGE(PG8_SB(1, 0), cB + kstep, voffB); PG8_STAGE(PG8_SA(1, 0), cA + kstep, voffA); PG8_STAGE(PG8_SB(1, 1), cB + hstepB + kstep, voffB);
        PG8_WAIT_V(6); PG8_BAR;
    } else {
        PG8_STAGE(PG8_SB(0, 0), cB, voffB); PG8_STAGE(PG8_SA(0, 0), cA, voffA); PG8_STAGE(PG8_SB(0, 1), cB + hstepB, voffB); PG8_STAGE(PG8_SA(0, 1), cA + hstepA, voffA);
        if (wr == 1) PG8_BAR;
        PG8_WAIT_V(4); PG8_BAR;
        PG8_STAGE(PG8_SB(1, 0), cB + kstep, voffB); PG8_STAGE(PG8_SA(1, 0), cA + kstep, voffA); PG8_STAGE(PG8_SB(1, 1), cB + hstepB + kstep, voffB);
        PG8_WAIT_V(6); PG8_BAR;
    }
    for (;;) {
        const bool has_next = S.next(ui + 1, nxt);
        const char* nA = has_next ? (const char*)g.A + (size_t)nxt.pm * tstepA : cA; const char* nB = has_next ? (const char*)g.Bt + (size_t)nxt.pn * tstepB : cB;
        for (int t = 0; t < nt; t += 2) {
            const bool last = (t == nt - 2);
            const char* a1 = cA + (size_t)(t + 1) * kstep;
            const char* a2 = last ? nA : cA + (size_t)(t + 2) * kstep; const char* b2 = last ? nB : cB + (size_t)(t + 2) * kstep;
            const char* a3 = a2 + kstep; const char* b3 = b2 + kstep;
            if (last && has_next) S.a_ready(nxt);
            if constexpr (Epi::MID) { if (t == nt / 2) E.mid(acc, cur, wr, wc, fr, fq); }
            if constexpr (SP2) {
            PG8_LDB(B0, 0, 0); PG8_LDB(B1, 0, 1); PG8_SCHED; PG8_LDA(At, 0, 0); PG8_STAGE(PG8_SA(1, 1), a1 + hstepA, voffA);
            PG8_WAIT_V(8); PG8_WAIT_L(0); PG8_BAR; PG8_MMA(0, 0, At, B0); PG8_MMA(0, 1, At, B1); PG8_BAR; PG8_SCHED;
            PG8_LDA(At, 0, 1); PG8_STAGE(PG8_SB(0, 0), b2, voffB); PG8_STAGE(PG8_SB(0, 1), b2 + hstepB, voffB); PG8_STAGE(PG8_SA(0, 0), a2, voffA);
            PG8_WAIT_V(8); PG8_WAIT_L(0); PG8_BAR; PG8_MMA(1, 0, At, B0); PG8_MMA(1, 1, At, B1); PG8_BAR; PG8_SCHED;
            PG8_LDB(B0, 1, 0); PG8_LDB(B1, 1, 1); PG8_SCHED; PG8_LDA(At, 1, 0); PG8_STAGE(PG8_SA(0, 1), a2 + hstepA, voffA);
            PG8_WAIT_V(8); PG8_WAIT_L(0); PG8_BAR; PG8_MMA(0, 0, At, B0); PG8_MMA(0, 1, At, B1); PG8_BAR; PG8_SCHED;
            PG8_LDA(At, 1, 1); PG8_STAGE(PG8_SB(1, 0), b3, voffB); PG8_STAGE(PG8_SB(1, 1), b3 + hstepB, voffB); PG8_STAGE(PG8_SA(1, 0), a3, voffA);
            PG8_WAIT_V(8); PG8_WAIT_L(0); PG8_BAR; PG8_MMA(1, 0, At, B0); PG8_MMA(1, 1, At, B1); PG8_BAR; PG8_SCHED;
            } else {
            PG8_LDB(B0, 0, 0); PG8_SCHED; PG8_LDA(At, 0, 0); PG8_STAGE(PG8_SA(1, 1), a1 + hstepA, voffA);
            PG8_WAIT_L(8); PG8_BAR; PG8_WAIT_L(0); PG8_MMA(0, 0, At, B0); PG8_BAR; PG8_SCHED;
            PG8_LDB(B1, 0, 1); PG8_STAGE(PG8_SB(0, 0), b2, voffB);
            PG8_BAR; PG8_WAIT_L(0); PG8_MMA(0, 1, At, B1); PG8_BAR;
            PG8_LDA(At, 0, 1); PG8_STAGE(PG8_SA(0, 0), a2, voffA);
            PG8_BAR; PG8_WAIT_L(0); PG8_MMA(1, 0, At, B0); PG8_BAR; PG8_SCHED;
            PG8_STAGE(PG8_SB(0, 1), b2 + hstepB, voffB);
            PG8_WAIT_V(6); PG8_BAR; PG8_MMA(1, 1, At, B1); PG8_BAR;
            PG8_LDB(B0, 1, 0); PG8_SCHED; PG8_LDA(At, 1, 0); PG8_STAGE(PG8_SA(0, 1), a2 + hstepA, voffA);
            PG8_WAIT_L(8); PG8_BAR; PG8_WAIT_L(0); PG8_MMA(0, 0, At, B0); PG8_BAR; PG8_SCHED;
            PG8_LDB(B1, 1, 1); PG8_STAGE(PG8_SB(1, 0), b3, voffB);
            PG8_BAR; PG8_WAIT_L(0); PG8_MMA(0, 1, At, B1); PG8_BAR;
            PG8_LDA(At, 1, 1); PG8_STAGE(PG8_SA(1, 0), a3, voffA);
            PG8_BAR; PG8_WAIT_L(0); PG8_MMA(1, 0, At, B0); PG8_BAR; PG8_SCHED;
            PG8_STAGE(PG8_SB(1, 1), b3 + hstepB, voffB);
            PG8_WAIT_V(6); PG8_BAR; PG8_MMA(1, 1, At, B1); PG8_BAR;
            }
        }
        if constexpr (ALIGN_EPI) { if (wr == 0) PG8_BAR; }
        if constexpr (!Epi::AFTER_DRAIN) { unsigned long long pt0 = 0; if (PROBE_SEC == 50 + pid) pt0 = __builtin_amdgcn_s_memrealtime(); E(acc, cur, wr, wc, fr, fq); S.done(cur); if (PROBE_SEC == 50 + pid) pacc += __builtin_amdgcn_s_memrealtime() - pt0; }
        if (!has_next) break;
#pragma unroll
        for (int a = 0; a < 2; ++a)
#pragma unroll
            for (int b = 0; b < 2; ++b)
#pragma unroll
                for (int m = 0; m < 4; ++m)
#pragma unroll
                    for (int n = 0; n < 2; ++n) acc[a][b][m][n] = (f32x4){0.f, 0.f, 0.f, 0.f};
        cur = nxt; cA = nA; cB = nB; ++ui;
        if constexpr (ALIGN_EPI) { if (wr == 1) PG8_BAR; }
    }
    PG8_WAIT_V(0);
    if constexpr (!ALIGN_EPI) { if (wr == 0) PG8_BAR; }
    PG8_BAR;
    if constexpr (Epi::AFTER_DRAIN) { E.fused(acc, cur, wr, wc, fr, fq, lds, wid, lane); S.done(cur); }
#undef PG8_SA
#undef PG8_SB
#undef PG8_STAGE
#undef PG8_LDA
#undef PG8_LDB
#undef PG8_MMA
#undef PG8_WAIT_V
#undef PG8_WAIT_L
#undef PG8_BAR
#undef PG8_SCHED
}
}

#ifndef PG8_SP2
#define PG8_SP2 true
#endif
#ifndef PG8_ALIGN
#define PG8_ALIGN true
#endif

constexpr int NWAVES = 8;
#ifndef MK_ONE_LAUNCH
#define MK_ONE_LAUNCH 1
#endif
constexpr int NPHASES = 7;
#ifndef PROBE_DUP
#define PROBE_DUP 0
#endif


constexpr int BATCH = 8, SEQ = 8192, D = 1024, M = BATCH * SEQ, NIN = 7168;
constexpr int RH = 4, DK = 128, DV = 256, CH = 64, NCH = SEQ / CH;
constexpr float LN_EPS = 1e-5f;
constexpr float DN_ALPHA = 1.189207115002721f;

constexpr size_t MiB = 1u << 20;
constexpr size_t WS_CTL = 0, CTL_ZERO_BYTES = 1 * MiB;
constexpr size_t WS_WIN = 2 * MiB;
constexpr size_t WS_PCAT = 16 * MiB;
constexpr size_t WS_WOUT = 20 * MiB;
constexpr size_t WS_ROPE = 22 * MiB;
constexpr size_t WS_Q = 32 * MiB, WS_K = 96 * MiB, WS_V = 160 * MiB, WS_ACAT = 288 * MiB, WS_XL = 544 * MiB, WS_GR = 672 * MiB, WS_GL = 800 * MiB, WS_END = 928 * MiB;
constexpr size_t WS_SLOC = 928 * MiB, WS_END2 = 960 * MiB;
constexpr size_t WS_MERGED = WS_Q;
constexpr int CW_TMO = 0, CW_CODE = 1, CW_BAR = 4096;

constexpr int RING_OFF = 0, RING_BYTES = 131072;
constexpr int LDSCTL_OFF = 163328, MISC_OFF = LDSCTL_OFF + 320;
constexpr int LDS_BYTES = 163840;
static_assert(MISC_OFF + 128 <= LDS_BYTES, "LDS map");

#define GAS __attribute__((address_space(1)))
#define LAS __attribute__((address_space(3)))
typedef unsigned short bf16;
typedef unsigned v4u __attribute__((ext_vector_type(4)));
typedef unsigned v2u __attribute__((ext_vector_type(2)));
typedef float f32x4 __attribute__((ext_vector_type(4)));
typedef GAS unsigned gu32;
#define RLX_AGENT __ATOMIC_RELAXED, __HIP_MEMORY_SCOPE_AGENT
#define LDS_WAIT() asm volatile("s_waitcnt lgkmcnt(0)" ::: "memory")
#define VM_WAIT() asm volatile("s_waitcnt vmcnt(0)" ::: "memory")
__device__ __forceinline__ unsigned f2bf(float f) { unsigned u = __builtin_bit_cast(unsigned, f); return (u + 0x7fffu + ((u >> 16) & 1u)) >> 16; }
__device__ __forceinline__ unsigned pk2(float lo, float hi) { return f2bf(lo) | (f2bf(hi) << 16); }
__device__ __forceinline__ float bflo(unsigned w) { return __builtin_bit_cast(float, w << 16); }
__device__ __forceinline__ float bfhi(unsigned w) { return __builtin_bit_cast(float, w & 0xffff0000u); }
__device__ __forceinline__ float bf2f(bf16 b) { return __builtin_bit_cast(float, ((unsigned)b) << 16); }

#define XB_TMO      128
#define XB_XCNT(j)  (256  + 64 * (j))
#define XB_XSUB(j)  (1280 + 64 * (j))
#define XB_XGEN(j)  (2304 + 64 * (j))
#define XB_TOP      3328
#define XB_TOPGEN   3392
#define XCD_BAR_WORDS 3456
#define XB_SPIN_CAP (1u << 18)

__device__ __forceinline__ unsigned xb_ld(unsigned* p)              { return __hip_atomic_load(p, __ATOMIC_RELAXED, __HIP_MEMORY_SCOPE_AGENT); }
__device__ __forceinline__ unsigned xb_add(unsigned* p, unsigned v) { return __hip_atomic_fetch_add(p, v, __ATOMIC_RELAXED, __HIP_MEMORY_SCOPE_AGENT); }
__device__ __forceinline__ unsigned xb_xcc_id() { return (unsigned)__builtin_amdgcn_s_getreg((3 << 11) | 20) & 0xFu; }
#define XB_SPIN(cond, bar) do { unsigned _sp = 0; while (cond) { __builtin_amdgcn_s_sleep(1); \
    if ((++_sp & 255u) == 0u) { if (xb_ld(&(bar)[XB_TMO])) break; if (_sp > XB_SPIN_CAP) { atomicAdd(&(bar)[XB_TMO], 1u); break; } } } } while (0)

struct XcdBarrier {
    unsigned* bar; unsigned x;
    volatile LAS unsigned* st;
};

__device__ __forceinline__ XcdBarrier xcd_barrier_post(unsigned* bar, volatile LAS unsigned* st) {
    XcdBarrier b; b.bar = bar; b.x = xb_xcc_id(); b.st = st;
    if (threadIdx.x == 0) (void)xb_add(&bar[XB_XCNT(b.x)], 1u);
    return b;
}
__device__ __forceinline__ void xcd_barrier_complete(unsigned* bar, unsigned x, unsigned& nloc, unsigned& nx) {
    const unsigned G = gridDim.x * gridDim.y * gridDim.z;
    unsigned sum, cnt, mine, sp = 0u;
    for (;;) {
        sum = 0u; cnt = 0u; mine = 0u;
#pragma unroll
        for (unsigned j = 0; j < 16; ++j) { const unsigned c = xb_ld(&bar[XB_XCNT(j)]); sum += c; cnt += (c > 0u) ? 1u : 0u; mine = (j == x) ? c : mine; }
        if (sum == G) break;
        __builtin_amdgcn_s_sleep(1);
        if ((++sp & 255u) == 0u) { if (xb_ld(&bar[XB_TMO])) break; if (sp > XB_SPIN_CAP) { atomicAdd(&bar[XB_TMO], 1u); break; } }
    }
    nloc = mine > 0u ? mine : 1u; nx = cnt > 0u ? cnt : 1u;
}

__device__ __forceinline__ void xcd_barrier(const XcdBarrier& b) {
    asm volatile("s_waitcnt vmcnt(0)" ::: "memory");
    __syncthreads();
    if (threadIdx.x == 0) {
        unsigned* bar = b.bar;
        __builtin_amdgcn_s_waitcnt(0);
        unsigned nloc = b.st[0], nx = b.st[1];
        if (nloc == 0u) { xcd_barrier_complete(bar, b.x, nloc, nx); b.st[0] = nloc; b.st[1] = nx; }
        const unsigned old = xb_add(&bar[XB_XSUB(b.x)], 1u);
        const unsigned gen = old / nloc;
        if (old + 1u == (gen + 1u) * nloc) {
            __builtin_amdgcn_fence(__ATOMIC_RELEASE, "agent");
            asm volatile("s_waitcnt vmcnt(0)" ::: "memory");
            const unsigned og = xb_add(&bar[XB_TOP], 1u);
            const unsigned tg = og / nx;
            if (og + 1u == (tg + 1u) * nx) xb_add(&bar[XB_TOPGEN], 1u);
            else XB_SPIN(xb_ld(&bar[XB_TOPGEN]) == tg, bar);
            __builtin_amdgcn_fence(__ATOMIC_ACQUIRE, "agent");
            xb_add(&bar[XB_XGEN(b.x)], 1u);
            asm volatile("s_waitcnt vmcnt(0)" ::: "memory");
        } else {
            XB_SPIN(xb_ld(&bar[XB_XGEN(b.x)]) == gen, bar);
            __builtin_amdgcn_fence(__ATOMIC_ACQUIRE, "agent");
            asm volatile("s_waitcnt vmcnt(0)" ::: "memory");
        }
    }
    __syncthreads();
}


namespace rt {
#define RT_DI __device__ __forceinline__
typedef short bf16x8 __attribute__((ext_vector_type(8)));
typedef short s16x4 __attribute__((ext_vector_type(4)));
typedef short v4i16_t __attribute__((ext_vector_type(4)));
typedef float f32x16 __attribute__((ext_vector_type(16)));
typedef float f32x2_t __attribute__((ext_vector_type(2)));
typedef __bf16 bf16x2_t __attribute__((ext_vector_type(2)));
typedef LAS const char* lds_cptr;
constexpr int NSEG = 8, CPS = NCH / NSEG;
constexpr int L_QT = 0, L_KT = 16384, L_VT = 32768, L_PT = 65536, L_ST = 73728, L_GB = 77824;
RT_DI unsigned cvtpk(float lo, float hi) { f32x2_t v = {lo, hi}; bf16x2_t b = __builtin_convertvector(v, bf16x2_t); return __builtin_bit_cast(unsigned, b); }
RT_DI unsigned off_b(unsigned row, unsigned ch) { return 256u * row + 16u * (ch ^ (((row & 3u) << 2) | ((row >> 2) & 3u))); }
RT_DI unsigned off_p(unsigned row, unsigned ch) { return 128u * row + 16u * (ch ^ ((row >> 1) & 7u)); }
RT_DI s16x4 trd(lds_cptr p) { return __builtin_bit_cast(s16x4, __builtin_amdgcn_ds_read_tr16_b64_v4i16((LAS v4i16_t*)p)); }
RT_DI bf16x8 tr8(lds_cptr tile, unsigned lane, unsigned c, unsigned ks) {
    const unsigned hh = lane >> 5, blk = (lane >> 4) & 1u, q = (lane & 15u) >> 2, p = lane & 3u;
    const s16x4 lo = trd(tile + off_b(16 * ks + 8 * hh + q, 4 * c + 2 * blk + (p >> 1)) + 8 * (p & 1u));
    const s16x4 hi = trd(tile + off_b(16 * ks + 8 * hh + 4 + q, 4 * c + 2 * blk + (p >> 1)) + 8 * (p & 1u));
    return __builtin_shufflevector(lo, hi, 0, 1, 2, 3, 4, 5, 6, 7);
}
RT_DI bf16x8 scale_frag(bf16x8 v, const float (&f)[8]) {
    const v4u w = __builtin_bit_cast(v4u, v); v4u o;
    o.x = cvtpk(bflo(w.x) * f[0], bfhi(w.x) * f[1]); o.y = cvtpk(bflo(w.y) * f[2], bfhi(w.y) * f[3]);
    o.z = cvtpk(bflo(w.z) * f[4], bfhi(w.z) * f[5]); o.w = cvtpk(bflo(w.w) * f[6], bfhi(w.w) * f[7]);
    return __builtin_bit_cast(bf16x8, o);
}
RT_DI bf16x8 pack8(const f32x16& x, int s) {
    v4u o; o.x = cvtpk(x[8 * s], x[8 * s + 1]); o.y = cvtpk(x[8 * s + 2], x[8 * s + 3]); o.z = cvtpk(x[8 * s + 4], x[8 * s + 5]); o.w = cvtpk(x[8 * s + 6], x[8 * s + 7]);
    return __builtin_bit_cast(bf16x8, o);
}
#define RT_MFMA32(a, b, c) __builtin_amdgcn_mfma_f32_32x32x16_bf16((a), (b), (c), 0, 0, 0)
#define RT_MFMA16(a, b, c) __builtin_amdgcn_mfma_f32_16x16x32_bf16((a), (b), (c), 0, 0, 0)

struct Stage { v4u q[2], k[2], v[4]; };
template <bool WITH_Q>
RT_DI void stage_load(Stage& st, const bf16* Q, const bf16* K, const bf16* V, size_t m0, int h, int t) {
    const char* qb = (const char*)(Q + m0 * 512 + h * 128); const char* kb = (const char*)(K + m0 * 512 + h * 128); const char* vb = (const char*)(V + m0 * 1024 + h * 256);
#pragma unroll
    for (int k = 0; k < 2; ++k) { const int id = t + 512 * k, row = id >> 4, ch = id & 15; const unsigned off = (unsigned)(row * 512 + ch * 8) * 2u;
        if (WITH_Q) st.q[k] = *(const GAS v4u*)(qb + off);
        st.k[k] = *(const GAS v4u*)(kb + off); }
#pragma unroll
    for (int k = 0; k < 4; ++k) { const int id = t + 512 * k, row = id >> 5, c32 = id & 31; const unsigned off = (unsigned)(row * 1024 + c32 * 8) * 2u;
        st.v[k] = *(const GAS v4u*)(vb + off); }
}
template <bool WITH_Q>
RT_DI void stage_write(const Stage& st, LAS unsigned char* lds, int t) {
#pragma unroll
    for (int k = 0; k < 2; ++k) { const int id = t + 512 * k, row = id >> 4, ch = id & 15;
        if (WITH_Q) *(LAS v4u*)(lds + L_QT + off_b(row, ch)) = st.q[k];
        *(LAS v4u*)(lds + L_KT + off_b(row, ch)) = st.k[k]; }
#pragma unroll
    for (int k = 0; k < 4; ++k) { const int id = t + 512 * k, row = id >> 5, c32 = id & 31;
        *(LAS v4u*)(lds + L_VT + (c32 >> 4) * 16384 + off_b(row, c32 & 15)) = st.v[k]; }
}
RT_DI void kv_update(f32x16 (&S)[4], const bf16x8 (&vf)[4], lds_cptr KT, unsigned lane, float cdec, const float (&wj)[8], const float (&fk)[4]) {
#pragma unroll
    for (int dt = 0; dt < 4; ++dt) S[dt] = S[dt] * cdec;
#pragma unroll
    for (int ks = 0; ks < 4; ++ks) {
        float f[8];
#pragma unroll
        for (int jj = 0; jj < 8; ++jj) f[jj] = wj[jj] * fk[ks];
        const bf16x8 vs = scale_frag(vf[ks], f);
#pragma unroll
        for (int dt = 0; dt < 4; ++dt) { const bf16x8 kf = tr8(KT, lane, dt, ks); S[dt] = RT_MFMA32(kf, vs, S[dt]); }
    }
}
RT_DI int crow(int reg, int hh) { return (reg & 3) + 8 * (reg >> 2) + 4 * hh; }

RT_DI void pass1(LAS unsigned char* lds, int tid, int wave, int item, const bf16* K, const bf16* V, float* SLOC) {
    const int chain = item >> 3, seg = item & 7, b = chain >> 2, h = chain & 3;
    if (seg == NSEG - 1) return;
    const unsigned lane = tid & 63, r = lane & 31, hh = lane >> 5;
    const float lg = log1pf(-exp2f(-5.f - (float)h));
    const float cdec = expf(lg * 64.f);
    float wj[8], fk[4];
#pragma unroll
    for (int jj = 0; jj < 8; ++jj) wj[jj] = expf(lg * (float)(7 - jj));
#pragma unroll
    for (int ks = 0; ks < 4; ++ks) fk[ks] = expf(lg * (float)(56 - 16 * ks - 8 * (int)hh));
    f32x16 S[4];
#pragma unroll
    for (int dt = 0; dt < 4; ++dt)
#pragma unroll
        for (int i = 0; i < 16; ++i) S[dt][i] = 0.f;
    lds_cptr KT = (lds_cptr)(lds + L_KT), VT = (lds_cptr)(lds + L_VT + (wave >> 2) * 16384);
    Stage st;
    const size_t mseg = (size_t)b * SEQ + (size_t)seg * CPS * CH;
    stage_load<false>(st, nullptr, K, V, mseg, h, tid);
    for (int c = 0; c < CPS; ++c) {
        __syncthreads();
        stage_write<false>(st, lds, tid);
        __syncthreads();
        if (c + 1 < CPS) stage_load<false>(st, nullptr, K, V, mseg + (size_t)(c + 1) * CH, h, tid);
        bf16x8 vf[4];
#pragma unroll
        for (int ks = 0; ks < 4; ++ks) vf[ks] = tr8(VT, lane, wave & 3, ks);
        kv_update(S, vf, KT, lane, cdec, wj, fk);
    }
    float* dst = SLOC + (size_t)item * (128 * 256) + wave * 4096 + lane;
#pragma unroll
    for (int dt = 0; dt < 4; ++dt)
#pragma unroll
        for (int i = 0; i < 16; ++i) dst[(dt * 16 + i) * 64] = S[dt][i];
}

RT_DI void pass2(LAS unsigned char* lds, int tid_, int wave, int item, const bf16* Q, const bf16* K, const bf16* V, const bf16* SGR, bf16* DST, const float* SLOC, const float* gn_g, const float* gn_b, unsigned long long& pacc) {
    const int chain = item >> 3, seg = item & 7, b = chain >> 2, h = chain & 3;
    const unsigned lane_ = tid_ & 63; const int tid = tid_;
    float cdec, lg2; const int it16 = wave >> 1, jt0 = 2 * (wave & 1);
    f32x16 S[4];
    {
    const unsigned lane = lane_;
    const float lg = log1pf(-exp2f(-5.f - (float)h));
    cdec = expf(lg * 64.f); lg2 = lg * 1.4426950408889634f;
#pragma unroll
    for (int dt = 0; dt < 4; ++dt)
#pragma unroll
        for (int i = 0; i < 16; ++i) S[dt][i] = 0.f;
    {
        const float sdec = expf(lg * (float)(CPS * CH));
        for (int g = 0; g < seg; ++g) { const float* src = SLOC + (size_t)(chain * NSEG + g) * (128 * 256) + wave * 4096 + lane;
#pragma unroll
            for (int dt = 0; dt < 4; ++dt)
#pragma unroll
                for (int i = 0; i < 16; ++i) S[dt][i] = S[dt][i] * sdec + src[(dt * 16 + i) * 64]; }
    }
    }
    __syncthreads();
    for (int i = tid; i < 512; i += 512) ((LAS float*)(lds + L_GB))[i] = (i < 256) ? gn_g[h * 256 + i] : gn_b[h * 256 + i - 256];
    lds_cptr QT = (lds_cptr)(lds + L_QT), KT = (lds_cptr)(lds + L_KT), VT = (lds_cptr)(lds + L_VT + (wave >> 2) * 16384), PT = (lds_cptr)(lds + L_PT);
    Stage st;
    const size_t mseg = (size_t)b * SEQ + (size_t)seg * CPS * CH;
    stage_load<true>(st, Q, K, V, mseg, h, tid);
    for (int c = 0; c < CPS; ++c) {
        const size_t m0 = mseg + (size_t)c * CH;
        int tid = tid_; asm volatile("" : "+v"(tid));
        const unsigned lane = tid & 63, r = lane & 31, hh = lane >> 5, fr = lane & 15, fq = lane >> 4;
        float wj[8], fk[4], pdec[2][4];
#pragma unroll
        for (int jj = 0; jj < 8; ++jj) wj[jj] = __builtin_amdgcn_exp2f(lg2 * (float)(7 - jj));
#pragma unroll
        for (int ks = 0; ks < 4; ++ks) fk[ks] = __builtin_amdgcn_exp2f(lg2 * (float)(56 - 16 * ks - 8 * (int)hh));
        const float qd0 = __builtin_amdgcn_exp2f(lg2 * (float)(r + 1)), qd1 = __builtin_amdgcn_exp2f(lg2 * (float)(r + 33));
#pragma unroll
        for (int tt = 0; tt < 2; ++tt)
#pragma unroll
            for (int e = 0; e < 4; ++e) { const int i = 16 * it16 + (int)fr, j = 16 * (jt0 + tt) + 4 * (int)fq + e; pdec[tt][e] = __builtin_amdgcn_exp2f(lg2 * (float)(i > j ? i - j : j - i)); }
        PSEC_B(11) stage_write<true>(st, lds, tid);
        __syncthreads();
        PSEC_E(11) PSEC_B(12)
        {
            f32x4 p[2] = {(f32x4){0.f, 0.f, 0.f, 0.f}, (f32x4){0.f, 0.f, 0.f, 0.f}};
#pragma unroll
            for (int s = 0; s < 4; ++s) {
                const bf16x8 qf = *(const LAS bf16x8*)(QT + off_b(fr + 16 * it16, 4 * s + fq));
#pragma unroll
                for (int tt = 0; tt < 2; ++tt) { const bf16x8 kf = *(const LAS bf16x8*)(KT + off_b(fr + 16 * (jt0 + tt), 4 * s + fq)); p[tt] = RT_MFMA16(kf, qf, p[tt]); }
            }
#pragma unroll
            for (int tt = 0; tt < 2; ++tt) { v2u w; w.x = cvtpk(p[tt][0] * pdec[tt][0], p[tt][1] * pdec[tt][1]); w.y = cvtpk(p[tt][2] * pdec[tt][2], p[tt][3] * pdec[tt][3]);
                *(LAS v2u*)(lds + L_PT + off_p(16 * it16 + fr, 2 * (jt0 + tt) + (fq >> 1)) + 8 * (fq & 1)) = w; }
        }
        __syncthreads();
        PSEC_E(12) PSEC_B(13)
        f32x16 z[2];
#pragma unroll
        for (int it = 0; it < 2; ++it)
#pragma unroll
            for (int i = 0; i < 16; ++i) z[it][i] = 0.f;
#pragma unroll
        for (int dt = 0; dt < 4; ++dt)
#pragma unroll
            for (int s = 0; s < 2; ++s) {
                const bf16x8 xs = pack8(S[dt], s);
#pragma unroll
                for (int it = 0; it < 2; ++it) {
                    const s16x4 lo = *(const LAS s16x4*)(QT + off_b(32 * it + r, 4 * dt + 2 * s) + 8 * hh);
                    const s16x4 hi = *(const LAS s16x4*)(QT + off_b(32 * it + r, 4 * dt + 2 * s + 1) + 8 * hh);
                    const bf16x8 qb = __builtin_shufflevector(lo, hi, 0, 1, 2, 3, 4, 5, 6, 7);
                    z[it] = RT_MFMA32(xs, qb, z[it]);
                }
            }
        z[0] = z[0] * qd0; z[1] = z[1] * qd1;
        PSEC_E(13) PSEC_B(14)
        bf16x8 vf[4];
#pragma unroll
        for (int ks = 0; ks < 4; ++ks) vf[ks] = tr8(VT, lane, wave & 3, ks);
#pragma unroll
        for (int ks = 0; ks < 4; ++ks)
#pragma unroll
            for (int it = 0; it < 2; ++it) { const bf16x8 pf = *(const LAS bf16x8*)(PT + off_p(32 * it + r, 2 * ks + hh)); z[it] = RT_MFMA32(vf[ks], pf, z[it]); }
        PSEC_E(14) PSEC_B(15)
        kv_update(S, vf, KT, lane, cdec, wj, fk);
        PSEC_E(15) PSEC_B(16)
        if (c + 1 < CPS) stage_load<true>(st, Q, K, V, m0 + CH, h, tid);
        const size_t ooff = (m0 + r) * 2048 + h * 256 + 32 * wave + 4 * hh; const bf16* srow0 = SGR + ooff; bf16* orow0 = DST + ooff;
        v2u sg[2][4];
#pragma unroll
        for (int it = 0; it < 2; ++it)
#pragma unroll
            for (int g4 = 0; g4 < 4; ++g4) sg[it][g4] = *(const GAS v2u*)(srow0 + (size_t)it * 32 * 2048 + 8 * g4);
        typedef float f2 __attribute__((ext_vector_type(2)));
#pragma unroll
        for (int it = 0; it < 2; ++it) {
            float s1 = 0.f;
#pragma unroll
            for (int i = 0; i < 16; ++i) s1 += z[it][i];
            s1 += __shfl_xor(s1, 32);
            const float mw = s1 * (1.f / 32.f); float m2 = 0.f;
#pragma unroll
            for (int i = 0; i < 16; ++i) { const float d = z[it][i] - mw; m2 += d * d; }
            m2 += __shfl_xor(m2, 32);
            if (hh == 0) *(LAS f2*)(lds + L_ST + ((32 * it + r) * 8 + wave) * 8) = (f2){mw, m2};
        }
        __syncthreads();
        PSEC_E(16) PSEC_B(17)
#pragma unroll
        for (int it = 0; it < 2; ++it) {
            const LAS f32x4* sp = (const LAS f32x4*)(lds + L_ST + (32 * it + r) * 64);
            const f32x4 a0 = sp[0], a1 = sp[1], a2 = sp[2], a3 = sp[3];
            const float mean = ((a0[0] + a0[2]) + (a1[0] + a1[2]) + (a2[0] + a2[2]) + (a3[0] + a3[2])) * 0.125f;
            float q = (a0[1] + a0[3]) + (a1[1] + a1[3]) + (a2[1] + a2[3]) + (a3[1] + a3[3]);
            { const float d0 = a0[0] - mean, d1 = a0[2] - mean, d2 = a1[0] - mean, d3 = a1[2] - mean, d4 = a2[0] - mean, d5 = a2[2] - mean, d6 = a3[0] - mean, d7 = a3[2] - mean;
              q += 32.f * ((d0 * d0 + d1 * d1) + (d2 * d2 + d3 * d3) + (d4 * d4 + d5 * d5) + (d6 * d6 + d7 * d7)); }
            const float rstd = 1.f / sqrtf(q * (1.f / 256.f) + LN_EPS);
#pragma unroll
            for (int g4 = 0; g4 < 4; ++g4) {
                const f32x4 gg = *(const LAS f32x4*)(lds + L_GB + (32 * wave + 8 * g4 + 4 * hh) * 4), bb = *(const LAS f32x4*)(lds + L_GB + 1024 + (32 * wave + 8 * g4 + 4 * hh) * 4);
                const float y0 = (z[it][4 * g4 + 0] - mean) * rstd * gg[0] + bb[0], y1 = (z[it][4 * g4 + 1] - mean) * rstd * gg[1] + bb[1];
                const float y2 = (z[it][4 * g4 + 2] - mean) * rstd * gg[2] + bb[2], y3 = (z[it][4 * g4 + 3] - mean) * rstd * gg[3] + bb[3];
                v2u w; w.x = cvtpk(bflo(sg[it][g4].x) * y0, bfhi(sg[it][g4].x) * y1); w.y = cvtpk(bflo(sg[it][g4].y) * y2, bfhi(sg[it][g4].y) * y3);
                *(GAS v2u*)(orow0 + (size_t)it * 32 * 2048 + 8 * g4) = w;
            }
        }
        PSEC_E(17)
    }
    __syncthreads();
}
#undef RT_MFMA32
#undef RT_MFMA16
#undef RT_DI
}


namespace lr {
#define LR_DI __device__ __forceinline__
typedef short bf16x8 __attribute__((ext_vector_type(8)));
typedef float f32x16 __attribute__((ext_vector_type(16)));
constexpr int TOK = 256, NIT = SEQ / TOK;
constexpr int L_WT = 0, L_AG = 16384, L_BIAS = L_AG + 4096, L_CWT = L_BIAS + 256, L_WV = L_CWT + 2560, WV_XW = 0, WV_XCF = 9216, WV_SGT = WV_XCF + 4096, WV_BYTES = WV_SGT + 2048, L_END = L_WV + 8 * WV_BYTES;
static_assert(L_END <= LDSCTL_OFF && (L_WV % 16) == 0, "LRU LDS map");
struct XStage { v4u v[9]; };
LR_DI void x_load(XStage& st, const bf16* XL, int b, int cb, int tw, int lane) {
    const char* base = (const char*)(XL + ((size_t)b * SEQ + tw) * 1024 + cb * 128) - 3 * 2048;
    const int rmin = (tw == 0) ? 3 : 0;
#pragma unroll
    for (int k = 0; k < 9; ++k) { int id = lane + 64 * k; id = id < 35 * 16 ? id : 35 * 16 - 1; const int R = id >> 4, ch = id & 15, Rl = R < rmin ? rmin : R;
        const v4u v = *(const GAS v4u*)(base + (unsigned)(Rl * 2048 + ch * 16));
        st.v[k] = (R < rmin) ? (v4u){0u, 0u, 0u, 0u} : v; }
}
LR_DI void x_write(const XStage& st, LAS unsigned char* xw, int lane) {
#pragma unroll
    for (int k = 0; k < 9; ++k) { const int id = lane + 64 * k, R = id >> 4, ch = id & 15;
        if (id < 35 * 16) *(LAS v4u*)(xw + R * 256 + 16 * (ch ^ (R & 15))) = st.v[k]; }
}
LR_DI void run(LAS unsigned char* lds, int tid_, int wave, int item, const bf16* XL, const bf16* SGL, bf16* DST, const float* conv_w, const float* conv_b,
               const float* w_a, const float* b_a, const float* w_x, const float* b_x, const float* lam, unsigned long long& pacc) {
    const int b = item >> 5, cb = (item >> 2) & 7, q = item & 3;
    float bias_r, bias_i, Lc2, Lcn2;
    _Pragma("nounroll") for (int rep = 0; rep < ((((PROBE_DUP) >> 9) & 1) + 1); ++rep)
    {
        const int tid = tid_;
        __syncthreads();
#pragma unroll
        for (int i = 0; i < 2; ++i) { const int id = tid + 512 * i, gate = id >> 9, ch = (id >> 5) & 15, n = id & 31;
            const float* W = (gate ? w_x : w_a) + ((size_t)cb * 128 + 8 * ch) * 128 + q * 32 + n; float v[8];
#pragma unroll
            for (int e = 0; e < 8; ++e) v[e] = W[e * 128];
            v4u o; o.x = rt::cvtpk(v[0], v[1]); o.y = rt::cvtpk(v[2], v[3]); o.z = rt::cvtpk(v[4], v[5]); o.w = rt::cvtpk(v[6], v[7]);
            *(LAS v4u*)(lds + L_WT + gate * 8192 + rt::off_b(n, ch)) = o; }
        if (tid < 64) ((LAS float*)(lds + L_BIAS))[tid] = ((tid >> 5) ? b_x : b_a)[cb * 128 + q * 32 + (tid & 31)];
        if (tid < 272) ((LAS unsigned*)(lds + L_AG))[tid < 256 ? tid : 256 + (tid - 256)] = 0u;
        for (int i = tid; i < 16 * 5 * 8; i += 512) { const int ch = i / 40, j = (i % 40) >> 3, e = i & 7; const int c = cb * 128 + 8 * ch + e;
            ((LAS float*)(lds + L_CWT))[i] = (j < 4) ? conv_w[j * 1024 + c] : conv_b[c]; }
        __syncthreads();
        const int r = tid & 31, chn = cb * 128 + q * 32 + r;
        bias_r = ((LAS float*)(lds + L_BIAS))[r]; bias_i = ((LAS float*)(lds + L_BIAS))[32 + r];
        const float Lc = -8.0f * log1pf(expf(-lam[chn]));
        Lc2 = Lc * 1.4426950408889634f; Lcn2 = 2.0f * Lc;
    }
    XStage st;
    x_load(st, XL, b, cb, 32 * wave, tid_ & 63);
#pragma unroll 1
    for (int it = 0; it < NIT; ++it) {
        const int t0 = it * TOK;
        int tid = tid_; asm volatile("" : "+v"(tid));
        const unsigned lane = tid & 63, r = lane & 31, hh = lane >> 5;
        LAS unsigned char* wv = lds + L_WV + wave * WV_BYTES;
        PSEC_B(1)
        x_write(st, wv + WV_XW, lane);
        const size_t orow0 = ((size_t)b * SEQ + t0 + 32 * wave) * 2048 + cb * 128 + q * 32;
        v4u sgv[2];
#pragma unroll
        for (int k = 0; k < 2; ++k) { const int id = lane + 64 * k; sgv[k] = *(const GAS v4u*)(SGL + orow0 + (size_t)(id >> 2) * 2048 + (id & 3) * 8); }
        if (it + 1 < NIT) x_load(st, XL, b, cb, t0 + TOK + 32 * wave, lane);
        PSEC_E(1) PSEC_B(2)
        {
            const unsigned ch = lane & 15;
            v4u raw[2][7];
#pragma unroll
            for (int k = 0; k < 2; ++k)
#pragma unroll
                for (int d = 0; d < 7; ++d) { const unsigned R = 4 * ((lane >> 4) + 4 * k) + d; raw[k][d] = *(const LAS v4u*)(wv + WV_XW + R * 256 + 16 * (ch ^ (R & 15))); }
            f32x4 cwv[5][2];
#pragma unroll
            for (int j = 0; j < 5; ++j) { cwv[j][0] = *(const LAS f32x4*)(lds + L_CWT + (ch * 40 + j * 8) * 4); cwv[j][1] = *(const LAS f32x4*)(lds + L_CWT + (ch * 40 + j * 8 + 4) * 4); }
            asm volatile("s_waitcnt lgkmcnt(0)" ::: "memory");
#pragma unroll
            for (int k = 0; k < 2; ++k) {
                const unsigned T = 4 * ((lane >> 4) + 4 * k);
#pragma unroll
                for (int e4 = 0; e4 < 4; ++e4) { float o[8];
#pragma unroll
                    for (int e = 0; e < 8; ++e) { const int hv = e >> 2, c4 = e & 3; float s = cwv[4][hv][c4];
#pragma unroll
                        for (int j = 0; j < 4; ++j) { const v4u w = raw[k][e4 + j]; const unsigned dw = (e >> 1) == 0 ? w.x : (e >> 1) == 1 ? w.y : (e >> 1) == 2 ? w.z : w.w;
                            s += cwv[j][hv][c4] * ((e & 1) ? bfhi(dw) : bflo(dw)); }
                        o[e] = s; }
                    v4u co; co.x = rt::cvtpk(o[0], o[1]); co.y = rt::cvtpk(o[2], o[3]); co.z = rt::cvtpk(o[4], o[5]); co.w = rt::cvtpk(o[6], o[7]);
                    const unsigned R = T + e4;
                    *(LAS v4u*)(wv + WV_XW + R * 256 + 16 * (ch ^ (R & 15))) = co;
                    if ((ch >> 2) == (unsigned)q) {
                        LAS float* xf = (LAS float*)(wv + WV_XCF) + R * 32 + (ch & 3) * 8;
                        *(LAS f32x4*)xf = (f32x4){o[0], o[1], o[2], o[3]}; *(LAS f32x4*)(xf + 4) = (f32x4){o[4], o[5], o[6], o[7]}; }
                }
            }
        }
#pragma unroll
        for (int k = 0; k < 2; ++k) { const int id = lane + 64 * k; *(LAS v4u*)(wv + WV_SGT + id * 16) = sgv[k]; }
        PSEC_E(2) PSEC_B(3)
        f32x16 ar, ai;
#pragma unroll
        for (int i = 0; i < 16; ++i) { ar[i] = bias_r; ai[i] = bias_i; }
#pragma unroll
        for (int ks = 0; ks < 8; ++ks) {
            const bf16x8 xa = *(const LAS bf16x8*)(wv + WV_XW + r * 256 + 16 * ((2 * ks + hh) ^ (r & 15)));
            const bf16x8 wa = *(const LAS bf16x8*)(lds + L_WT + rt::off_b(r, 2 * ks + hh));
            const bf16x8 wx = *(const LAS bf16x8*)(lds + L_WT + 8192 + rt::off_b(r, 2 * ks + hh));
            ar = __builtin_amdgcn_mfma_f32_32x32x16_bf16(xa, wa, ar, 0, 0, 0);
            ai = __builtin_amdgcn_mfma_f32_32x32x16_bf16(xa, wx, ai, 0, 0, 0);
        }
        PSEC_E(3) PSEC_B(4)
        float a[16], u[16];
#pragma unroll
        for (int i = 0; i < 16; ++i) {
            const float xc = ((const LAS float*)(wv + WV_XCF))[((i & 3) + 8 * (i >> 2) + 4 * hh) * 32 + r];
            const float rg = __builtin_amdgcn_rcpf(1.0f + __builtin_amdgcn_exp2f(-1.4426950408889634f * ar[i]));
            const float ig = __builtin_amdgcn_rcpf(1.0f + __builtin_amdgcn_exp2f(-1.4426950408889634f * ai[i]));
            const float av = __builtin_amdgcn_exp2f(rg * Lc2);
            const float y = rg * Lcn2;
            const float s_small = -y * (1.0f + y * (0.5f + y * (0.16666667f + y * 0.041666668f)));
            const float s_big = 1.0f - av * av;
            const float s = (y > -0.25f) ? s_small : s_big;
            a[i] = av; u[i] = __builtin_amdgcn_sqrtf(s) * (ig * xc);
        }
        PSEC_E(4) PSEC_B(5)
        float Ag[4], Hg[4], Ap[4], Hp[4];
#pragma unroll
        for (int g = 0; g < 4; ++g) { Ag[g] = (a[4 * g] * a[4 * g + 1]) * (a[4 * g + 2] * a[4 * g + 3]);
            Hg[g] = ((u[4 * g] * a[4 * g + 1] + u[4 * g + 1]) * a[4 * g + 2] + u[4 * g + 2]) * a[4 * g + 3] + u[4 * g + 3];
            Ap[g] = __shfl_xor(Ag[g], 32); Hp[g] = __shfl_xor(Hg[g], 32); }
        float Ac = 1.0f, Hc = 0.0f, Ab[4], Hb[4];
#pragma unroll
        for (int g = 0; g < 4; ++g) {
            const float A1 = hh ? Ap[g] : Ag[g], H1 = hh ? Hp[g] : Hg[g], A2 = hh ? Ag[g] : Ap[g], H2 = hh ? Hg[g] : Hp[g];
            const float Hc1 = A1 * Hc + H1, Ac1 = Ac * A1;
            Ab[g] = hh ? Ac1 : Ac; Hb[g] = hh ? Hc1 : Hc;
            Hc = A2 * Hc1 + H2; Ac = Ac1 * A2;
        }
        float cin;
        {
            const int pw = (wave + 7) & 7; const unsigned need = (wave == 0) ? (unsigned)it : (unsigned)(it + 1);
            volatile LAS unsigned* fl = (volatile LAS unsigned*)(lds + L_AG + 1024);
            unsigned spins = 0;
            while (fl[pw] < need) { __builtin_amdgcn_s_sleep(1); if (++spins > (1u << 22)) break; }
            asm volatile("" ::: "memory");
            cin = ((volatile LAS float*)(lds + L_AG))[pw * 32 + r];
            const float cout = Ac * cin + Hc;
            if (hh == 0) ((volatile LAS float*)(lds + L_AG))[wave * 32 + r] = cout;
            asm volatile("s_waitcnt lgkmcnt(0)" ::: "memory");
            if (lane == 0) fl[wave] = (unsigned)(it + 1);
        }
        PSEC_E(5) PSEC_B(6)
        LAS bf16* slab = (LAS bf16*)(wv + WV_SGT);
#pragma unroll
        for (int g = 0; g < 4; ++g) { float h = Hb[g] + Ab[g] * cin;
#pragma unroll
            for (int e = 0; e < 4; ++e) { const int i = 4 * g + e; h = a[i] * h + u[i];
                LAS bf16* p = slab + ((i & 3) + 8 * (i >> 2) + 4 * hh) * 32 + r;
                *p = (bf16)(rt::cvtpk(bf2f(*p) * h, 0.f) & 0xffffu); } }
#pragma unroll
        for (int k = 0; k < 2; ++k) { const int id = lane + 64 * k; const v4u v = *(const LAS v4u*)(wv + WV_SGT + id * 16);
            *(GAS v4u*)(DST + orow0 + (size_t)(id >> 2) * 2048 + (id & 3) * 8) = v; }
        PSEC_E(6)
    }
    __syncthreads();
}
#undef LR_DI
}

struct Frame {
    LAS unsigned char* lds;
    volatile LAS unsigned* MISC;
    gu32* ctl;
    int tid, lane, wave;
    int vcu, G;
    const float* x; float* out;
    const float *ln_in_g, *ln_in_b, *w_in, *b_merge, *gn_g, *gn_b, *w_ret, *conv_w, *conv_b, *w_rg_a, *b_rg_a, *w_rg_x, *b_rg_x, *lam, *w_lru, *w_out, *ln_out_g, *ln_out_b;
    bf16 *WinT, *PcatT, *WoutT; float* rope;
    bf16 *Q, *K, *V, *SGR, *XL, *SGL, *GR, *GL, *MERGED, *XN;
};

__device__ __forceinline__ float wave_sum(float v) {
#pragma unroll
    for (int o = 1; o < 64; o <<= 1) v += __shfl_xor(v, o);
    return v;
}
__device__ __forceinline__ int win_dest_row(int c) {
    if (c >= 1024) return c;
    const int blk = c >> 9, cc = c & 511, head = cc >> 7, idx = cc & 127, bj = idx >> 6, i = idx & 63;
    return blk * 512 + (head >> 1) * 256 + 128 * bj + (head & 1) * 64 + i;
}
template <bool WIN>
__device__ __forceinline__ void p0_transpose_item(const float* W, int ldw, bf16* WT, int ldt, int koff, LAS float* scr, int k0, int n0, int lane) {
#pragma unroll 8
    for (int i = 0; i < 32; ++i) { const int kk = 2 * i + (lane >> 5); scr[kk * 33 + (lane & 31)] = W[(size_t)(k0 + kk) * ldw + n0 + (lane & 31)]; }
    LDS_WAIT(); asm volatile("" ::: "memory");
    const int c = lane & 7;
#pragma unroll
    for (int j = 0; j < 4; ++j) { const int n = (lane >> 3) + 8 * j; const LAS float* s = scr + (8 * c) * 33 + n;
        const int col = n0 + n; const int drow = WIN ? win_dest_row(col) : col;
        const float sc = (WIN && col >= 512 && col < 1024) ? 0.08838834764831845f : 1.0f;
        v4u o; o.x = pk2(s[0 * 33] * sc, s[1 * 33] * sc); o.y = pk2(s[2 * 33] * sc, s[3 * 33] * sc); o.z = pk2(s[4 * 33] * sc, s[5 * 33] * sc); o.w = pk2(s[6 * 33] * sc, s[7 * 33] * sc);
        *(GAS v4u*)(WT + (size_t)drow * ldt + koff + k0 + 8 * c) = o; }
    LDS_WAIT(); asm volatile("" ::: "memory");
}
__device__ __forceinline__ void p0_prologue(Frame& F) {
    LAS float* scr = (LAS float*)(F.lds + RING_OFF + F.wave * 16384);
    const int gw = F.vcu * NWAVES + F.wave, NGW = F.G * NWAVES;
    constexpr int I_IN = (D / 64) * (NIN / 32), I_SQ = (D / 64) * (D / 32);
    constexpr int NITEMS = I_IN + 3 * I_SQ;
    for (int it = gw; it < NITEMS; it += NGW) {
        int r = it;
        if (r < I_IN) { const int nblk = NIN / 32; p0_transpose_item<true>(F.w_in, NIN, F.WinT, D, 0, scr, 64 * (r / nblk), 32 * (r % nblk), F.lane); continue; } r -= I_IN;
        const int nblk = D / 32, k0 = 64 * ((r % I_SQ) / nblk), n0 = 32 * ((r % I_SQ) % nblk);
        if (r < I_SQ) { p0_transpose_item<false>(F.w_ret, D, F.PcatT, 2 * D, 0, scr, k0, n0, F.lane); continue; }
        if (r < 2 * I_SQ) { p0_transpose_item<false>(F.w_lru, D, F.PcatT, 2 * D, D, scr, k0, n0, F.lane); continue; }
        p0_transpose_item<false>(F.w_out, D, F.WoutT, D, 0, scr, k0, n0, F.lane);
    }
    for (int e = (F.vcu * NWAVES * 64) + F.tid; e < SEQ * 64; e += F.G * NWAVES * 64) {
        const int pos = e >> 6, i = e & 63;
        const double inv = exp(-(double)i * (9.210340371976184 / 64.0));
        const double ang = (double)pos * inv;
        const double n = rint(ang * 0.15915494309189535);
        double r = fma(-n, 6.283185307179586, ang); r = fma(-n, 2.4492935982947064e-16, r);
        const float rf = (float)r;
        typedef float f32x2 __attribute__((ext_vector_type(2)));
        f32x2 cs; cs.x = cosf(rf); cs.y = sinf(rf);
        *(GAS f32x2*)((GAS float*)F.rope + (size_t)e * 2) = cs;
    }
    f32x4 gv[4], bv[4];
#pragma unroll
    for (int j = 0; j < 4; ++j) { gv[j] = *((const GAS f32x4*)F.ln_in_g + F.lane + 64 * j); bv[j] = *((const GAS f32x4*)F.ln_in_b + F.lane + 64 * j); }
    f32x4 vn[4];
    if (gw < M) {
#pragma unroll
        for (int j = 0; j < 4; ++j) vn[j] = ((const GAS f32x4*)(F.x + (size_t)gw * D) + F.lane)[64 * j]; }
    for (int m = gw; m < M; m += NGW) {
        f32x4 v[4]; float s = 0.f;
#pragma unroll
        for (int j = 0; j < 4; ++j) { v[j] = vn[j]; s += (v[j].x + v[j].y) + (v[j].z + v[j].w); }
        if (m + NGW < M) {
#pragma unroll
            for (int j = 0; j < 4; ++j) vn[j] = ((const GAS f32x4*)(F.x + (size_t)(m + NGW) * D) + F.lane)[64 * j]; }
        const float mean = wave_sum(s) * (1.f / D); float s2 = 0.f;
#pragma unroll
        for (int j = 0; j < 4; ++j) { v[j] = v[j] - mean; s2 += (v[j].x * v[j].x + v[j].y * v[j].y) + (v[j].z * v[j].z + v[j].w * v[j].w); }
        const float rstd = 1.f / sqrtf(wave_sum(s2) * (1.f / D) + LN_EPS);
        GAS v2u* o8 = (GAS v2u*)(F.XN + (size_t)m * D) + F.lane;
#pragma unroll
        for (int j = 0; j < 4; ++j) { const f32x4 y = v[j] * rstd * gv[j] + bv[j]; v2u w; w.x = pk2(y.x, y.y); w.y = pk2(y.z, y.w); o8[64 * j] = w; }
    }
}

__device__ __forceinline__ void ret_simple(Frame& F, int item, float* RAW) {
    const int b = item >> 5, h = (item >> 3) & 3, es = item & 7, t = F.tid;
    LAS float* Qs = (LAS float*)(F.lds);
    LAS float* Ks = Qs + 64 * 129;
    LAS float* Vs = Ks + 64 * 129;
    LAS float* Ps = Vs + 64 * 32;
    LAS float* Ss = Ps + 64 * 65;
    const float lg = log1pf(-exp2f(-5.f - (float)h));
    for (int i = t; i < 128 * 32; i += 512) Ss[i] = 0.f;
    const float cdec = expf(lg * 64.f);
    for (int c = 0; c < NCH; ++c) {
        const size_t m0 = (size_t)b * SEQ + (size_t)c * CH;
        __syncthreads();
#pragma unroll
        for (int k = 0; k < 2; ++k) { const int id = t + 512 * k, row = id >> 4, c8 = id & 15;
            const v4u q = *(const GAS v4u*)(F.Q + (m0 + row) * 512 + h * 128 + c8 * 8), kk = *(const GAS v4u*)(F.K + (m0 + row) * 512 + h * 128 + c8 * 8);
            LAS float* qd = Qs + row * 129 + c8 * 8; LAS float* kd = Ks + row * 129 + c8 * 8;
            qd[0] = bflo(q.x); qd[1] = bfhi(q.x); qd[2] = bflo(q.y); qd[3] = bfhi(q.y); qd[4] = bflo(q.z); qd[5] = bfhi(q.z); qd[6] = bflo(q.w); qd[7] = bfhi(q.w);
            kd[0] = bflo(kk.x); kd[1] = bfhi(kk.x); kd[2] = bflo(kk.y); kd[3] = bfhi(kk.y); kd[4] = bflo(kk.z); kd[5] = bfhi(kk.z); kd[6] = bflo(kk.w); kd[7] = bfhi(kk.w); }
        if (t < 256) { const int row = t >> 2, c8 = t & 3;
            const v4u v = *(const GAS v4u*)(F.V + (m0 + row) * 1024 + h * 256 + es * 32 + c8 * 8);
            LAS float* vd = Vs + row * 32 + c8 * 8;
            vd[0] = bflo(v.x); vd[1] = bfhi(v.x); vd[2] = bflo(v.y); vd[3] = bfhi(v.y); vd[4] = bflo(v.z); vd[5] = bfhi(v.z); vd[6] = bflo(v.w); vd[7] = bfhi(v.w); }
        __syncthreads();
        {
            const int i = t >> 3, jg = t & 7; float a[8];
#pragma unroll
            for (int jj = 0; jj < 8; ++jj) a[jj] = 0.f;
            for (int d = 0; d < 128; ++d) { const float q = Qs[i * 129 + d];
#pragma unroll
                for (int jj = 0; jj < 8; ++jj) a[jj] += q * Ks[(jg * 8 + jj) * 129 + d]; }
#pragma unroll
            for (int jj = 0; jj < 8; ++jj) { const int j = jg * 8 + jj; const int dd = i > j ? i - j : j - i; Ps[i * 65 + j] = a[jj] * expf(lg * (float)dd); }
        }
        __syncthreads();
        {
            const int e = t & 31, ig = t >> 5;
#pragma unroll
            for (int ii = 0; ii < 4; ++ii) { const int i = ig * 4 + ii; float o1 = 0.f, o2 = 0.f;
                for (int j = 0; j < 64; ++j) o1 += Ps[i * 65 + j] * Vs[j * 32 + e];
                for (int d = 0; d < 128; ++d) o2 += Qs[i * 129 + d] * Ss[d * 32 + e];
                RAW[(m0 + i) * 1024 + h * 256 + es * 32 + e] = o1 + expf(lg * (float)(i + 1)) * o2; }
        }
        __syncthreads();
        {
            const int e = t & 31, dg = t >> 5; float a[8];
#pragma unroll
            for (int dd = 0; dd < 8; ++dd) a[dd] = 0.f;
            for (int j = 0; j < 64; ++j) { const float vd = Vs[j * 32 + e] * expf(lg * (float)(63 - j));
#pragma unroll
                for (int dd = 0; dd < 8; ++dd) a[dd] += Ks[j * 129 + dg * 8 + dd] * vd; }
#pragma unroll
            for (int dd = 0; dd < 8; ++dd) { const int d = dg * 8 + dd; Ss[d * 32 + e] = Ss[d * 32 + e] * cdec + a[dd]; }
        }
    }
    __syncthreads();
}

__device__ __forceinline__ void lru_simple(Frame& F, int item) {
    const int b = item >> 5, cb = (item >> 2) & 7, q = item & 3, t = F.tid;
    LAS float* Xs = (LAS float*)(F.lds);
    LAS float* XC = Xs + 67 * 128;
    LAS float* Wa = XC + 64 * 129;
    LAS float* Wx = Wa + 128 * 32;
    LAS float* AA = Wx + 128 * 32;
    LAS float* UU = AA + 64 * 32;
    LAS float* Hc = UU + 64 * 32;
    __syncthreads();
    for (int i = t; i < 128 * 32; i += 512) { const int r = i >> 5, c = i & 31;
        Wa[i] = F.w_rg_a[((size_t)cb * 128 + r) * 128 + q * 32 + c]; Wx[i] = F.w_rg_x[((size_t)cb * 128 + r) * 128 + q * 32 + c]; }
    if (t < 32) Hc[t] = 0.f;
    const int c = t & 31, tg = t >> 5, ch = cb * 128 + q * 32 + c;
    const float ba = F.b_rg_a[ch], bx = F.b_rg_x[ch];
    const float lamv = F.lam[ch];
    const float Lc = -8.0f * log1pf(expf(-lamv));
    for (int tile = 0; tile < SEQ / 64; ++tile) {
        const int t0 = tile * 64; const size_t m0 = (size_t)b * SEQ + t0;
        __syncthreads();
        for (int id = t; id < 67 * 16; id += 512) { const int r = id >> 4, c8 = id & 15; const int s = t0 - 3 + r;
            v4u v = (v4u){0u, 0u, 0u, 0u};
            if (s >= 0) v = *(const GAS v4u*)(F.XL + ((size_t)b * SEQ + s) * 1024 + cb * 128 + c8 * 8);
            LAS float* xd = Xs + r * 128 + c8 * 8;
            xd[0] = bflo(v.x); xd[1] = bfhi(v.x); xd[2] = bflo(v.y); xd[3] = bfhi(v.y); xd[4] = bflo(v.z); xd[5] = bfhi(v.z); xd[6] = bflo(v.w); xd[7] = bfhi(v.w); }
        __syncthreads();
#pragma unroll 4
        for (int k = 0; k < 16; ++k) { const int id = t + 512 * k, tt = id >> 7, i = id & 127, cc = cb * 128 + i;
            float a = F.conv_b[cc];
#pragma unroll
            for (int j = 0; j < 4; ++j) a += F.conv_w[j * 1024 + cc] * Xs[(tt + j) * 128 + i];
            XC[tt * 129 + i] = a; }
        __syncthreads();
#pragma unroll
        for (int k = 0; k < 4; ++k) { const int tt = tg * 4 + k; float rp = ba, ip = bx;
            for (int i = 0; i < 128; ++i) { const float xv = XC[tt * 129 + i]; rp += xv * Wa[i * 32 + c]; ip += xv * Wx[i * 32 + c]; }
            const float r = 1.0f / (1.0f + expf(-rp)), ig = 1.0f / (1.0f + expf(-ip));
            const float la = r * Lc;
            AA[tt * 32 + c] = expf(la);
            UU[tt * 32 + c] = sqrtf(-expm1f(2.0f * la)) * (ig * XC[tt * 129 + q * 32 + c]); }
        __syncthreads();
        if (t < 32) { float hh = Hc[t];
            for (int k = 0; k < 64; ++k) { hh = AA[k * 32 + t] * hh + UU[k * 32 + t]; UU[k * 32 + t] = hh; }
            Hc[t] = hh; }
        __syncthreads();
#pragma unroll
        for (int k = 0; k < 4; ++k) { const int id = t + 512 * k, tt = id >> 5, cc = id & 31; const size_t off = (m0 + tt) * 1024 + cb * 128 + q * 32 + cc;
            F.SGL[off] = (bf16)f2bf(bf2f(F.SGL[off]) * UU[tt * 32 + cc]); }
    }
    __syncthreads();
}

__device__ __forceinline__ void gn_gate(Frame& F, const float* RAW) {
    const int gw = F.vcu * NWAVES + F.wave, NGW = F.G * NWAVES;
    for (int m = gw; m < M; m += NGW) {
        const GAS f32x4* xr = (const GAS f32x4*)(RAW + (size_t)m * D) + F.lane;
        GAS v2u* sg = (GAS v2u*)(F.SGR + (size_t)m * D) + F.lane;
#pragma unroll
        for (int j = 0; j < 4; ++j) {
            f32x4 v = xr[64 * j];
            const float mean = wave_sum((v.x + v.y) + (v.z + v.w)) * (1.f / 256.f);
            v = v - mean;
            const float rstd = 1.f / sqrtf(wave_sum((v.x * v.x + v.y * v.y) + (v.z * v.z + v.w * v.w)) * (1.f / 256.f) + LN_EPS);
            const f32x4 g = *((const GAS f32x4*)F.gn_g + F.lane + 64 * j), bb = *((const GAS f32x4*)F.gn_b + F.lane + 64 * j);
            const f32x4 y = v * rstd * g + bb;
            const v2u s = sg[64 * j]; v2u w;
            w.x = pk2(bflo(s.x) * y.x, bfhi(s.x) * y.y); w.y = pk2(bflo(s.y) * y.z, bfhi(s.y) * y.w);
            sg[64 * j] = w;
        }
    }
}

__device__ __forceinline__ void final_ln(Frame& F) {
    const int gw = F.vcu * NWAVES + F.wave, NGW = F.G * NWAVES;
    f32x4 xn[4]; v2u yn[4];
    if (gw < M) {
#pragma unroll
        for (int j = 0; j < 4; ++j) { xn[j] = ((const GAS f32x4*)(F.x + (size_t)gw * D) + F.lane)[64 * j]; yn[j] = ((const GAS v2u*)(F.V + (size_t)gw * D) + F.lane)[64 * j]; } }
    for (int m = gw; m < M; m += NGW) {
        GAS f32x4* orow = (GAS f32x4*)(F.out + (size_t)m * D) + F.lane;
        f32x4 v[4], y[4]; float s = 0.f;
#pragma unroll
        for (int j = 0; j < 4; ++j) { v[j] = xn[j]; y[j] = (f32x4){bflo(yn[j].x), bfhi(yn[j].x), bflo(yn[j].y), bfhi(yn[j].y)}; s += (v[j].x + v[j].y) + (v[j].z + v[j].w); }
        if (m + NGW < M) {
#pragma unroll
            for (int j = 0; j < 4; ++j) { xn[j] = ((const GAS f32x4*)(F.x + (size_t)(m + NGW) * D) + F.lane)[64 * j]; yn[j] = ((const GAS v2u*)(F.V + (size_t)(m + NGW) * D) + F.lane)[64 * j]; } }
        float mean = wave_sum(s) * (1.f / D); float s2 = 0.f;
#pragma unroll
        for (int j = 0; j < 4; ++j) { v[j] = v[j] - mean; s2 += (v[j].x * v[j].x + v[j].y * v[j].y) + (v[j].z * v[j].z + v[j].w * v[j].w); }
        float rstd = 1.f / sqrtf(wave_sum(s2) * (1.f / D) + LN_EPS);
        s = 0.f;
#pragma unroll
        for (int j = 0; j < 4; ++j) { const f32x4 g = *((const GAS f32x4*)F.ln_in_g + F.lane + 64 * j), bb = *((const GAS f32x4*)F.ln_in_b + F.lane + 64 * j);
            v[j] = (v[j] * rstd * g + bb) * DN_ALPHA + y[j]; s += (v[j].x + v[j].y) + (v[j].z + v[j].w); }
        mean = wave_sum(s) * (1.f / D); s2 = 0.f;
#pragma unroll
        for (int j = 0; j < 4; ++j) { v[j] = v[j] - mean; s2 += (v[j].x * v[j].x + v[j].y * v[j].y) + (v[j].z * v[j].z + v[j].w * v[j].w); }
        rstd = 1.f / sqrtf(wave_sum(s2) * (1.f / D) + LN_EPS);
#pragma unroll
        for (int j = 0; j < 4; ++j) { const f32x4 g = *((const GAS f32x4*)F.ln_out_g + F.lane + 64 * j), bb = *((const GAS f32x4*)F.ln_out_b + F.lane + 64 * j);
            orow[64 * j] = v[j] * rstd * g + bb; }
    }
}

struct Args { const float* in[19]; float* out; unsigned char* ws; int ph_lo, ph_hi, li, pad; };
__global__ void __launch_bounds__(NWAVES * 64, 2) fwd_kernel(Args args) {
    extern __shared__ __attribute__((aligned(16))) unsigned char lds[];
    Frame F;
    F.lds = (LAS unsigned char*)lds;
    F.MISC = (volatile LAS unsigned*)(F.lds + MISC_OFF);
    F.tid = threadIdx.x; F.lane = F.tid & 63; F.wave = __builtin_amdgcn_readfirstlane(F.tid >> 6);
    F.G = gridDim.x; { const int bx = blockIdx.x; F.vcu = (F.G % 8 == 0) ? (bx % 8) * (F.G / 8) + bx / 8 : bx; }
    unsigned char* ws = args.ws;
    F.ctl = (gu32*)(ws + WS_CTL);
    F.x = args.in[0]; F.ln_in_g = args.in[1]; F.ln_in_b = args.in[2]; F.w_in = args.in[3]; F.b_merge = args.in[4]; F.gn_g = args.in[5]; F.gn_b = args.in[6]; F.w_ret = args.in[7];
    F.conv_w = args.in[8]; F.conv_b = args.in[9]; F.w_rg_a = args.in[10]; F.b_rg_a = args.in[11]; F.w_rg_x = args.in[12]; F.b_rg_x = args.in[13]; F.lam = args.in[14]; F.w_lru = args.in[15];
    F.w_out = args.in[16]; F.ln_out_g = args.in[17]; F.ln_out_b = args.in[18]; F.out = args.out;
    F.WinT = (bf16*)(ws + WS_WIN); F.PcatT = (bf16*)(ws + WS_PCAT); F.WoutT = (bf16*)(ws + WS_WOUT); F.rope = (float*)(ws + WS_ROPE);
    F.Q = (bf16*)(ws + WS_Q); F.K = (bf16*)(ws + WS_K); F.V = (bf16*)(ws + WS_V); F.SGR = (bf16*)(ws + WS_ACAT); F.XL = (bf16*)(ws + WS_XL); F.SGL = (bf16*)(ws + WS_ACAT) + 1024;
    F.GR = (bf16*)(ws + WS_GR); F.GL = (bf16*)(ws + WS_GL); F.MERGED = (bf16*)(ws + WS_MERGED); F.XN = (bf16*)args.out;
    for (int u = F.tid; u < (LDS_BYTES - LDSCTL_OFF) / 4; u += NWAVES * 64) ((LAS unsigned*)(F.lds + LDSCTL_OFF))[u] = 0u;
    __syncthreads();
    XcdBarrier bar; bar.bar = (unsigned*)(F.ctl + CW_BAR); bar.x = 0; bar.st = nullptr;
    if (MK_ONE_LAUNCH) bar = xcd_barrier_post((unsigned*)(F.ctl + CW_BAR), F.MISC + 8);
#define GRID_BAR(seam) do { if (!MK_ONE_LAUNCH) { if (F.tid == 0) __hip_atomic_store(F.ctl + CW_TMO, 0xBADBA0u | (unsigned)(seam), RLX_AGENT); } else { xcd_barrier(bar); } } while (0)
    const int lo = args.ph_lo, hi = args.ph_hi;
    unsigned long long pacc = 0;
#define IN(k) (lo <= (k) && (k) < hi)
#define BOTH(k) (IN(k) && IN((k) + 1))
#define NREP(k) ((((PROBE_DUP) >> (k)) & 1) + 1)

    if (IN(0)) { PSEC_B(30) _Pragma("nounroll") for (int rep = 0; rep < NREP(0); ++rep) p0_prologue(F); PSEC_E(30) PSEC_B(40) if (BOTH(0)) GRID_BAR(0); PSEC_E(40) }

    if (IN(1)) {
        PSEC_B(31)
        _Pragma("nounroll") for (int rep = 0; rep < NREP(1); ++rep) {
        pg8::Gemm g{F.XN, F.WinT, M, NIN, D}; pg8::StaticOrder S; S.init(M, NIN, F.G, (int)blockIdx.x);
        pg8::EpiIn E{F.Q, F.K, F.V, F.SGR, F.XL, F.SGL, F.GR, F.GL, F.rope, F.b_merge};
        pg8::gemm_phase<pg8::EpiIn, pg8::StaticOrder, PG8_ALIGN, PG8_SP2>(F.lds + RING_OFF, g, S, E, pacc, 1);
        }
        PSEC_E(31) PSEC_B(41)
        if (BOTH(1)) GRID_BAR(1);
        PSEC_E(41)
    }

    if (IN(2)) {
        PSEC_B(32)
        _Pragma("nounroll") for (int rep = 0; rep < NREP(8); ++rep)
        for (int it = F.vcu; it < 256; it += F.G) rt::pass1(F.lds, F.tid, F.wave, it, F.K, F.V, (float*)(ws + WS_SLOC));
        PSEC_E(32) PSEC_B(33)
        _Pragma("nounroll") for (int rep = 0; rep < NREP(2); ++rep)
        for (int it = F.vcu; it < 256; it += F.G) lr::run(F.lds, F.tid, F.wave, it, F.XL, F.SGL, (rep + 1 < NREP(2)) ? (bf16*)F.out : F.SGL, F.conv_w, F.conv_b, F.w_rg_a, F.b_rg_a, F.w_rg_x, F.b_rg_x, F.lam, pacc);
        PSEC_E(33) PSEC_B(42)
        if (BOTH(2)) GRID_BAR(2);
        PSEC_E(42)
    }

    if (IN(3)) {
        PSEC_B(34)
        _Pragma("nounroll") for (int rep = 0; rep < NREP(3); ++rep)
        for (int it = F.vcu; it < 256; it += F.G) rt::pass2(F.lds, F.tid, F.wave, it, F.Q, F.K, F.V, F.SGR, (rep + 1 < NREP(3)) ? (bf16*)F.out : F.SGR, (const float*)(ws + WS_SLOC), F.gn_g, F.gn_b, pacc);
        PSEC_E(34) PSEC_B(43)
        if (BOTH(3)) GRID_BAR(3);
        PSEC_E(43)
    }

    if (IN(4)) {
        PSEC_B(35)
        _Pragma("nounroll") for (int rep = 0; rep < NREP(4); ++rep) {
        pg8::Gemm g{F.SGR, F.PcatT, M, D, 2 * D}; pg8::StaticOrder S; S.init(M, D, F.G, (int)blockIdx.x);
        pg8::EpiMerge2 E{F.MERGED, F.GR, F.GL, D};
        pg8::gemm_phase<pg8::EpiMerge2, pg8::StaticOrder, PG8_ALIGN, PG8_SP2>(F.lds + RING_OFF, g, S, E, pacc, 4);
        }
        PSEC_E(35) PSEC_B(44)
        if (BOTH(4)) GRID_BAR(4);
        PSEC_E(44)
    }

    if (IN(5)) {
        PSEC_B(37)
        _Pragma("nounroll") for (int rep = 0; rep < NREP(5); ++rep) {
        pg8::Gemm g{F.MERGED, F.WoutT, M, D, D}; pg8::StaticOrder S; S.init(M, D, F.G, (int)blockIdx.x);
        pg8::EpiBf16Plain E{F.V, D};
        pg8::gemm_phase<pg8::EpiBf16Plain, pg8::StaticOrder, PG8_ALIGN, PG8_SP2>(F.lds + RING_OFF, g, S, E, pacc, 5);
        }
        PSEC_E(37) PSEC_B(46)
        if (BOTH(5)) GRID_BAR(5);
        PSEC_E(46)
    }

    if (IN(6)) { PSEC_B(38) final_ln(F); PSEC_E(38) }
    if (PROBE_SEC != 0 && blockIdx.x == 0 && F.wave == 0) { const unsigned long long t0 = __builtin_amdgcn_s_memrealtime(); while (__builtin_amdgcn_s_memrealtime() - t0 < pacc) __builtin_amdgcn_s_sleep(8); }
#undef IN
#undef BOTH
}

extern "C" void kernel_launch(void* const* d_in, const int* in_sizes, int n_in, void* d_out, int out_size, void* d_ws, size_t ws_size, hipStream_t stream) {
    static int grid = 0;
    if (grid == 0) {
        if (n_in != 19 || in_sizes[0] != M * D || out_size != M * D || ws_size < WS_END2) { fprintf(stderr, "kernel_launch: unexpected shapes (n_in %d, in0 %d, out %d, ws %zu); nothing launched\n", n_in, n_in > 0 ? in_sizes[0] : -1, out_size, ws_size); grid = -1; return; }
        int dev = 0, cus = 0, per_cu = 0;
        if (hipGetDevice(&dev) != hipSuccess || hipDeviceGetAttribute(&cus, hipDeviceAttributeMultiprocessorCount, dev) != hipSuccess) { grid = -1; return; }
        if (hipFuncSetAttribute((const void*)fwd_kernel, hipFuncAttributeMaxDynamicSharedMemorySize, LDS_BYTES) != hipSuccess) { fprintf(stderr, "kernel_launch: hipFuncSetAttribute failed\n"); grid = -1; return; }
        if (hipOccupancyMaxActiveBlocksPerMultiprocessor(&per_cu, (const void*)fwd_kernel, NWAVES * 64, LDS_BYTES) != hipSuccess || per_cu < 1) { fprintf(stderr, "kernel_launch: occupancy query reports %d\n", per_cu); per_cu = 1; }
        (void)hipGetLastError();
        grid = cus;
    }
    if (grid < 0) return;
    if (hipMemsetAsync((char*)d_ws + WS_CTL, 0, CTL_ZERO_BYTES, stream) != hipSuccess) return;
    Args a{};
    for (int i = 0; i < 19; ++i) a.in[i] = (const float*)d_in[i];
    a.out = (float*)d_out; a.ws = (unsigned char*)d_ws;
    const int nl = MK_ONE_LAUNCH ? 1 : NPHASES;
    for (int li = 0; li < nl; ++li) {
        a.ph_lo = MK_ONE_LAUNCH ? 0 : li; a.ph_hi = MK_ONE_LAUNCH ? NPHASES : li + 1; a.li = li;
        hipLaunchKernelGGL(fwd_kernel, dim3(grid), dim3(NWAVES * 64), LDS_BYTES, stream, a);
        if (hipPeekAtLastError() != hipSuccess) break;
    }
}
```

```cpp
#include <hip/hip_runtime.h>
#include <cstdio>
#include <cstdint>
#ifndef PROBE_SEC
#define PROBE_SEC 0
#endif
#define PSEC_B(k) unsigned long long psec_t0_##k = 0; if (PROBE_SEC == (k)) { __builtin_amdgcn_sched_barrier(0); psec_t0_##k = __builtin_amdgcn_s_memrealtime(); __builtin_amdgcn_sched_barrier(0); }
#define PSEC_E(k) if (PROBE_SEC == (k)) { __builtin_amdgcn_sched_barrier(0); pacc += __builtin_amdgcn_s_memrealtime() - psec_t0_##k; __builtin_amdgcn_sched_barrier(0); }
namespace pg8 {
#define PG8_LAS __attribute__((address_space(3)))
typedef unsigned short bf16_t;
typedef short bf16x8 __attribute__((ext_vector_type(8)));
typedef float f32x4 __attribute__((ext_vector_type(4)));
typedef unsigned u32x4 __attribute__((ext_vector_type(4)));
constexpr int BM = 256, BK = 64, HALF = 128, HTB = HALF * BK * 2  , STAGE_BYTES = 8 * HTB, NXCD = 8, WGM = 8;

__host__ __device__ __forceinline__ int lds_byte(int r, int c) { const int st = (r >> 4) * 2 + (c >> 5), rr = r & 15, cc = c & 31, ob = rr * 64 + cc * 2; return st * 1024 + (ob ^ (((ob >> 9) & 1) << 5)); }
__host__ __device__ __forceinline__ void stage_rc(int b, int& R, int& C) { const int st = b / 1024, sb = b % 1024, swz = sb ^ (((sb >> 9) & 1) << 5); R = (st >> 1) * 16 + swz / 64; C = (st & 1) * 32 + (swz % 64) / 2; }
__host__ __device__ __forceinline__ int perm32(int rho) { const int n = rho >> 4, i = rho & 15; return 8 * (i >> 2) + 4 * n + (i & 3); }

struct Unit { int pm, pn; };
struct Gemm { const bf16_t* A; const bf16_t* Bt; int M, N, K; int lda = 0, ldb = 0; };

struct StaticOrder {
    int nM, nN, nwg, G, c;
    __host__ __device__ void init(int M, int N, int G_, int c_) { nM = M / BM; nN = N / BM; nwg = nM * nN; G = G_; c = c_; }
    __host__ __device__ bool next(int i, Unit& u) const {
        const long L = (long)i * G + c; if (L >= nwg) return false;
        int wgid = (int)L; { const int q = nwg / NXCD, r = nwg % NXCD, xcd = wgid % NXCD, off = wgid / NXCD; wgid = (xcd < r ? xcd * (q + 1) : r * (q + 1) + (xcd - r) * q) + off; }
        const int nig = WGM * nN, gid = wgid / nig, fm = gid * WGM, gsz = (nM - fm) < WGM ? (nM - fm) : WGM;
        u.pm = fm + ((wgid % nig) % gsz); u.pn = (wgid % nig) / gsz; return true;
    }
    __device__ __forceinline__ void a_ready(const Unit&) const {}
    __device__ __forceinline__ void done(const Unit&) const {}
};

__device__ __forceinline__ unsigned cvt_pk_bf16(float lo, float hi) { unsigned r; asm volatile("v_cvt_pk_bf16_f32 %0, %1, %2" : "=v"(r) : "v"(lo), "v"(hi)); return r; }
typedef unsigned u32x2 __attribute__((ext_vector_type(2)));
#ifndef EPI_SC1
#define EPI_SC1 0
#endif
__device__ __forceinline__ void st16(void* p, u32x4 v) {
#if EPI_SC1
    asm volatile("global_store_dwordx4 %0, %1, off sc1\n\ts_nop 1" :: "v"(p), "v"(v) : "memory");
#else
    *(u32x4*)p = v;
#endif
}
__device__ __forceinline__ float bf_lo(unsigned w) { return __builtin_bit_cast(float, w << 16); }
__device__ __forceinline__ float bf_hi(unsigned w) { return __builtin_bit_cast(float, w & 0xffff0000u); }
__device__ __forceinline__ float fast_sigmoid(float x) { return __builtin_amdgcn_rcpf(1.0f + __builtin_amdgcn_exp2f(-1.4426950408889634f * x)); }

struct EpiF32 {
    static constexpr bool PERM = false, AFTER_DRAIN = false, MID = false;
    float* C; int ldc;
    __device__ __forceinline__ void operator()(const f32x4 (&acc)[2][2][4][2], const Unit& u, int wr, int wc, int fr, int fq) const {
        const int row0 = u.pm * BM + wr * 64 + fr, col0 = u.pn * BM + wc * 32 + 4 * fq;
#pragma unroll
        for (int ai = 0; ai < 2; ++ai)
#pragma unroll
            for (int m = 0; m < 4; ++m) { float* rowp = C + (size_t)(row0 + ai * HALF + m * 16) * ldc + col0;
#pragma unroll
                for (int bj = 0; bj < 2; ++bj)
#pragma unroll
                    for (int n = 0; n < 2; ++n) *(f32x4*)(rowp + bj * HALF + n * 16) = acc[ai][bj][m][n]; }
    }
};
struct EpiGateF32 {
    static constexpr bool PERM = false, AFTER_DRAIN = false, MID = false;
    float* C; const bf16_t* G; int ldc;
    __device__ __forceinline__ void operator()(const f32x4 (&acc)[2][2][4][2], const Unit& u, int wr, int wc, int fr, int fq) const {
        const int row0 = u.pm * BM + wr * 64 + fr, col0 = u.pn * BM + wc * 32 + 4 * fq;
#pragma unroll
        for (int ai = 0; ai < 2; ++ai)
#pragma unroll
            for (int m = 0; m < 4; ++m) { const size_t off = (size_t)(row0 + ai * HALF + m * 16) * ldc + col0;
#pragma unroll
                for (int bj = 0; bj < 2; ++bj)
#pragma unroll
                    for (int n = 0; n < 2; ++n) { const u32x2 g = *(const u32x2*)(G + off + bj * HALF + n * 16); const f32x4 a = acc[ai][bj][m][n];
                        f32x4 o; o[0] = bf_lo(g.x) * a[0]; o[1] = bf_hi(g.x) * a[1]; o[2] = bf_lo(g.y) * a[2]; o[3] = bf_hi(g.y) * a[3];
                        *(f32x4*)(C + off + bj * HALF + n * 16) = o; } }
    }
};
struct EpiMerge {
    static constexpr bool PERM = true, AFTER_DRAIN = false, MID = false;
    bf16_t* O; const float* T1; const bf16_t* G; int ldc;
    __device__ __forceinline__ void operator()(const f32x4 (&acc)[2][2][4][2], const Unit& u, int wr, int wc, int fr, int fq) const {
        const int row0 = u.pm * BM + wr * 64 + fr, col0 = u.pn * BM + wc * 32 + 8 * fq;
#pragma unroll
        for (int ai = 0; ai < 2; ++ai)
#pragma unroll
            for (int m = 0; m < 4; ++m) { const size_t off = (size_t)(row0 + ai * HALF + m * 16) * ldc + col0;
#pragma unroll
                for (int bj = 0; bj < 2; ++bj) { const u32x4 g = *(const u32x4*)(G + off + bj * HALF);
                    const f32x4 t0 = *(const f32x4*)(T1 + off + bj * HALF), t1 = *(const f32x4*)(T1 + off + bj * HALF + 4);
                    const f32x4 a0 = acc[ai][bj][m][0], a1 = acc[ai][bj][m][1];
                    u32x4 w;
                    w.x = cvt_pk_bf16(t0[0] + bf_lo(g.x) * a0[0], t0[1] + bf_hi(g.x) * a0[1]);
                    w.y = cvt_pk_bf16(t0[2] + bf_lo(g.y) * a0[2], t0[3] + bf_hi(g.y) * a0[3]);
                    w.z = cvt_pk_bf16(t1[0] + bf_lo(g.z) * a1[0], t1[1] + bf_hi(g.z) * a1[1]);
                    w.w = cvt_pk_bf16(t1[2] + bf_lo(g.w) * a1[2], t1[3] + bf_hi(g.w) * a1[3]);
                    *(u32x4*)(O + off + bj * HALF) = w; } }
    }
};
struct EpiBf16Plain {
    static constexpr bool PERM = true, AFTER_DRAIN = false, MID = false;
    bf16_t* O; int ldc;
    __device__ __forceinline__ void operator()(const f32x4 (&acc)[2][2][4][2], const Unit& u, int wr, int wc, int fr, int fq) const {
        const int row0 = u.pm * BM + wr * 64 + fr, col0 = u.pn * BM + wc * 32 + 8 * fq;
#pragma unroll
        for (int ai = 0; ai < 2; ++ai)
#pragma unroll
            for (int m = 0; m < 4; ++m) { bf16_t* rowp = O + (size_t)(row0 + ai * HALF + m * 16) * ldc + col0;
#pragma unroll
                for (int bj = 0; bj < 2; ++bj) { const f32x4 a0 = acc[ai][bj][m][0] + 0.0f, a1 = acc[ai][bj][m][1] + 0.0f;
                    u32x4 w; w.x = cvt_pk_bf16(a0[0], a0[1]); w.y = cvt_pk_bf16(a0[2], a0[3]); w.z = cvt_pk_bf16(a1[0], a1[1]); w.w = cvt_pk_bf16(a1[2], a1[3]);
                    *(u32x4*)(rowp + bj * HALF) = w; } }
    }
};
struct EpiMerge2 {
    static constexpr bool PERM = true, AFTER_DRAIN = false, MID = true;
    bf16_t* O; const bf16_t* GR; const bf16_t* GL; int ldc;
    __device__ __forceinline__ void mid(f32x4 (&acc)[2][2][4][2], const Unit& u, int wr, int wc, int fr_, int fq) const {
        int fr = fr_; asm volatile("" : "+v"(fr));
        const unsigned off0 = (unsigned)((u.pm * BM + wr * 64 + fr) * ldc + u.pn * BM + wc * 32 + 8 * fq) * 2u;
        const char* grb = (const char*)GR;
#pragma unroll
        for (int ai = 0; ai < 2; ++ai)
#pragma unroll
            for (int m = 0; m < 4; ++m) {
#pragma unroll
                for (int bj = 0; bj < 2; ++bj) { const unsigned off = off0 + (unsigned)((ai * HALF + m * 16) * ldc + bj * HALF) * 2u;
                    const u32x4 gr = *(const u32x4*)(grb + off);
                    f32x4 r0, r1;
                    r0[0] = bf_lo(gr.x); r0[1] = bf_hi(gr.x); r0[2] = bf_lo(gr.y); r0[3] = bf_hi(gr.y);
                    r1[0] = bf_lo(gr.z); r1[1] = bf_hi(gr.z); r1[2] = bf_lo(gr.w); r1[3] = bf_hi(gr.w);
                    acc[ai][bj][m][0] = acc[ai][bj][m][0] * r0; acc[ai][bj][m][1] = acc[ai][bj][m][1] * r1;
                    asm volatile("" ::: "memory"); } }
    }
    __device__ __forceinline__ void operator()(const f32x4 (&acc)[2][2][4][2], const Unit& u, int wr, int wc, int fr, int fq) const {
        const int row0 = u.pm * BM + wr * 64 + fr, col0 = u.pn * BM + wc * 32 + 8 * fq;
#pragma unroll
        for (int ai = 0; ai < 2; ++ai)
#pragma unroll
            for (int m = 0; m < 4; ++m) { const size_t off = (size_t)(row0 + ai * HALF + m * 16) * ldc + col0;
#pragma unroll
                for (int bj = 0; bj < 2; ++bj) { const u32x4 g = *(const u32x4*)(GL + off + bj * HALF);
                    const f32x4 a0 = acc[ai][bj][m][0], a1 = acc[ai][bj][m][1];
                    u32x4 w;
                    w.x = cvt_pk_bf16(bf_lo(g.x) * a0[0], bf_hi(g.x) * a0[1]); w.y = cvt_pk_bf16(bf_lo(g.y) * a0[2], bf_hi(g.y) * a0[3]);
                    w.z = cvt_pk_bf16(bf_lo(g.z) * a1[0], bf_hi(g.z) * a1[1]); w.w = cvt_pk_bf16(bf_lo(g.w) * a1[2], bf_hi(g.w) * a1[3]);
                    *(u32x4*)(O + off + bj * HALF) = w; } }
    }
};
template <long D_SGR, long D_XL, long D_SGL>
struct EpiIn {
    static constexpr bool PERM = true, AFTER_DRAIN = false, MID = false;
    bf16_t *Q, *Kb, *V, *GR, *GL; const float* rope; const float* bmerge;
    __device__ __forceinline__ void operator()(const f32x4 (&acc)[2][2][4][2], const Unit& u, int wr, int wc, int fr, int fq) const {
        const int row0 = u.pm * BM + wr * 64 + fr; const int pn = u.pn;
        if (pn < 4) {
            bf16_t* base = (pn < 2) ? Q : Kb; const int head = 2 * (pn & 1) + (wc >> 1), i0 = 32 * (wc & 1) + 8 * fq;
#pragma unroll
            for (int ai = 0; ai < 2; ++ai)
#pragma unroll
                for (int m = 0; m < 4; ++m) { const int row = row0 + ai * HALF + m * 16, pos = row & 8191;
                    const f32x4* cs = (const f32x4*)(rope + ((size_t)pos * 64 + i0) * 2);
                    const f32x4 c0 = cs[0], c1 = cs[1], c2 = cs[2], c3 = cs[3];
                    const f32x4 xa = acc[ai][0][m][0], xb = acc[ai][0][m][1], ya = acc[ai][1][m][0], yb = acc[ai][1][m][1];
                    u32x4 o1, o2;
                    o1.x = cvt_pk_bf16(xa[0] * c0[0] - ya[0] * c0[1], xa[1] * c0[2] - ya[1] * c0[3]);
                    o1.y = cvt_pk_bf16(xa[2] * c1[0] - ya[2] * c1[1], xa[3] * c1[2] - ya[3] * c1[3]);
                    o1.z = cvt_pk_bf16(xb[0] * c2[0] - yb[0] * c2[1], xb[1] * c2[2] - yb[1] * c2[3]);
                    o1.w = cvt_pk_bf16(xb[2] * c3[0] - yb[2] * c3[1], xb[3] * c3[2] - yb[3] * c3[3]);
                    o2.x = cvt_pk_bf16(ya[0] * c0[0] + xa[0] * c0[1], ya[1] * c0[2] + xa[1] * c0[3]);
                    o2.y = cvt_pk_bf16(ya[2] * c1[0] + xa[2] * c1[1], ya[3] * c1[2] + xa[3] * c1[3]);
                    o2.z = cvt_pk_bf16(yb[0] * c2[0] + xb[0] * c2[1], yb[1] * c2[2] + xb[1] * c2[3]);
                    o2.w = cvt_pk_bf16(yb[2] * c3[0] + xb[2] * c3[1], yb[3] * c3[2] + xb[3] * c3[3]);
                    bf16_t* rp = base + (size_t)row * 512 + head * 128 + i0;
                    st16(rp, o1); st16(rp + 64, o2); }
        } else if (pn >= 20) {
            const int col0 = 128 * (pn - 20) + wc * 32 + 8 * fq;
            f32x4 b0v[2], b1v[2];
#pragma unroll
            for (int n = 0; n < 2; ++n) { b0v[n] = *(const f32x4*)(bmerge + col0 + 4 * n); b1v[n] = *(const f32x4*)(bmerge + 1024 + col0 + 4 * n); }
#pragma unroll
            for (int ai = 0; ai < 2; ++ai)
#pragma unroll
                for (int m = 0; m < 4; ++m) { const size_t off = (size_t)(row0 + ai * HALF + m * 16) * 1024 + col0;
                    float rho[8], gl[8];
#pragma unroll
                    for (int n = 0; n < 2; ++n)
#pragma unroll
                        for (int j = 0; j < 4; ++j) { const float mr = acc[ai][0][m][n][j] + b0v[n][j], ml = acc[ai][1][m][n][j] + b1v[n][j];
                            const float el = 1.0f + __builtin_amdgcn_exp2f(-1.4426950408889634f * ml);
                            gl[4 * n + j] = __builtin_amdgcn_rcpf(el); rho[4 * n + j] = fast_sigmoid(mr) * el; }
                    u32x4 w; w.x = cvt_pk_bf16(rho[0], rho[1]); w.y = cvt_pk_bf16(rho[2], rho[3]); w.z = cvt_pk_bf16(rho[4], rho[5]); w.w = cvt_pk_bf16(rho[6], rho[7]);
                    st16(GR + off, w);
                    w.x = cvt_pk_bf16(gl[0], gl[1]); w.y = cvt_pk_bf16(gl[2], gl[3]); w.z = cvt_pk_bf16(gl[4], gl[5]); w.w = cvt_pk_bf16(gl[6], gl[7]);
                    st16(GL + off, w); }
        } else {
            const int ty = (pn - 4) >> 2, colt = ((pn - 4) & 3) * BM, col0 = colt + wc * 32 + 8 * fq;
            bf16_t* base = V + (ty == 1 ? D_SGR : ty == 2 ? D_XL : ty == 3 ? D_SGL : 0L);
            const int ldo = (ty == 1 || ty == 3) ? 2048 : 1024;
#pragma unroll
            for (int ai = 0; ai < 2; ++ai)
#pragma unroll
                for (int m = 0; m < 4; ++m) { bf16_t* rowp = base + (size_t)(row0 + ai * HALF + m * 16) * ldo + col0;
#pragma unroll
                    for (int bj = 0; bj < 2; ++bj) { f32x4 v0 = acc[ai][bj][m][0] + 0.0f, v1 = acc[ai][bj][m][1] + 0.0f;
                        if (ty == 1 || ty == 3) {
#pragma unroll
                            for (int j = 0; j < 4; ++j) { v0[j] = v0[j] * fast_sigmoid(v0[j]); v1[j] = v1[j] * fast_sigmoid(v1[j]); } }
                        u32x4 w; w.x = cvt_pk_bf16(v0[0], v0[1]); w.y = cvt_pk_bf16(v0[2], v0[3]); w.z = cvt_pk_bf16(v1[0], v1[1]); w.w = cvt_pk_bf16(v1[2], v1[3]);
                        st16(rowp + bj * HALF, w); } }
        }
    }
};

template <class Epi, class Sched, bool ALIGN_EPI = false, bool SP2 = false>
__device__ __forceinline__ void gemm_phase(PG8_LAS unsigned char* lds, const Gemm g, const Sched& S, const Epi& E, unsigned long long& pacc, const int pid) {
    const int tid = threadIdx.x, wid = __builtin_amdgcn_readfirstlane(tid >> 6), lane = tid & 63, wr = wid >> 2, wc = wid & 3, fr = lane & 15, fq = lane >> 4;
    const int K = g.K, nt = K / BK, lda = g.lda ? g.lda : K, ldb = g.ldb ? g.ldb : K;
    unsigned voffA[2], voffB[2];
#pragma unroll
    for (int i = 0; i < 2; ++i) { int R, C; stage_rc(tid * 16 + i * 8192, R, C); const int Rb = Epi::PERM ? ((R & ~31) + perm32(R & 31)) : R;
        voffA[i] = (unsigned)(R * lda + C) * 2u; voffB[i] = (unsigned)(Rb * ldb + C) * 2u; }
    const size_t kstep = (size_t)(BK * 2);
    const size_t hstepA = (size_t)HALF * lda * 2, hstepB = (size_t)HALF * ldb * 2;
    const size_t tstepA = 2 * hstepA, tstepB = 2 * hstepB;
    const unsigned ldsw = (unsigned)wid * 1024u;
    const int aoff = lds_byte(wr * 64 + fr, fq * 8), boff = lds_byte(wc * 32 + fr, fq * 8);
#define PG8_SA(b, h) (((b) * 2 + (h)) * HTB)
#define PG8_SB(b, h) ((4 + (b) * 2 + (h)) * HTB)
#define PG8_STAGE(bufoff, gbase, voff) do { _Pragma("unroll") for (int _i = 0; _i < 2; ++_i) \
        __builtin_amdgcn_global_load_lds((const unsigned*)((const char*)(gbase) + (voff)[_i]), (PG8_LAS unsigned*)(lds + (bufoff) + ldsw + _i * 8192), 16, 0, 0); } while (0)
#define PG8_LDA(dst, b, h) do { _Pragma("unroll") for (int m = 0; m < 4; ++m) _Pragma("unroll") for (int k = 0; k < 2; ++k) dst[m][k] = *(const PG8_LAS bf16x8*)(lds + PG8_SA(b, h) + aoff + m * 2048 + k * 1024); } while (0)
#define PG8_LDB(dst, b, h) do { _Pragma("unroll") for (int n = 0; n < 2; ++n) _Pragma("unroll") for (int k = 0; k < 2; ++k) dst[n][k] = *(const PG8_LAS bf16x8*)(lds + PG8_SB(b, h) + boff + n * 2048 + k * 1024); } while (0)
#define PG8_MMA(ai, bj, At, Bt) do { __builtin_amdgcn_s_setprio(1); _Pragma("unroll") for (int m = 0; m < 4; ++m) _Pragma("unroll") for (int n = 0; n < 2; ++n) _Pragma("unroll") for (int k = 0; k < 2; ++k) \
        acc[ai][bj][m][n] = __builtin_amdgcn_mfma_f32_16x16x32_bf16(Bt[n][k], At[m][k], acc[ai][bj][m][n], 0, 0, 0); __builtin_amdgcn_s_setprio(0); } while (0)
#define PG8_WAIT_V(n) asm volatile("s_waitcnt vmcnt(" #n ")" ::: "memory")
#define PG8_WAIT_L(n) asm volatile("s_waitcnt lgkmcnt(" #n ")" ::: "memory")
#define PG8_BAR __builtin_amdgcn_s_barrier()
#define PG8_SCHED __builtin_amdgcn_sched_barrier(0)
    Unit cur, nxt; int ui = 0;
    if (!S.next(0, cur)) return;
    f32x4 acc[2][2][4][2];
#pragma unroll
    for (int a = 0; a < 2; ++a)
#pragma unroll
        for (int b = 0; b < 2; ++b)
#pragma unroll
            for (int m = 0; m < 4; ++m)
#pragma unroll
                for (int n = 0; n < 2; ++n) acc[a][b][m][n] = (f32x4){0.f, 0.f, 0.f, 0.f};
    bf16x8 At[4][2], B0[2][2], B1[2][2];
    const char* cA = (const char*)g.A + (size_t)cur.pm * tstepA; const char* cB = (const char*)g.Bt + (size_t)cur.pn * tstepB;
    S.a_ready(cur);
    if constexpr (SP2) {
        PG8_STAGE(PG8_SB(0, 0), cB, voffB); PG8_STAGE(PG8_SB(0, 1), cB + hstepB, voffB); PG8_STAGE(PG8_SA(0, 0), cA, voffA); PG8_STAGE(PG8_SA(0, 1), cA + hstepA, voffA);
        if (wr == 1) PG8_BAR;
        PG8_WAIT_V(2); PG8_BAR;
        PG8_STAGE(PG8_SB(1, 0), cB + kstep, voffB); PG8_STAGE(PG8_SA(1, 0), cA + kstep, voffA); PG8_STAGE(PG8_SB(1, 1), cB + hstepB + kstep, voffB);
        PG8_WAIT_V(6); PG8_BAR;
    } else {
        PG8_STAGE(PG8_SB(0, 0), cB, voffB); PG8_STAGE(PG8_SA(0, 0), cA, voffA); PG8_STAGE(PG8_SB(0, 1), cB + hstepB, voffB); PG8_STAGE(PG8_SA(0, 1), cA + hstepA, voffA);
        if (wr == 1) PG8_BAR;
        PG8_WAIT_V(4); PG8_BAR;
        PG8_STAGE(PG8_SB(1, 0), cB + kstep, voffB); PG8_STAGE(PG8_SA(1, 0), cA + kstep, voffA); PG8_STAGE(PG8_SB(1, 1), cB + hstepB + kstep, voffB);
        PG8_WAIT_V(6); PG8_BAR;
    }
    for (;;) {
        const bool has_next = S.next(ui + 1, nxt);
        const char* nA = has_next ? (const char*)g.A + (size_t)nxt.pm * tstepA : cA; const char* nB = has_next ? (const char*)g.Bt + (size_t)nxt.pn * tstepB : cB;
        for (int t = 0; t < nt; t += 2) {
            const bool last = (t == nt - 2);
            const char* a1 = cA + (size_t)(t + 1) * kstep;
            const char* a2 = last ? nA : cA + (size_t)(t + 2) * kstep; const char* b2 = last ? nB : cB + (size_t)(t + 2) * kstep;
            const char* a3 = a2 + kstep; const char* b3 = b2 + kstep;
            if (last && has_next) S.a_ready(nxt);
            if constexpr (Epi::MID) { if (t == nt / 2) E.mid(acc, cur, wr, wc, fr, fq); }
            if constexpr (SP2) {
            PG8_LDB(B0, 0, 0); PG8_LDB(B1, 0, 1); PG8_SCHED; PG8_LDA(At, 0, 0); PG8_STAGE(PG8_SA(1, 1), a1 + hstepA, voffA);
            PG8_WAIT_V(8); PG8_WAIT_L(0); PG8_BAR; PG8_MMA(0, 0, At, B0); PG8_MMA(0, 1, At, B1); PG8_BAR; PG8_SCHED;
            PG8_LDA(At, 0, 1); PG8_STAGE(PG8_SB(0, 0), b2, voffB); PG8_STAGE(PG8_SB(0, 1), b2 + hstepB, voffB); PG8_STAGE(PG8_SA(0, 0), a2, voffA);
            PG8_WAIT_V(8); PG8_WAIT_L(0); PG8_BAR; PG8_MMA(1, 0, At, B0); PG8_MMA(1, 1, At, B1); PG8_BAR; PG8_SCHED;
            PG8_LDB(B0, 1, 0); PG8_LDB(B1, 1, 1); PG8_SCHED; PG8_LDA(At, 1, 0); PG8_STAGE(PG8_SA(0, 1), a2 + hstepA, voffA);
            PG8_WAIT_V(8); PG8_WAIT_L(0); PG8_BAR; PG8_MMA(0, 0, At, B0); PG8_MMA(0, 1, At, B1); PG8_BAR; PG8_SCHED;
            PG8_LDA(At, 1, 1); PG8_STAGE(PG8_SB(1, 0), b3, voffB); PG8_STAGE(PG8_SB(1, 1), b3 + hstepB, voffB); PG8_STAGE(PG8_SA(1, 0), a3, voffA);
            PG8_WAIT_V(8); PG8_WAIT_L(0); PG8_BAR; PG8_MMA(1, 0, At, B0); PG8_MMA(1, 1, At, B1); PG8_BAR; PG8_SCHED;
            } else {
            PG8_LDB(B0, 0, 0); PG8_SCHED; PG8_LDA(At, 0, 0); PG8_STAGE(PG8_SA(1, 1), a1 + hstepA, voffA);
            PG8_WAIT_L(8); PG8_BAR; PG8_WAIT_L(0); PG8_MMA(0, 0, At, B0); PG8_BAR; PG8_SCHED;
            PG8_LDB(B1, 0, 1); PG8_STAGE(PG8_SB(0, 0), b2, voffB);
            PG8_BAR; PG8_WAIT_L(0); PG8_MMA(0, 1, At, B1); PG8_BAR;
            PG8_LDA(At, 0, 1); PG8_STAGE(PG8_SA(0, 0), a2, voffA);
            PG8_BAR; PG8_WAIT_L(0); PG8_MMA(1, 0, At, B0); PG8_BAR; PG8_SCHED;
            PG8_STAGE(PG8_SB(0, 1), b2 + hstepB, voffB);
            PG8_WAIT_V(6); PG8_BAR; PG8_MMA(1, 1, At, B1); PG8_BAR;
            PG8_LDB(B0, 1, 0); PG8_SCHED; PG8_LDA(At, 1, 0); PG8_STAGE(PG8_SA(0, 1), a2 + hstepA, voffA);
            PG8_WAIT_L(8); PG8_BAR; PG8_WAIT_L(0); PG8_MMA(0, 0, At, B0); PG8_BAR; PG8_SCHED;
            PG8_LDB(B1, 1, 1); PG8_STAGE(PG8_SB(1, 0), b3, voffB);
            PG8_BAR; PG8_WAIT_L(0); PG8_MMA(0, 1, At, B1); PG8_BAR;
            PG8_LDA(At, 1, 1); PG8_STAGE(PG8_SA(1, 0), a3, voffA);
            PG8_BAR; PG8_WAIT_L(0); PG8_MMA(1, 0, At, B0); PG8_BAR; PG8_SCHED;
            PG8_STAGE(PG8_SB(1, 1), b3 + hstepB, voffB);
            PG8_WAIT_V(6); PG8_BAR; PG8_MMA(1, 1, At, B1); PG8_BAR;
            }
        }
        if constexpr (ALIGN_EPI) { if (wr == 0) PG8_BAR; }
        if constexpr (!Epi::AFTER_DRAIN) { unsigned long long pt0 = 0; if (PROBE_SEC == 50 + pid) pt0 = __builtin_amdgcn_s_memrealtime(); E(acc, cur, wr, wc, fr, fq); S.done(cur); if (PROBE_SEC == 50 + pid) pacc += __builtin_amdgcn_s_memrealtime() - pt0; }
        if (!has_next) break;
#pragma unroll
        for (int a = 0; a < 2; ++a)
#pragma unroll
            for (int b = 0; b < 2; ++b)
#pragma unroll
                for (int m = 0; m < 4; ++m)
#pragma unroll
                    for (int n = 0; n < 2; ++n) acc[a][b][m][n] = (f32x4){0.f, 0.f, 0.f, 0.f};
        cur = nxt; cA = nA; cB = nB; ++ui;
        if constexpr (ALIGN_EPI) { if (wr == 1) PG8_BAR; }
    }
    PG8_WAIT_V(0);
    if constexpr (!ALIGN_EPI) { if (wr == 0) PG8_BAR; }
    PG8_BAR;
    if constexpr (Epi::AFTER_DRAIN) { E.fused(acc, cur, wr, wc, fr, fq, lds, wid, lane); S.done(cur); }
#undef PG8_SA
#undef PG8_SB
#undef PG8_STAGE
#undef PG8_LDA
#undef PG8_LDB
#undef PG8_MMA
#undef PG8_WAIT_V
#undef PG8_WAIT_L
#undef PG8_BAR
#undef PG8_SCHED
}
}

#ifndef PG8_SP2
#define PG8_SP2 true
#endif
#ifndef PG8_ALIGN
#define PG8_ALIGN true
#endif

constexpr int NWAVES = 8;
#ifndef MK_ONE_LAUNCH
#define MK_ONE_LAUNCH 1
#endif
constexpr int NPHASES = 7;
#ifndef PROBE_DUP
#define PROBE_DUP 0
#endif


constexpr int BATCH = 8, SEQ = 8192, D = 1024, M = BATCH * SEQ, NIN = 7168;
constexpr int RH = 4, DK = 128, DV = 256, CH = 64, NCH = SEQ / CH;
constexpr float LN_EPS = 1e-5f;
constexpr float DN_ALPHA = 1.189207115002721f;

constexpr size_t MiB = 1u << 20;
constexpr size_t WS_CTL = 0, CTL_ZERO_BYTES = 65536;
constexpr size_t WS_WIN = 2 * MiB;
constexpr size_t WS_PCAT = 16 * MiB;
constexpr size_t WS_WOUT = 20 * MiB;
constexpr size_t WS_ROPE = 22 * MiB;
constexpr size_t WS_Q = 32 * MiB, WS_K = 96 * MiB, WS_V = 160 * MiB, WS_ACAT = 288 * MiB, WS_XL = 544 * MiB, WS_GR = 672 * MiB, WS_GL = 800 * MiB, WS_END = 928 * MiB;
constexpr size_t WS_SLOC = 928 * MiB, WS_END2 = 960 * MiB;
constexpr size_t WS_MERGED = WS_Q;
constexpr int CW_TMO = 0, CW_CODE = 1, CW_BAR = 4096;

constexpr int RING_OFF = 0, RING_BYTES = 131072;
constexpr int LDSCTL_OFF = 163328, MISC_OFF = LDSCTL_OFF + 320;
constexpr int LDS_BYTES = 163840;
static_assert(MISC_OFF + 128 <= LDS_BYTES, "LDS map");

#define GAS __attribute__((address_space(1)))
#define LAS __attribute__((address_space(3)))
typedef unsigned short bf16;
typedef unsigned v4u __attribute__((ext_vector_type(4)));
typedef unsigned v2u __attribute__((ext_vector_type(2)));
typedef float f32x4 __attribute__((ext_vector_type(4)));
typedef GAS unsigned gu32;
#define RLX_AGENT __ATOMIC_RELAXED, __HIP_MEMORY_SCOPE_AGENT
#define LDS_WAIT() asm volatile("s_waitcnt lgkmcnt(0)" ::: "memory")
#define VM_WAIT() asm volatile("s_waitcnt vmcnt(0)" ::: "memory")
__device__ __forceinline__ unsigned f2bf(float f) { unsigned u = __builtin_bit_cast(unsigned, f); return (u + 0x7fffu + ((u >> 16) & 1u)) >> 16; }
__device__ __forceinline__ unsigned pk2(float lo, float hi) { return f2bf(lo) | (f2bf(hi) << 16); }
__device__ __forceinline__ float bflo(unsigned w) { return __builtin_bit_cast(float, w << 16); }
__device__ __forceinline__ float bfhi(unsigned w) { return __builtin_bit_cast(float, w & 0xffff0000u); }
__device__ __forceinline__ float bf2f(bf16 b) { return __builtin_bit_cast(float, ((unsigned)b) << 16); }

#define XB_TMO      128
#define XB_XCNT(j)  (256  + 64 * (j))
#define XB_XSUB(j)  (1280 + 64 * (j))
#define XB_XGEN(j)  (2304 + 64 * (j))
#define XB_TOP      3328
#define XB_TOPGEN   3392
#define XCD_BAR_WORDS 3456
#define XB_SPIN_CAP (1u << 18)

__device__ __forceinline__ unsigned xb_ld(unsigned* p)              { return __hip_atomic_load(p, __ATOMIC_RELAXED, __HIP_MEMORY_SCOPE_AGENT); }
__device__ __forceinline__ unsigned xb_add(unsigned* p, unsigned v) { return __hip_atomic_fetch_add(p, v, __ATOMIC_RELAXED, __HIP_MEMORY_SCOPE_AGENT); }
__device__ __forceinline__ unsigned xb_xcc_id() { return (unsigned)__builtin_amdgcn_s_getreg((3 << 11) | 20) & 0xFu; }
#define XB_SPIN(cond, bar) do { unsigned _sp = 0; while (cond) { __builtin_amdgcn_s_sleep(1); \
    if ((++_sp & 255u) == 0u) { if (xb_ld(&(bar)[XB_TMO])) break; if (_sp > XB_SPIN_CAP) { atomicAdd(&(bar)[XB_TMO], 1u); break; } } } } while (0)

struct XcdBarrier {
    unsigned* bar; unsigned x;
    volatile LAS unsigned* st;
};

__device__ __forceinline__ XcdBarrier xcd_barrier_post(unsigned* bar, volatile LAS unsigned* st) {
    XcdBarrier b; b.bar = bar; b.x = xb_xcc_id(); b.st = st;
    if (threadIdx.x == 0) (void)xb_add(&bar[XB_XCNT(b.x)], 1u);
    return b;
}
__device__ __forceinline__ void xcd_barrier_complete(unsigned* bar, unsigned x, unsigned& nloc, unsigned& nx) {
    const unsigned G = gridDim.x * gridDim.y * gridDim.z;
    unsigned sum, cnt, mine, sp = 0u;
    for (;;) {
        sum = 0u; cnt = 0u; mine = 0u;
#pragma unroll
        for (unsigned j = 0; j < 16; ++j) { const unsigned c = xb_ld(&bar[XB_XCNT(j)]); sum += c; cnt += (c > 0u) ? 1u : 0u; mine = (j == x) ? c : mine; }
        if (sum == G) break;
        __builtin_amdgcn_s_sleep(1);
        if ((++sp & 255u) == 0u) { if (xb_ld(&bar[XB_TMO])) break; if (sp > XB_SPIN_CAP) { atomicAdd(&bar[XB_TMO], 1u); break; } }
    }
    nloc = mine > 0u ? mine : 1u; nx = cnt > 0u ? cnt : 1u;
}

__device__ __forceinline__ void xcd_barrier(const XcdBarrier& b) {
    asm volatile("s_waitcnt vmcnt(0)" ::: "memory");
    __syncthreads();
    if (threadIdx.x == 0) {
        unsigned* bar = b.bar;
        __builtin_amdgcn_s_waitcnt(0);
        unsigned nloc = b.st[0], nx = b.st[1];
        if (nloc == 0u) { xcd_barrier_complete(bar, b.x, nloc, nx); b.st[0] = nloc; b.st[1] = nx; }
        const unsigned old = xb_add(&bar[XB_XSUB(b.x)], 1u);
        const unsigned gen = old / nloc;
        if (old + 1u == (gen + 1u) * nloc) {
            __builtin_amdgcn_fence(__ATOMIC_RELEASE, "agent");
            asm volatile("s_waitcnt vmcnt(0)" ::: "memory");
            const unsigned og = xb_add(&bar[XB_TOP], 1u);
            const unsigned tg = og / nx;
            if (og + 1u == (tg + 1u) * nx) xb_add(&bar[XB_TOPGEN], 1u);
            else XB_SPIN(xb_ld(&bar[XB_TOPGEN]) == tg, bar);
            __builtin_amdgcn_fence(__ATOMIC_ACQUIRE, "agent");
            xb_add(&bar[XB_XGEN(b.x)], 1u);
            asm volatile("s_waitcnt vmcnt(0)" ::: "memory");
        } else {
            XB_SPIN(xb_ld(&bar[XB_XGEN(b.x)]) == gen, bar);
            __builtin_amdgcn_fence(__ATOMIC_ACQUIRE, "agent");
            asm volatile("s_waitcnt vmcnt(0)" ::: "memory");
        }
    }
    __syncthreads();
}


namespace rt {
#define RT_DI __device__ __forceinline__
typedef short bf16x8 __attribute__((ext_vector_type(8)));
typedef short s16x4 __attribute__((ext_vector_type(4)));
typedef short v4i16_t __attribute__((ext_vector_type(4)));
typedef float f32x16 __attribute__((ext_vector_type(16)));
typedef float f32x2_t __attribute__((ext_vector_type(2)));
typedef __bf16 bf16x2_t __attribute__((ext_vector_type(2)));
typedef LAS const char* lds_cptr;
constexpr int NSEG = 8, CPS = NCH / NSEG;
constexpr int L_QT = 0, L_KT = 16384, L_VT = 32768, TBUF = 65536, L_PT = 2 * TBUF, L_ST = L_PT + 8192, L_GB = L_ST + 4096;
static_assert(L_GB + 2048 <= LDSCTL_OFF, "retention LDS map");
RT_DI unsigned cvtpk(float lo, float hi) { f32x2_t v = {lo, hi}; bf16x2_t b = __builtin_convertvector(v, bf16x2_t); return __builtin_bit_cast(unsigned, b); }
RT_DI unsigned off_b(unsigned row, unsigned ch) { return 256u * row + 16u * (ch ^ (((row & 3u) << 2) | ((row >> 2) & 3u))); }
RT_DI unsigned off_p(unsigned row, unsigned ch) { return 128u * row + 16u * (ch ^ ((row >> 1) & 7u)); }
RT_DI s16x4 trd(lds_cptr p) { return __builtin_bit_cast(s16x4, __builtin_amdgcn_ds_read_tr16_b64_v4i16((LAS v4i16_t*)p)); }
RT_DI bf16x8 tr8(lds_cptr tile, unsigned lane, unsigned c, unsigned ks) {
    const unsigned hh = lane >> 5, blk = (lane >> 4) & 1u, q = (lane & 15u) >> 2, p = lane & 3u;
    const s16x4 lo = trd(tile + off_b(16 * ks + 8 * hh + q, 4 * c + 2 * blk + (p >> 1)) + 8 * (p & 1u));
    const s16x4 hi = trd(tile + off_b(16 * ks + 8 * hh + 4 + q, 4 * c + 2 * blk + (p >> 1)) + 8 * (p & 1u));
    return __builtin_shufflevector(lo, hi, 0, 1, 2, 3, 4, 5, 6, 7);
}
RT_DI bf16x8 scale_frag(bf16x8 v, const float (&f)[8]) {
    const v4u w = __builtin_bit_cast(v4u, v); v4u o;
    o.x = cvtpk(bflo(w.x) * f[0], bfhi(w.x) * f[1]); o.y = cvtpk(bflo(w.y) * f[2], bfhi(w.y) * f[3]);
    o.z = cvtpk(bflo(w.z) * f[4], bfhi(w.z) * f[5]); o.w = cvtpk(bflo(w.w) * f[6], bfhi(w.w) * f[7]);
    return __builtin_bit_cast(bf16x8, o);
}
RT_DI bf16x8 pack8(const f32x16& x, int s) {
    v4u o; o.x = cvtpk(x[8 * s], x[8 * s + 1]); o.y = cvtpk(x[8 * s + 2], x[8 * s + 3]); o.z = cvtpk(x[8 * s + 4], x[8 * s + 5]); o.w = cvtpk(x[8 * s + 6], x[8 * s + 7]);
    return __builtin_bit_cast(bf16x8, o);
}
#define RT_MFMA32(a, b, c) __builtin_amdgcn_mfma_f32_32x32x16_bf16((a), (b), (c), 0, 0, 0)
#define RT_MFMA16(a, b, c) __builtin_amdgcn_mfma_f32_16x16x32_bf16((a), (b), (c), 0, 0, 0)

RT_DI void glds16(const void* gsrc, unsigned lds_dst) { unsigned keep;
    asm volatile("s_mov_b32 %0, m0\n\ts_mov_b32 m0, %2\n\ts_nop 0\n\tglobal_load_lds_dwordx4 %1, off\n\ts_mov_b32 m0, %0" : "=&s"(keep) : "v"(gsrc), "s"(lds_dst) : "memory"); }
template <bool WITH_Q>
RT_DI void stage_dma(LAS unsigned char* buf, const bf16* Q, const bf16* K, const bf16* V, size_t m0, int h, int wave, unsigned lane) {
    const unsigned lrow = lane >> 4, slot = lane & 15;
    const unsigned lb = (unsigned)__builtin_amdgcn_readfirstlane((int)(unsigned)(size_t)buf);
    const char* qb = (const char*)(Q + m0 * 512 + h * 128); const char* kb = (const char*)(K + m0 * 512 + h * 128); const char* vb = (const char*)(V + m0 * 1024 + h * 256);
#pragma unroll
    for (int i = 0; i < 2; ++i) { const unsigned p = 2 * wave + i, row = 4 * p + lrow, ch = slot ^ (((row & 3u) << 2) | ((row >> 2) & 3u)), off = (row * 512 + ch * 8) * 2u;
        if (WITH_Q) glds16(qb + off, lb + L_QT + p * 1024);
        glds16(kb + off, lb + L_KT + p * 1024); }
#pragma unroll
    for (int i = 0; i < 4; ++i) { const unsigned p = 4 * wave + i, tile = p >> 4, pp = p & 15, row = 4 * pp + lrow, ch = slot ^ (((row & 3u) << 2) | ((row >> 2) & 3u)), off = (row * 1024 + tile * 128 + ch * 8) * 2u;
        glds16(vb + off, lb + L_VT + tile * 16384 + pp * 1024); }
}
#define RT_BARRIER() do { asm volatile("s_waitcnt lgkmcnt(0)" ::: "memory"); __builtin_amdgcn_s_barrier(); asm volatile("" ::: "memory"); } while (0)
RT_DI void kv_update(f32x16 (&S)[4], const bf16x8 (&vf)[4], lds_cptr KT, unsigned lane, float cdec, const float (&wj)[8], const float (&fk)[4]) {
#pragma unroll
    for (int dt = 0; dt < 4; ++dt) S[dt] = S[dt] * cdec;
#pragma unroll
    for (int ks = 0; ks < 4; ++ks) {
        float f[8];
#pragma unroll
        for (int jj = 0; jj < 8; ++jj) f[jj] = wj[jj] * fk[ks];
        const bf16x8 vs = scale_frag(vf[ks], f);
#pragma unroll
        for (int dt = 0; dt < 4; ++dt) { const bf16x8 kf = tr8(KT, lane, dt, ks); S[dt] = RT_MFMA32(kf, vs, S[dt]); }
    }
}
RT_DI int crow(int reg, int hh) { return (reg & 3) + 8 * (reg >> 2) + 4 * hh; }

RT_DI void pass1(LAS unsigned char* lds, int tid, int wave, int item, const bf16* K, const bf16* V, float* SLOC) {
    const int chain = item >> 3, seg = item & 7, b = chain >> 2, h = chain & 3;
    if (seg == NSEG - 1) return;
    const unsigned lane = tid & 63, r = lane & 31, hh = lane >> 5;
    const float lg = log1pf(-exp2f(-5.f - (float)h));
    const float cdec = expf(lg * 64.f);
    float wj[8], fk[4];
#pragma unroll
    for (int jj = 0; jj < 8; ++jj) wj[jj] = expf(lg * (float)(7 - jj));
#pragma unroll
    for (int ks = 0; ks < 4; ++ks) fk[ks] = expf(lg * (float)(56 - 16 * ks - 8 * (int)hh));
    f32x16 S[4];
#pragma unroll
    for (int dt = 0; dt < 4; ++dt)
#pragma unroll
        for (int i = 0; i < 16; ++i) S[dt][i] = 0.f;
    const size_t mseg = (size_t)b * SEQ + (size_t)seg * CPS * CH;
    __syncthreads();
    stage_dma<false>(lds, nullptr, K, V, mseg, h, wave, lane);
    for (int c = 0; c < CPS; ++c) {
        LAS unsigned char* tb = lds + (c & 1) * TBUF;
        asm volatile("s_waitcnt vmcnt(0)" ::: "memory");
        RT_BARRIER();
        if (c + 1 < CPS) stage_dma<false>(lds + ((c + 1) & 1) * TBUF, nullptr, K, V, mseg + (size_t)(c + 1) * CH, h, wave, lane);
        lds_cptr KT = (lds_cptr)(tb + L_KT), VT = (lds_cptr)(tb + L_VT + (wave >> 2) * 16384);
        bf16x8 vf[4];
#pragma unroll
        for (int ks = 0; ks < 4; ++ks) vf[ks] = tr8(VT, lane, wave & 3, ks);
        kv_update(S, vf, KT, lane, cdec, wj, fk);
    }
    float* dst = SLOC + (size_t)item * (128 * 256) + wave * 4096 + lane;
#pragma unroll
    for (int dt = 0; dt < 4; ++dt)
#pragma unroll
        for (int i = 0; i < 16; ++i) dst[(dt * 16 + i) * 64] = S[dt][i];
}

RT_DI void pass2(LAS unsigned char* lds, int tid_, int wave, int item, const bf16* Q, const bf16* K, const bf16* V, const bf16* SGR, bf16* DST, const float* SLOC, const float* gn_g, const float* gn_b, unsigned long long& pacc) {
    const int chain = item >> 3, seg = item & 7, b = chain >> 2, h = chain & 3;
    const unsigned lane_ = tid_ & 63; const int tid = tid_;
    float cdec, lg2; const int it16 = wave >> 1, jt0 = 2 * (wave & 1);
    f32x16 S[4];
    {
    const unsigned lane = lane_;
    const float lg = log1pf(-exp2f(-5.f - (float)h));
    cdec = expf(lg * 64.f); lg2 = lg * 1.4426950408889634f;
#pragma unroll
    for (int dt = 0; dt < 4; ++dt)
#pragma unroll
        for (int i = 0; i < 16; ++i) S[dt][i] = 0.f;
    {
        const float sdec = expf(lg * (float)(CPS * CH));
        for (int g = 0; g < seg; ++g) { const float* src = SLOC + (size_t)(chain * NSEG + g) * (128 * 256) + wave * 4096 + lane;
#pragma unroll
            for (int dt = 0; dt < 4; ++dt)
#pragma unroll
                for (int i = 0; i < 16; ++i) S[dt][i] = S[dt][i] * sdec + src[(dt * 16 + i) * 64]; }
    }
    }
    __syncthreads();
    for (int i = tid; i < 512; i += 512) ((LAS float*)(lds + L_GB))[i] = (i < 256) ? gn_g[h * 256 + i] : gn_b[h * 256 + i - 256];
    lds_cptr PT = (lds_cptr)(lds + L_PT);
    const size_t mseg = (size_t)b * SEQ + (size_t)seg * CPS * CH;
    stage_dma<true>(lds, Q, K, V, mseg, h, wave, lane_);
    asm volatile("s_waitcnt vmcnt(0)" ::: "memory");
    RT_BARRIER();
    for (int c = 0; c < CPS; ++c) {
        const size_t m0 = mseg + (size_t)c * CH;
        LAS unsigned char* tb = lds + (c & 1) * TBUF;
        lds_cptr QT = (lds_cptr)(tb + L_QT), KT = (lds_cptr)(tb + L_KT), VT = (lds_cptr)(tb + L_VT + (wave >> 2) * 16384);
        int tid = tid_; asm volatile("" : "+v"(tid));
        const unsigned lane = tid & 63, r = lane & 31, hh = lane >> 5, fr = lane & 15, fq = lane >> 4;
        float wj[8], fk[4], pdec[2][4];
#pragma unroll
        for (int jj = 0; jj < 8; ++jj) wj[jj] = __builtin_amdgcn_exp2f(lg2 * (float)(7 - jj));
#pragma unroll
        for (int ks = 0; ks < 4; ++ks) fk[ks] = __builtin_amdgcn_exp2f(lg2 * (float)(56 - 16 * ks - 8 * (int)hh));
        const float qd0 = __builtin_amdgcn_exp2f(lg2 * (float)(r + 1)), qd1 = __builtin_amdgcn_exp2f(lg2 * (float)(r + 33));
#pragma unroll
        for (int tt = 0; tt < 2; ++tt)
#pragma unroll
            for (int e = 0; e < 4; ++e) { const int i = 16 * it16 + (int)fr, j = 16 * (jt0 + tt) + 4 * (int)fq + e; pdec[tt][e] = __builtin_amdgcn_exp2f(lg2 * (float)(i > j ? i - j : j - i)); }
        PSEC_B(11)
        if (c + 1 < CPS) stage_dma<true>(lds + ((c + 1) & 1) * TBUF, Q, K, V, m0 + CH, h, wave, lane);
        const size_t ooff = (m0 + r) * 2048 + h * 256 + 32 * wave + 4 * hh; const bf16* srow0 = SGR + ooff; bf16* orow0 = DST + ooff;
        v2u sg[2][4];
#pragma unroll
        for (int it = 0; it < 2; ++it)
#pragma unroll
            for (int g4 = 0; g4 < 4; ++g4) sg[it][g4] = *(const GAS v2u*)(srow0 + (size_t)it * 32 * 2048 + 8 * g4);
        PSEC_E(11) PSEC_B(12)
        {
            f32x4 p[2] = {(f32x4){0.f, 0.f, 0.f, 0.f}, (f32x4){0.f, 0.f, 0.f, 0.f}};
#pragma unroll
            for (int s = 0; s < 4; ++s) {
                const bf16x8 qf = *(const LAS bf16x8*)(QT + off_b(fr + 16 * it16, 4 * s + fq));
#pragma unroll
                for (int tt = 0; tt < 2; ++tt) { const bf16x8 kf = *(const LAS bf16x8*)(KT + off_b(fr + 16 * (jt0 + tt), 4 * s + fq)); p[tt] = RT_MFMA16(kf, qf, p[tt]); }
            }
#pragma unroll
            for (int tt = 0; tt < 2; ++tt) { v2u w; w.x = cvtpk(p[tt][0] * pdec[tt][0], p[tt][1] * pdec[tt][1]); w.y = cvtpk(p[tt][2] * pdec[tt][2], p[tt][3] * pdec[tt][3]);
                *(LAS v2u*)(lds + L_PT + off_p(16 * it16 + fr, 2 * (jt0 + tt) + (fq >> 1)) + 8 * (fq & 1)) = w; }
        }
        PSEC_E(12) PSEC_B(13)
        f32x16 z[2];
#pragma unroll
        for (int it = 0; it < 2; ++it)
#pragma unroll
            for (int i = 0; i < 16; ++i) z[it][i] = 0.f;
#pragma unroll
        for (int dt = 0; dt < 4; ++dt)
#pragma unroll
            for (int s = 0; s < 2; ++s) {
                const bf16x8 xs = pack8(S[dt], s);
#pragma unroll
                for (int it = 0; it < 2; ++it) {
                    const s16x4 lo = *(const LAS s16x4*)(QT + off_b(32 * it + r, 4 * dt + 2 * s) + 8 * hh);
                    const s16x4 hi = *(const LAS s16x4*)(QT + off_b(32 * it + r, 4 * dt + 2 * s + 1) + 8 * hh);
                    const bf16x8 qb = __builtin_shufflevector(lo, hi, 0, 1, 2, 3, 4, 5, 6, 7);
                    z[it] = RT_MFMA32(xs, qb, z[it]);
                }
            }
        z[0] = z[0] * qd0; z[1] = z[1] * qd1;
        RT_BARRIER();
        PSEC_E(13) PSEC_B(14)
        bf16x8 vf[4];
#pragma unroll
        for (int ks = 0; ks < 4; ++ks) vf[ks] = tr8(VT, lane, wave & 3, ks);
#pragma unroll
        for (int ks = 0; ks < 4; ++ks)
#pragma unroll
            for (int it = 0; it < 2; ++it) { const bf16x8 pf = *(const LAS bf16x8*)(PT + off_p(32 * it + r, 2 * ks + hh)); z[it] = RT_MFMA32(vf[ks], pf, z[it]); }
        PSEC_E(14) PSEC_B(15)
        kv_update(S, vf, KT, lane, cdec, wj, fk);
        PSEC_E(15) PSEC_B(16)
        typedef float f2 __attribute__((ext_vector_type(2)));
#pragma unroll
        for (int it = 0; it < 2; ++it) {
            float s1 = 0.f;
#pragma unroll
            for (int i = 0; i < 16; ++i) s1 += z[it][i];
            s1 += __shfl_xor(s1, 32);
            const float mw = s1 * (1.f / 32.f); float m2 = 0.f;
#pragma unroll
            for (int i = 0; i < 16; ++i) { const float d = z[it][i] - mw; m2 += d * d; }
            m2 += __shfl_xor(m2, 32);
            if (hh == 0) *(LAS f2*)(lds + L_ST + ((32 * it + r) * 8 + wave) * 8) = (f2){mw, m2};
        }
        asm volatile("s_waitcnt vmcnt(0)" ::: "memory");
        RT_BARRIER();
        PSEC_E(16) PSEC_B(17)
#pragma unroll
        for (int it = 0; it < 2; ++it) {
            const LAS f32x4* sp = (const LAS f32x4*)(lds + L_ST + (32 * it + r) * 64);
            const f32x4 a0 = sp[0], a1 = sp[1], a2 = sp[2], a3 = sp[3];
            const float mean = ((a0[0] + a0[2]) + (a1[0] + a1[2]) + (a2[0] + a2[2]) + (a3[0] + a3[2])) * 0.125f;
            float q = (a0[1] + a0[3]) + (a1[1] + a1[3]) + (a2[1] + a2[3]) + (a3[1] + a3[3]);
            { const float d0 = a0[0] - mean, d1 = a0[2] - mean, d2 = a1[0] - mean, d3 = a1[2] - mean, d4 = a2[0] - mean, d5 = a2[2] - mean, d6 = a3[0] - mean, d7 = a3[2] - mean;
              q += 32.f * ((d0 * d0 + d1 * d1) + (d2 * d2 + d3 * d3) + (d4 * d4 + d5 * d5) + (d6 * d6 + d7 * d7)); }
            const float rstd = 1.f / sqrtf(q * (1.f / 256.f) + LN_EPS);
#pragma unroll
            for (int g4 = 0; g4 < 4; ++g4) {
                const f32x4 gg = *(const LAS f32x4*)(lds + L_GB + (32 * wave + 8 * g4 + 4 * hh) * 4), bb = *(const LAS f32x4*)(lds + L_GB + 1024 + (32 * wave + 8 * g4 + 4 * hh) * 4);
                const float y0 = (z[it][4 * g4 + 0] - mean) * rstd * gg[0] + bb[0], y1 = (z[it][4 * g4 + 1] - mean) * rstd * gg[1] + bb[1];
                const float y2 = (z[it][4 * g4 + 2] - mean) * rstd * gg[2] + bb[2], y3 = (z[it][4 * g4 + 3] - mean) * rstd * gg[3] + bb[3];
                v2u w; w.x = cvtpk(bflo(sg[it][g4].x) * y0, bfhi(sg[it][g4].x) * y1); w.y = cvtpk(bflo(sg[it][g4].y) * y2, bfhi(sg[it][g4].y) * y3);
                *(GAS v2u*)(orow0 + (size_t)it * 32 * 2048 + 8 * g4) = w;
            }
        }
        PSEC_E(17)
    }
    __syncthreads();
}
#undef RT_MFMA32
#undef RT_MFMA16
#undef RT_DI
}


namespace lr {
#define LR_DI __device__ __forceinline__
typedef short bf16x8 __attribute__((ext_vector_type(8)));
typedef float f32x16 __attribute__((ext_vector_type(16)));
constexpr int TOK = 256, NIT = SEQ / TOK;
constexpr int L_WT = 0, L_AG = 16384, L_BIAS = L_AG + 4096, L_CWT = L_BIAS + 256, L_WV = L_CWT + 2560, WV_XW = 0, WV_XCF = 9216, WV_SGT = WV_XCF + 4096, WV_BYTES = WV_SGT + 2048, L_END = L_WV + 8 * WV_BYTES;
static_assert(L_END <= LDSCTL_OFF && (L_WV % 16) == 0, "LRU LDS map");
struct XStage { v4u v[9]; };
LR_DI void x_load(XStage& st, const bf16* XL, int b, int cb, int tw, int lane) {
    const char* base = (const char*)(XL + ((size_t)b * SEQ + tw) * 1024 + cb * 128) - 3 * 2048;
    const int rmin = (tw == 0) ? 3 : 0;
#pragma unroll
    for (int k = 0; k < 9; ++k) { int id = lane + 64 * k; id = id < 35 * 16 ? id : 35 * 16 - 1; const int R = id >> 4, ch = id & 15, Rl = R < rmin ? rmin : R;
        const v4u v = *(const GAS v4u*)(base + (unsigned)(Rl * 2048 + ch * 16));
        st.v[k] = (R < rmin) ? (v4u){0u, 0u, 0u, 0u} : v; }
}
LR_DI void x_write(const XStage& st, LAS unsigned char* xw, int lane) {
#pragma unroll
    for (int k = 0; k < 9; ++k) { const int id = lane + 64 * k, R = id >> 4, ch = id & 15;
        if (id < 35 * 16) *(LAS v4u*)(xw + R * 256 + 16 * (ch ^ (R & 15))) = st.v[k]; }
}
LR_DI void run(LAS unsigned char* lds, int tid_, int wave, int item, const bf16* XL, const bf16* SGL, bf16* DST, const float* conv_w, const float* conv_b,
               const float* w_a, const float* b_a, const float* w_x, const float* b_x, const float* lam, unsigned long long& pacc) {
    const int b = item >> 5, cb = (item >> 2) & 7, q = item & 3;
    float bias_r, bias_i, Lc2, Lcn2;
    _Pragma("nounroll") for (int rep = 0; rep < ((((PROBE_DUP) >> 9) & 1) + 1); ++rep)
    {
        const int tid = tid_;
        __syncthreads();
#pragma unroll
        for (int i = 0; i < 2; ++i) { const int id = tid + 512 * i, gate = id >> 9, ch = (id >> 5) & 15, n = id & 31;
            const float* W = (gate ? w_x : w_a) + ((size_t)cb * 128 + 8 * ch) * 128 + q * 32 + n; float v[8];
#pragma unroll
            for (int e = 0; e < 8; ++e) v[e] = W[e * 128];
            v4u o; o.x = rt::cvtpk(v[0], v[1]); o.y = rt::cvtpk(v[2], v[3]); o.z = rt::cvtpk(v[4], v[5]); o.w = rt::cvtpk(v[6], v[7]);
            *(LAS v4u*)(lds + L_WT + gate * 8192 + rt::off_b(n, ch)) = o; }
        if (tid < 64) ((LAS float*)(lds + L_BIAS))[tid] = ((tid >> 5) ? b_x : b_a)[cb * 128 + q * 32 + (tid & 31)];
        if (tid < 272) ((LAS unsigned*)(lds + L_AG))[tid < 256 ? tid : 256 + (tid - 256)] = 0u;
        for (int i = tid; i < 16 * 5 * 8; i += 512) { const int ch = i / 40, j = (i % 40) >> 3, e = i & 7; const int c = cb * 128 + 8 * ch + e;
            ((LAS float*)(lds + L_CWT))[i] = (j < 4) ? conv_w[j * 1024 + c] : conv_b[c]; }
        __syncthreads();
        const int r = tid & 31, chn = cb * 128 + q * 32 + r;
        bias_r = ((LAS float*)(lds + L_BIAS))[r]; bias_i = ((LAS float*)(lds + L_BIAS))[32 + r];
        const float Lc = -8.0f * log1pf(expf(-lam[chn]));
        Lc2 = Lc * 1.4426950408889634f; Lcn2 = 2.0f * Lc;
    }
    XStage st;
    x_load(st, XL, b, cb, 32 * wave, tid_ & 63);
#pragma unroll 1
    for (int it = 0; it < NIT; ++it) {
        const int t0 = it * TOK;
        int tid = tid_; asm volatile("" : "+v"(tid));
        const unsigned lane = tid & 63, r = lane & 31, hh = lane >> 5;
        LAS unsigned char* wv = lds + L_WV + wave * WV_BYTES;
        PSEC_B(1)
        x_write(st, wv + WV_XW, lane);
        const size_t orow0 = ((size_t)b * SEQ + t0 + 32 * wave) * 2048 + cb * 128 + q * 32;
        v4u sgv[2];
#pragma unroll
        for (int k = 0; k < 2; ++k) { const int id = lane + 64 * k; sgv[k] = *(const GAS v4u*)(SGL + orow0 + (size_t)(id >> 2) * 2048 + (id & 3) * 8); }
        if (it + 1 < NIT) x_load(st, XL, b, cb, t0 + TOK + 32 * wave, lane);
        PSEC_E(1) PSEC_B(2)
        {
            const unsigned ch = lane & 15;
            v4u raw[2][7];
#pragma unroll
            for (int k = 0; k < 2; ++k)
#pragma unroll
                for (int d = 0; d < 7; ++d) { const unsigned R = 4 * ((lane >> 4) + 4 * k) + d; raw[k][d] = *(const LAS v4u*)(wv + WV_XW + R * 256 + 16 * (ch ^ (R & 15))); }
            f32x4 cwv[5][2];
#pragma unroll
            for (int j = 0; j < 5; ++j) { cwv[j][0] = *(const LAS f32x4*)(lds + L_CWT + (ch * 40 + j * 8) * 4); cwv[j][1] = *(const LAS f32x4*)(lds + L_CWT + (ch * 40 + j * 8 + 4) * 4); }
            asm volatile("s_waitcnt lgkmcnt(0)" ::: "memory");
#pragma unroll
            for (int k = 0; k < 2; ++k) {
                const unsigned T = 4 * ((lane >> 4) + 4 * k);
#pragma unroll
                for (int e4 = 0; e4 < 4; ++e4) { float o[8];
#pragma unroll
                    for (int e = 0; e < 8; ++e) { const int hv = e >> 2, c4 = e & 3; float s = cwv[4][hv][c4];
#pragma unroll
                        for (int j = 0; j < 4; ++j) { const v4u w = raw[k][e4 + j]; const unsigned dw = (e >> 1) == 0 ? w.x : (e >> 1) == 1 ? w.y : (e >> 1) == 2 ? w.z : w.w;
                            s += cwv[j][hv][c4] * ((e & 1) ? bfhi(dw) : bflo(dw)); }
                        o[e] = s; }
                    v4u co; co.x = rt::cvtpk(o[0], o[1]); co.y = rt::cvtpk(o[2], o[3]); co.z = rt::cvtpk(o[4], o[5]); co.w = rt::cvtpk(o[6], o[7]);
                    const unsigned R = T + e4;
                    *(LAS v4u*)(wv + WV_XW + R * 256 + 16 * (ch ^ (R & 15))) = co;
                    if ((ch >> 2) == (unsigned)q) {
                        LAS float* xf = (LAS float*)(wv + WV_XCF) + R * 32 + (ch & 3) * 8;
                        *(LAS f32x4*)xf = (f32x4){o[0], o[1], o[2], o[3]}; *(LAS f32x4*)(xf + 4) = (f32x4){o[4], o[5], o[6], o[7]}; }
                }
            }
        }
#pragma unroll
        for (int k = 0; k < 2; ++k) { const int id = lane + 64 * k; *(LAS v4u*)(wv + WV_SGT + id * 16) = sgv[k]; }
        PSEC_E(2) PSEC_B(3)
        f32x16 ar, ai;
#pragma unroll
        for (int i = 0; i < 16; ++i) { ar[i] = bias_r; ai[i] = bias_i; }
#pragma unroll
        for (int ks = 0; ks < 8; ++ks) {
            const bf16x8 xa = *(const LAS bf16x8*)(wv + WV_XW + r * 256 + 16 * ((2 * ks + hh) ^ (r & 15)));
            const bf16x8 wa = *(const LAS bf16x8*)(lds + L_WT + rt::off_b(r, 2 * ks + hh));
            const bf16x8 wx = *(const LAS bf16x8*)(lds + L_WT + 8192 + rt::off_b(r, 2 * ks + hh));
            ar = __builtin_amdgcn_mfma_f32_32x32x16_bf16(xa, wa, ar, 0, 0, 0);
            ai = __builtin_amdgcn_mfma_f32_32x32x16_bf16(xa, wx, ai, 0, 0, 0);
        }
        PSEC_E(3) PSEC_B(4)
        float a[16], u[16];
#pragma unroll
        for (int i = 0; i < 16; ++i) {
            const float xc = ((const LAS float*)(wv + WV_XCF))[((i & 3) + 8 * (i >> 2) + 4 * hh) * 32 + r];
            const float rg = __builtin_amdgcn_rcpf(1.0f + __builtin_amdgcn_exp2f(-1.4426950408889634f * ar[i]));
            const float ig = __builtin_amdgcn_rcpf(1.0f + __builtin_amdgcn_exp2f(-1.4426950408889634f * ai[i]));
            const float av = __builtin_amdgcn_exp2f(rg * Lc2);
            const float y = rg * Lcn2;
            const float s_small = -y * (1.0f + y * (0.5f + y * (0.16666667f + y * 0.041666668f)));
            const float s_big = 1.0f - av * av;
            const float s = (y > -0.25f) ? s_small : s_big;
            a[i] = av; u[i] = __builtin_amdgcn_sqrtf(s) * (ig * xc);
        }
        PSEC_E(4) PSEC_B(5)
        float Ag[4], Hg[4], Ap[4], Hp[4];
#pragma unroll
        for (int g = 0; g < 4; ++g) { Ag[g] = (a[4 * g] * a[4 * g + 1]) * (a[4 * g + 2] * a[4 * g + 3]);
            Hg[g] = ((u[4 * g] * a[4 * g + 1] + u[4 * g + 1]) * a[4 * g + 2] + u[4 * g + 2]) * a[4 * g + 3] + u[4 * g + 3];
            Ap[g] = __shfl_xor(Ag[g], 32); Hp[g] = __shfl_xor(Hg[g], 32); }
        float Ac = 1.0f, Hc = 0.0f, Ab[4], Hb[4];
#pragma unroll
        for (int g = 0; g < 4; ++g) {
            const float A1 = hh ? Ap[g] : Ag[g], H1 = hh ? Hp[g] : Hg[g], A2 = hh ? Ag[g] : Ap[g], H2 = hh ? Hg[g] : Hp[g];
            const float Hc1 = A1 * Hc + H1, Ac1 = Ac * A1;
            Ab[g] = hh ? Ac1 : Ac; Hb[g] = hh ? Hc1 : Hc;
            Hc = A2 * Hc1 + H2; Ac = Ac1 * A2;
        }
        float cin;
        {
            const int pw = (wave + 7) & 7; const unsigned need = (wave == 0) ? (unsigned)it : (unsigned)(it + 1);
            volatile LAS unsigned* fl = (volatile LAS unsigned*)(lds + L_AG + 1024);
            unsigned spins = 0;
            while (fl[pw] < need) { __builtin_amdgcn_s_sleep(1); if (++spins > (1u << 22)) break; }
            asm volatile("" ::: "memory");
            cin = ((volatile LAS float*)(lds + L_AG))[pw * 32 + r];
            const float cout = Ac * cin + Hc;
            if (hh == 0) ((volatile LAS float*)(lds + L_AG))[wave * 32 + r] = cout;
            asm volatile("s_waitcnt lgkmcnt(0)" ::: "memory");
            if (lane == 0) fl[wave] = (unsigned)(it + 1);
        }
        PSEC_E(5) PSEC_B(6)
        LAS bf16* slab = (LAS bf16*)(wv + WV_SGT);
#pragma unroll
        for (int g = 0; g < 4; ++g) { float h = Hb[g] + Ab[g] * cin;
#pragma unroll
            for (int e = 0; e < 4; ++e) { const int i = 4 * g + e; h = a[i] * h + u[i];
                LAS bf16* p = slab + ((i & 3) + 8 * (i >> 2) + 4 * hh) * 32 + r;
                *p = (bf16)(rt::cvtpk(bf2f(*p) * h, 0.f) & 0xffffu); } }
#pragma unroll
        for (int k = 0; k < 2; ++k) { const int id = lane + 64 * k; const v4u v = *(const LAS v4u*)(wv + WV_SGT + id * 16);
            *(GAS v4u*)(DST + orow0 + (size_t)(id >> 2) * 2048 + (id & 3) * 8) = v; }
        PSEC_E(6)
    }
    __syncthreads();
}
#undef LR_DI
}

struct Frame {
    LAS unsigned char* lds;
    volatile LAS unsigned* MISC;
    gu32* ctl;
    int tid, lane, wave;
    int vcu, G;
    const float* x; float* out;
    const float *ln_in_g, *ln_in_b, *w_in, *b_merge, *gn_g, *gn_b, *w_ret, *conv_w, *conv_b, *w_rg_a, *b_rg_a, *w_rg_x, *b_rg_x, *lam, *w_lru, *w_out, *ln_out_g, *ln_out_b;
    bf16 *WinT, *PcatT, *WoutT; float* rope;
    bf16 *Q, *K, *V, *SGR, *XL, *SGL, *GR, *GL, *MERGED, *XN;
};

__device__ __forceinline__ float wave_sum(float v) {
#pragma unroll
    for (int o = 1; o < 64; o <<= 1) v += __shfl_xor(v, o);
    return v;
}
__device__ __forceinline__ int win_dest_row(int c) {
    if (c >= 5120) { const int n = (c - 5120) & 1023, lru = (c - 5120) >> 10; return 5120 + 256 * (n >> 7) + 128 * lru + (n & 127); }
    if (c >= 1024) return c;
    const int blk = c >> 9, cc = c & 511, head = cc >> 7, idx = cc & 127, bj = idx >> 6, i = idx & 63;
    return blk * 512 + (head >> 1) * 256 + 128 * bj + (head & 1) * 64 + i;
}
template <bool WIN>
__device__ __forceinline__ void p0_transpose_item(const float* W, int ldw, bf16* WT, int ldt, int koff, LAS float* scr, int k0, int n0, int lane) {
#pragma unroll 8
    for (int i = 0; i < 32; ++i) { const int kk = 2 * i + (lane >> 5); scr[kk * 33 + (lane & 31)] = W[(size_t)(k0 + kk) * ldw + n0 + (lane & 31)]; }
    LDS_WAIT(); asm volatile("" ::: "memory");
    const int c = lane & 7;
#pragma unroll
    for (int j = 0; j < 4; ++j) { const int n = (lane >> 3) + 8 * j; const LAS float* s = scr + (8 * c) * 33 + n;
        const int col = n0 + n; const int drow = WIN ? win_dest_row(col) : col;
        const float sc = (WIN && col >= 512 && col < 1024) ? 0.08838834764831845f : 1.0f;
        v4u o; o.x = pk2(s[0 * 33] * sc, s[1 * 33] * sc); o.y = pk2(s[2 * 33] * sc, s[3 * 33] * sc); o.z = pk2(s[4 * 33] * sc, s[5 * 33] * sc); o.w = pk2(s[6 * 33] * sc, s[7 * 33] * sc);
        *(GAS v4u*)(WT + (size_t)drow * ldt + koff + k0 + 8 * c) = o; }
    LDS_WAIT(); asm volatile("" ::: "memory");
}
__device__ __forceinline__ void p0_prologue(Frame& F) {
    LAS float* scr = (LAS float*)(F.lds + RING_OFF + F.wave * 16384);
    const int gw = F.vcu * NWAVES + F.wave, NGW = F.G * NWAVES;
    constexpr int I_IN = (D / 64) * (NIN / 32), I_SQ = (D / 64) * (D / 32);
    constexpr int NITEMS = I_IN + 3 * I_SQ;
    for (int it = gw; it < NITEMS; it += NGW) {
        int r = it;
        if (r < I_IN) { const int nblk = NIN / 32; p0_transpose_item<true>(F.w_in, NIN, F.WinT, D, 0, scr, 64 * (r / nblk), 32 * (r % nblk), F.lane); continue; } r -= I_IN;
        const int nblk = D / 32, k0 = 64 * ((r % I_SQ) / nblk), n0 = 32 * ((r % I_SQ) % nblk);
        if (r < I_SQ) { p0_transpose_item<false>(F.w_ret, D, F.PcatT, 2 * D, 0, scr, k0, n0, F.lane); continue; }
        if (r < 2 * I_SQ) { p0_transpose_item<false>(F.w_lru, D, F.PcatT, 2 * D, D, scr, k0, n0, F.lane); continue; }
        p0_transpose_item<false>(F.w_out, D, F.WoutT, D, 0, scr, k0, n0, F.lane);
    }
    for (int e = (F.vcu * NWAVES * 64) + F.tid; e < SEQ * 64; e += F.G * NWAVES * 64) {
        const int pos = e >> 6, i = e & 63;
        const double inv = exp(-(double)i * (9.210340371976184 / 64.0));
        const double ang = (double)pos * inv;
        const double n = rint(ang * 0.15915494309189535);
        double r = fma(-n, 6.283185307179586, ang); r = fma(-n, 2.4492935982947064e-16, r);
        const float rf = (float)r;
        typedef float f32x2 __attribute__((ext_vector_type(2)));
        f32x2 cs; cs.x = cosf(rf); cs.y = sinf(rf);
        *(GAS f32x2*)((GAS float*)F.rope + (size_t)e * 2) = cs;
    }
    f32x4 gv[4], bv[4];
#pragma unroll
    for (int j = 0; j < 4; ++j) { const int e4 = 128 * (j >> 1) + 2 * F.lane + (j & 1); gv[j] = *((const GAS f32x4*)F.ln_in_g + e4); bv[j] = *((const GAS f32x4*)F.ln_in_b + e4); }
    f32x4 vn[4];
    if (gw < M) {
#pragma unroll
        for (int j = 0; j < 4; ++j) vn[j] = ((const GAS f32x4*)(F.x + (size_t)gw * D))[128 * (j >> 1) + 2 * F.lane + (j & 1)]; }
    for (int m = gw; m < M; m += NGW) {
        f32x4 v[4]; float s = 0.f;
#pragma unroll
        for (int j = 0; j < 4; ++j) { v[j] = vn[j]; s += (v[j].x + v[j].y) + (v[j].z + v[j].w); }
        if (m + NGW < M) {
#pragma unroll
            for (int j = 0; j < 4; ++j) vn[j] = ((const GAS f32x4*)(F.x + (size_t)(m + NGW) * D))[128 * (j >> 1) + 2 * F.lane + (j & 1)]; }
        const float mean = wave_sum(s) * (1.f / D); float s2 = 0.f;
#pragma unroll
        for (int j = 0; j < 4; ++j) { v[j] = v[j] - mean; s2 += (v[j].x * v[j].x + v[j].y * v[j].y) + (v[j].z * v[j].z + v[j].w * v[j].w); }
        const float rstd = 1.f / sqrtf(wave_sum(s2) * (1.f / D) + LN_EPS);
        GAS v4u* o16 = (GAS v4u*)(F.XN + (size_t)m * D) + F.lane;
#pragma unroll
        for (int jj = 0; jj < 2; ++jj) { const f32x4 y0 = v[2 * jj] * rstd * gv[2 * jj] + bv[2 * jj], y1 = v[2 * jj + 1] * rstd * gv[2 * jj + 1] + bv[2 * jj + 1];
            v4u w; w.x = pk2(y0.x, y0.y); w.y = pk2(y0.z, y0.w); w.z = pk2(y1.x, y1.y); w.w = pk2(y1.z, y1.w); o16[64 * jj] = w; }
    }
}

__device__ __forceinline__ void ret_simple(Frame& F, int item, float* RAW) {
    const int b = item >> 5, h = (item >> 3) & 3, es = item & 7, t = F.tid;
    LAS float* Qs = (LAS float*)(F.lds);
    LAS float* Ks = Qs + 64 * 129;
    LAS float* Vs = Ks + 64 * 129;
    LAS float* Ps = Vs + 64 * 32;
    LAS float* Ss = Ps + 64 * 65;
    const float lg = log1pf(-exp2f(-5.f - (float)h));
    for (int i = t; i < 128 * 32; i += 512) Ss[i] = 0.f;
    const float cdec = expf(lg * 64.f);
    for (int c = 0; c < NCH; ++c) {
        const size_t m0 = (size_t)b * SEQ + (size_t)c * CH;
        __syncthreads();
#pragma unroll
        for (int k = 0; k < 2; ++k) { const int id = t + 512 * k, row = id >> 4, c8 = id & 15;
            const v4u q = *(const GAS v4u*)(F.Q + (m0 + row) * 512 + h * 128 + c8 * 8), kk = *(const GAS v4u*)(F.K + (m0 + row) * 512 + h * 128 + c8 * 8);
            LAS float* qd = Qs + row * 129 + c8 * 8; LAS float* kd = Ks + row * 129 + c8 * 8;
            qd[0] = bflo(q.x); qd[1] = bfhi(q.x); qd[2] = bflo(q.y); qd[3] = bfhi(q.y); qd[4] = bflo(q.z); qd[5] = bfhi(q.z); qd[6] = bflo(q.w); qd[7] = bfhi(q.w);
            kd[0] = bflo(kk.x); kd[1] = bfhi(kk.x); kd[2] = bflo(kk.y); kd[3] = bfhi(kk.y); kd[4] = bflo(kk.z); kd[5] = bfhi(kk.z); kd[6] = bflo(kk.w); kd[7] = bfhi(kk.w); }
        if (t < 256) { const int row = t >> 2, c8 = t & 3;
            const v4u v = *(const GAS v4u*)(F.V + (m0 + row) * 1024 + h * 256 + es * 32 + c8 * 8);
            LAS float* vd = Vs + row * 32 + c8 * 8;
            vd[0] = bflo(v.x); vd[1] = bfhi(v.x); vd[2] = bflo(v.y); vd[3] = bfhi(v.y); vd[4] = bflo(v.z); vd[5] = bfhi(v.z); vd[6] = bflo(v.w); vd[7] = bfhi(v.w); }
        __syncthreads();
        {
            const int i = t >> 3, jg = t & 7; float a[8];
#pragma unroll
            for (int jj = 0; jj < 8; ++jj) a[jj] = 0.f;
            for (int d = 0; d < 128; ++d) { const float q = Qs[i * 129 + d];
#pragma unroll
                for (int jj = 0; jj < 8; ++jj) a[jj] += q * Ks[(jg * 8 + jj) * 129 + d]; }
#pragma unroll
            for (int jj = 0; jj < 8; ++jj) { const int j = jg * 8 + jj; const int dd = i > j ? i - j : j - i; Ps[i * 65 + j] = a[jj] * expf(lg * (float)dd); }
        }
        __syncthreads();
        {
            const int e = t & 31, ig = t >> 5;
#pragma unroll
            for (int ii = 0; ii < 4; ++ii) { const int i = ig * 4 + ii; float o1 = 0.f, o2 = 0.f;
                for (int j = 0; j < 64; ++j) o1 += Ps[i * 65 + j] * Vs[j * 32 + e];
                for (int d = 0; d < 128; ++d) o2 += Qs[i * 129 + d] * Ss[d * 32 + e];
                RAW[(m0 + i) * 1024 + h * 256 + es * 32 + e] = o1 + expf(lg * (float)(i + 1)) * o2; }
        }
        __syncthreads();
        {
            const int e = t & 31, dg = t >> 5; float a[8];
#pragma unroll
            for (int dd = 0; dd < 8; ++dd) a[dd] = 0.f;
            for (int j = 0; j < 64; ++j) { const float vd = Vs[j * 32 + e] * expf(lg * (float)(63 - j));
#pragma unroll
                for (int dd = 0; dd < 8; ++dd) a[dd] += Ks[j * 129 + dg * 8 + dd] * vd; }
#pragma unroll
            for (int dd = 0; dd < 8; ++dd) { const int d = dg * 8 + dd; Ss[d * 32 + e] = Ss[d * 32 + e] * cdec + a[dd]; }
        }
    }
    __syncthreads();
}

__device__ __forceinline__ void lru_simple(Frame& F, int item) {
    const int b = item >> 5, cb = (item >> 2) & 7, q = item & 3, t = F.tid;
    LAS float* Xs = (LAS float*)(F.lds);
    LAS float* XC = Xs + 67 * 128;
    LAS float* Wa = XC + 64 * 129;
    LAS float* Wx = Wa + 128 * 32;
    LAS float* AA = Wx + 128 * 32;
    LAS float* UU = AA + 64 * 32;
    LAS float* Hc = UU + 64 * 32;
    __syncthreads();
    for (int i = t; i < 128 * 32; i += 512) { const int r = i >> 5, c = i & 31;
        Wa[i] = F.w_rg_a[((size_t)cb * 128 + r) * 128 + q * 32 + c]; Wx[i] = F.w_rg_x[((size_t)cb * 128 + r) * 128 + q * 32 + c]; }
    if (t < 32) Hc[t] = 0.f;
    const int c = t & 31, tg = t >> 5, ch = cb * 128 + q * 32 + c;
    const float ba = F.b_rg_a[ch], bx = F.b_rg_x[ch];
    const float lamv = F.lam[ch];
    const float Lc = -8.0f * log1pf(expf(-lamv));
    for (int tile = 0; tile < SEQ / 64; ++tile) {
        const int t0 = tile * 64; const size_t m0 = (size_t)b * SEQ + t0;
        __syncthreads();
        for (int id = t; id < 67 * 16; id += 512) { const int r = id >> 4, c8 = id & 15; const int s = t0 - 3 + r;
            v4u v = (v4u){0u, 0u, 0u, 0u};
            if (s >= 0) v = *(const GAS v4u*)(F.XL + ((size_t)b * SEQ + s) * 1024 + cb * 128 + c8 * 8);
            LAS float* xd = Xs + r * 128 + c8 * 8;
            xd[0] = bflo(v.x); xd[1] = bfhi(v.x); xd[2] = bflo(v.y); xd[3] = bfhi(v.y); xd[4] = bflo(v.z); xd[5] = bfhi(v.z); xd[6] = bflo(v.w); xd[7] = bfhi(v.w); }
        __syncthreads();
#pragma unroll 4
        for (int k = 0; k < 16; ++k) { const int id = t + 512 * k, tt = id >> 7, i = id & 127, cc = cb * 128 + i;
            float a = F.conv_b[cc];
#pragma unroll
            for (int j = 0; j < 4; ++j) a += F.conv_w[j * 1024 + cc] * Xs[(tt + j) * 128 + i];
            XC[tt * 129 + i] = a; }
        __syncthreads();
#pragma unroll
        for (int k = 0; k < 4; ++k) { const int tt = tg * 4 + k; float rp = ba, ip = bx;
            for (int i = 0; i < 128; ++i) { const float xv = XC[tt * 129 + i]; rp += xv * Wa[i * 32 + c]; ip += xv * Wx[i * 32 + c]; }
            const float r = 1.0f / (1.0f + expf(-rp)), ig = 1.0f / (1.0f + expf(-ip));
            const float la = r * Lc;
            AA[tt * 32 + c] = expf(la);
            UU[tt * 32 + c] = sqrtf(-expm1f(2.0f * la)) * (ig * XC[tt * 129 + q * 32 + c]); }
        __syncthreads();
        if (t < 32) { float hh = Hc[t];
            for (int k = 0; k < 64; ++k) { hh = AA[k * 32 + t] * hh + UU[k * 32 + t]; UU[k * 32 + t] = hh; }
            Hc[t] = hh; }
        __syncthreads();
#pragma unroll
        for (int k = 0; k < 4; ++k) { const int id = t + 512 * k, tt = id >> 5, cc = id & 31; const size_t off = (m0 + tt) * 1024 + cb * 128 + q * 32 + cc;
            F.SGL[off] = (bf16)f2bf(bf2f(F.SGL[off]) * UU[tt * 32 + cc]); }
    }
    __syncthreads();
}

__device__ __forceinline__ void gn_gate(Frame& F, const float* RAW) {
    const int gw = F.vcu * NWAVES + F.wave, NGW = F.G * NWAVES;
    for (int m = gw; m < M; m += NGW) {
        const GAS f32x4* xr = (const GAS f32x4*)(RAW + (size_t)m * D) + F.lane;
        GAS v2u* sg = (GAS v2u*)(F.SGR + (size_t)m * D) + F.lane;
#pragma unroll
        for (int j = 0; j < 4; ++j) {
            f32x4 v = xr[64 * j];
            const float mean = wave_sum((v.x + v.y) + (v.z + v.w)) * (1.f / 256.f);
            v = v - mean;
            const float rstd = 1.f / sqrtf(wave_sum((v.x * v.x + v.y * v.y) + (v.z * v.z + v.w * v.w)) * (1.f / 256.f) + LN_EPS);
            const f32x4 g = *((const GAS f32x4*)F.gn_g + F.lane + 64 * j), bb = *((const GAS f32x4*)F.gn_b + F.lane + 64 * j);
            const f32x4 y = v * rstd * g + bb;
            const v2u s = sg[64 * j]; v2u w;
            w.x = pk2(bflo(s.x) * y.x, bfhi(s.x) * y.y); w.y = pk2(bflo(s.y) * y.z, bfhi(s.y) * y.w);
            sg[64 * j] = w;
        }
    }
}

__device__ __forceinline__ void final_ln(Frame& F) {
    const int gw = F.vcu * NWAVES + F.wave, NGW = F.G * NWAVES;
    f32x4 xn[4]; v2u yn[4];
    if (gw < M) {
#pragma unroll
        for (int j = 0; j < 4; ++j) { xn[j] = ((const GAS f32x4*)(F.x + (size_t)gw * D) + F.lane)[64 * j]; yn[j] = ((const GAS v2u*)(F.V + (size_t)gw * D) + F.lane)[64 * j]; } }
    for (int m = gw; m < M; m += NGW) {
        GAS f32x4* orow = (GAS f32x4*)(F.out + (size_t)m * D) + F.lane;
        f32x4 v[4], y[4]; float s = 0.f;
#pragma unroll
        for (int j = 0; j < 4; ++j) { v[j] = xn[j]; y[j] = (f32x4){bflo(yn[j].x), bfhi(yn[j].x), bflo(yn[j].y), bfhi(yn[j].y)}; s += (v[j].x + v[j].y) + (v[j].z + v[j].w); }
        if (m + NGW < M) {
#pragma unroll
            for (int j = 0; j < 4; ++j) { xn[j] = ((const GAS f32x4*)(F.x + (size_t)(m + NGW) * D) + F.lane)[64 * j]; yn[j] = ((const GAS v2u*)(F.V + (size_t)(m + NGW) * D) + F.lane)[64 * j]; } }
        float mean = wave_sum(s) * (1.f / D); float s2 = 0.f;
#pragma unroll
        for (int j = 0; j < 4; ++j) { v[j] = v[j] - mean; s2 += (v[j].x * v[j].x + v[j].y * v[j].y) + (v[j].z * v[j].z + v[j].w * v[j].w); }
        float rstd = 1.f / sqrtf(wave_sum(s2) * (1.f / D) + LN_EPS);
        s = 0.f;
#pragma unroll
        for (int j = 0; j < 4; ++j) { const f32x4 g = *((const GAS f32x4*)F.ln_in_g + F.lane + 64 * j), bb = *((const GAS f32x4*)F.ln_in_b + F.lane + 64 * j);
            v[j] = (v[j] * rstd * g + bb) * DN_ALPHA + y[j]; s += (v[j].x + v[j].y) + (v[j].z + v[j].w); }
        mean = wave_sum(s) * (1.f / D); s2 = 0.f;
#pragma unroll
        for (int j = 0; j < 4; ++j) { v[j] = v[j] - mean; s2 += (v[j].x * v[j].x + v[j].y * v[j].y) + (v[j].z * v[j].z + v[j].w * v[j].w); }
        rstd = 1.f / sqrtf(wave_sum(s2) * (1.f / D) + LN_EPS);
#pragma unroll
        for (int j = 0; j < 4; ++j) { const f32x4 g = *((const GAS f32x4*)F.ln_out_g + F.lane + 64 * j), bb = *((const GAS f32x4*)F.ln_out_b + F.lane + 64 * j);
            orow[64 * j] = v[j] * rstd * g + bb; }
    }
}

struct Args { const float* in[19]; float* out; unsigned char* ws; int ph_lo, ph_hi, li, pad; };
__global__ void __launch_bounds__(NWAVES * 64, 2) fwd_kernel(Args args) {
    extern __shared__ __attribute__((aligned(16))) unsigned char lds[];
    Frame F;
    F.lds = (LAS unsigned char*)lds;
    F.MISC = (volatile LAS unsigned*)(F.lds + MISC_OFF);
    F.tid = threadIdx.x; F.lane = F.tid & 63; F.wave = __builtin_amdgcn_readfirstlane(F.tid >> 6);
    F.G = gridDim.x; { const int bx = blockIdx.x; F.vcu = (F.G % 8 == 0) ? (bx % 8) * (F.G / 8) + bx / 8 : bx; }
    unsigned char* ws = args.ws;
    F.ctl = (gu32*)(ws + WS_CTL);
    F.x = args.in[0]; F.ln_in_g = args.in[1]; F.ln_in_b = args.in[2]; F.w_in = args.in[3]; F.b_merge = args.in[4]; F.gn_g = args.in[5]; F.gn_b = args.in[6]; F.w_ret = args.in[7];
    F.conv_w = args.in[8]; F.conv_b = args.in[9]; F.w_rg_a = args.in[10]; F.b_rg_a = args.in[11]; F.w_rg_x = args.in[12]; F.b_rg_x = args.in[13]; F.lam = args.in[14]; F.w_lru = args.in[15];
    F.w_out = args.in[16]; F.ln_out_g = args.in[17]; F.ln_out_b = args.in[18]; F.out = args.out;
    F.WinT = (bf16*)(ws + WS_WIN); F.PcatT = (bf16*)(ws + WS_PCAT); F.WoutT = (bf16*)(ws + WS_WOUT); F.rope = (float*)(ws + WS_ROPE);
    F.Q = (bf16*)(ws + WS_Q); F.K = (bf16*)(ws + WS_K); F.V = (bf16*)(ws + WS_V); F.SGR = (bf16*)(ws + WS_ACAT); F.XL = (bf16*)(ws + WS_XL); F.SGL = (bf16*)(ws + WS_ACAT) + 1024;
    F.GR = (bf16*)(ws + WS_GR); F.GL = (bf16*)(ws + WS_GL); F.MERGED = (bf16*)(ws + WS_MERGED); F.XN = (bf16*)args.out;
    for (int u = F.tid; u < (LDS_BYTES - LDSCTL_OFF) / 4; u += NWAVES * 64) ((LAS unsigned*)(F.lds + LDSCTL_OFF))[u] = 0u;
    __syncthreads();
    XcdBarrier bar; bar.bar = (unsigned*)(F.ctl + CW_BAR); bar.x = 0; bar.st = nullptr;
    if (MK_ONE_LAUNCH) bar = xcd_barrier_post((unsigned*)(F.ctl + CW_BAR), F.MISC + 8);
#define GRID_BAR(seam) do { if (!MK_ONE_LAUNCH) { if (F.tid == 0) __hip_atomic_store(F.ctl + CW_TMO, 0xBADBA0u | (unsigned)(seam), RLX_AGENT); } else { xcd_barrier(bar); } } while (0)
    const int lo = args.ph_lo, hi = args.ph_hi;
    unsigned long long pacc = 0;
    PSEC_B(60)
#define IN(k) (lo <= (k) && (k) < hi)
#define BOTH(k) (IN(k) && IN((k) + 1))
#define NREP(k) ((((PROBE_DUP) >> (k)) & 1) + 1)

    if (IN(0)) { PSEC_B(30) _Pragma("nounroll") for (int rep = 0; rep < NREP(0); ++rep) p0_prologue(F); PSEC_E(30) PSEC_B(40) if (BOTH(0)) GRID_BAR(0); PSEC_E(40) }

    if (IN(1)) {
        PSEC_B(31)
        _Pragma("nounroll") for (int rep = 0; rep < NREP(1); ++rep) {
        pg8::Gemm g{F.XN, F.WinT, M, NIN, D}; pg8::StaticOrder S; S.init(M, NIN, F.G, (int)blockIdx.x);
        typedef pg8::EpiIn<(long)(WS_ACAT - WS_V) / 2, (long)(WS_XL - WS_V) / 2, (long)(WS_ACAT - WS_V) / 2 + 1024> EpiInT;
        EpiInT E{F.Q, F.K, F.V, F.GR, F.GL, F.rope, F.b_merge};
        pg8::gemm_phase<EpiInT, pg8::StaticOrder, PG8_ALIGN, PG8_SP2>(F.lds + RING_OFF, g, S, E, pacc, 1);
        }
        PSEC_E(31) PSEC_B(41)
        if (BOTH(1)) GRID_BAR(1);
        PSEC_E(41)
    }

    if (IN(2)) {
        PSEC_B(32)
        _Pragma("nounroll") for (int rep = 0; rep < NREP(8); ++rep)
        for (int it = F.vcu; it < 256; it += F.G) rt::pass1(F.lds, F.tid, F.wave, it, F.K, F.V, (float*)(ws + WS_SLOC));
        PSEC_E(32) PSEC_B(33)
        _Pragma("nounroll") for (int rep = 0; rep < NREP(2); ++rep)
        for (int it = F.vcu; it < 256; it += F.G) lr::run(F.lds, F.tid, F.wave, it, F.XL, F.SGL, (rep + 1 < NREP(2)) ? (bf16*)F.out : F.SGL, F.conv_w, F.conv_b, F.w_rg_a, F.b_rg_a, F.w_rg_x, F.b_rg_x, F.lam, pacc);
        PSEC_E(33) PSEC_B(42)
        if (BOTH(2)) GRID_BAR(2);
        PSEC_E(42)
    }

    if (IN(3)) {
        PSEC_B(34)
        _Pragma("nounroll") for (int rep = 0; rep < NREP(3); ++rep)
        for (int it = F.vcu; it < 256; it += F.G) rt::pass2(F.lds, F.tid, F.wave, it, F.Q, F.K, F.V, F.SGR, (rep + 1 < NREP(3)) ? (bf16*)F.out : F.SGR, (const float*)(ws + WS_SLOC), F.gn_g, F.gn_b, pacc);
        PSEC_E(34) PSEC_B(43)
        if (BOTH(3)) GRID_BAR(3);
        PSEC_E(43)
    }

    if (IN(4)) {
        PSEC_B(35)
        _Pragma("nounroll") for (int rep = 0; rep < NREP(4); ++rep) {
        pg8::Gemm g{F.SGR, F.PcatT, M, D, 2 * D}; pg8::StaticOrder S; S.init(M, D, F.G, (int)blockIdx.x);
        pg8::EpiMerge2 E{F.MERGED, F.GR, F.GL, D};
        pg8::gemm_phase<pg8::EpiMerge2, pg8::StaticOrder, PG8_ALIGN, PG8_SP2>(F.lds + RING_OFF, g, S, E, pacc, 4);
        }
        PSEC_E(35) PSEC_B(44)
        if (BOTH(4)) GRID_BAR(4);
        PSEC_E(44)
    }

    if (IN(5)) {
        PSEC_B(37)
        _Pragma("nounroll") for (int rep = 0; rep < NREP(5); ++rep) {
        pg8::Gemm g{F.MERGED, F.WoutT, M, D, D}; pg8::StaticOrder S; S.init(M, D, F.G, (int)blockIdx.x);
        pg8::EpiBf16Plain E{F.V, D};
        pg8::gemm_phase<pg8::EpiBf16Plain, pg8::StaticOrder, PG8_ALIGN, PG8_SP2>(F.lds + RING_OFF, g, S, E, pacc, 5);
        }
        PSEC_E(37) PSEC_B(46)
        if (BOTH(5)) GRID_BAR(5);
        PSEC_E(46)
    }

    if (IN(6)) { PSEC_B(38) final_ln(F); PSEC_E(38) }
    PSEC_E(60)
    if (PROBE_SEC != 0 && F.wave == 0) { const unsigned long long t0 = __builtin_amdgcn_s_memrealtime(); while (__builtin_amdgcn_s_memrealtime() - t0 < pacc) __builtin_amdgcn_s_sleep(8); }
#undef IN
#undef BOTH
}

extern "C" void kernel_launch(void* const* d_in, const int* in_sizes, int n_in, void* d_out, int out_size, void* d_ws, size_t ws_size, hipStream_t stream) {
    static int grid = 0;
    if (grid == 0) {
        if (n_in != 19 || in_sizes[0] != M * D || out_size != M * D || ws_size < WS_END2) { fprintf(stderr, "kernel_launch: unexpected shapes (n_in %d, in0 %d, out %d, ws %zu); nothing launched\n", n_in, n_in > 0 ? in_sizes[0] : -1, out_size, ws_size); grid = -1; return; }
        int dev = 0, cus = 0, per_cu = 0;
        if (hipGetDevice(&dev) != hipSuccess || hipDeviceGetAttribute(&cus, hipDeviceAttributeMultiprocessorCount, dev) != hipSuccess) { grid = -1; return; }
        if (hipFuncSetAttribute((const void*)fwd_kernel, hipFuncAttributeMaxDynamicSharedMemorySize, LDS_BYTES) != hipSuccess) { fprintf(stderr, "kernel_launch: hipFuncSetAttribute failed\n"); grid = -1; return; }
        if (hipOccupancyMaxActiveBlocksPerMultiprocessor(&per_cu, (const void*)fwd_kernel, NWAVES * 64, LDS_BYTES) != hipSuccess || per_cu < 1) { fprintf(stderr, "kernel_launch: occupancy query reports %d\n", per_cu); per_cu = 1; }
        (void)hipGetLastError();
        grid = cus;
    }
    if (grid < 0) return;
    if (hipMemsetAsync((char*)d_ws + WS_CTL, 0, CTL_ZERO_BYTES, stream) != hipSuccess) return;
    Args a{};
    for (int i = 0; i < 19; ++i) a.in[i] = (const float*)d_in[i];
    a.out = (float*)d_out; a.ws = (unsigned char*)d_ws;
    const int nl = MK_ONE_LAUNCH ? 1 : NPHASES;
    for (int li = 0; li < nl; ++li) {
        a.ph_lo = MK_ONE_LAUNCH ? 0 : li; a.ph_hi = MK_ONE_LAUNCH ? NPHASES : li + 1; a.li = li;
        hipLaunchKernelGGL(fwd_kernel, dim3(grid), dim3(NWAVES * 64), LDS_BYTES, stream, a);
        if (hipPeekAtLastError() != hipSuccess) break;
    }
}
```
